# Optimizing an MI355X kernel written in HIP

```python
import jax, jax.numpy as jnp
from jax import lax
import numpy as np

D_MODEL = 1024
BATCH = 8
SEQ = 4096
DEPTH = 1

CHUNK = 64
EPS = 1e-6
ROPE_THETA = 10000.0
GLA_HEADS = 4
GLA_DK = 64
GLA_DV = 128
GLA_GATE_RANK = 16
GLA_TAU = 16.0
DSA_HEADS = 4
DSA_HEAD_DIM = 128
IDX_HEADS = 4
IDX_DIM = 64
TOPK_MAX = 256
Q_BLOCK = 128
D_FF = 4 * D_MODEL

GLA_QK = GLA_HEADS * GLA_DK
GLA_V = GLA_HEADS * GLA_DV
DSA_Q = DSA_HEADS * DSA_HEAD_DIM
IDX_Q = IDX_HEADS * IDX_DIM
SPLITS = (GLA_QK, GLA_QK, GLA_V, GLA_GATE_RANK, GLA_V, DSA_Q, DSA_HEAD_DIM, DSA_HEAD_DIM, IDX_Q, IDX_DIM, IDX_HEADS)
D_IN = sum(SPLITS)
D_MIX = GLA_V + DSA_Q

kernel_name = 'hymba_gla_dsa_sandwich_block'


def rmsnorm(x, w):
    xf = x.astype(jnp.float32)
    y = xf * lax.rsqrt(jnp.mean(xf * xf, axis=-1, keepdims=True) + EPS)
    return (y * w.astype(jnp.float32)).astype(x.dtype)


def layernorm(x, w, b):
    xf = x.astype(jnp.float32)
    mu = jnp.mean(xf, axis=-1, keepdims=True)
    var = jnp.mean(jnp.square(xf - mu), axis=-1, keepdims=True)
    y = (xf - mu) * lax.rsqrt(var + EPS)
    return (y * w.astype(jnp.float32) + b.astype(jnp.float32)).astype(x.dtype)


def rope(x, pos):
    d = x.shape[-1]
    inv = ROPE_THETA ** (-jnp.arange(0, d, 2, dtype=jnp.float32) / d)
    ang = pos.astype(jnp.float32)[:, None] * inv[None, :]
    cos = jnp.cos(ang)[None, :, None, :]
    sin = jnp.sin(ang)[None, :, None, :]
    x1, x2 = jnp.split(x.astype(jnp.float32), 2, axis=-1)
    out = jnp.concatenate([x1 * cos - x2 * sin, x2 * cos + x1 * sin], axis=-1)
    return out.astype(x.dtype)


def gla_mixer(q, k, v, g_log, r, norm_w):
    B, S = q.shape[0], q.shape[1]
    N = S // CHUNK

    def to_chunks(t, d):
        return t.astype(jnp.float32).reshape(B, N, CHUNK, GLA_HEADS, d).transpose(0, 3, 1, 2, 4)

    qc = to_chunks(q, GLA_DK) * (GLA_DK ** -0.5)
    kc = to_chunks(k, GLA_DK)
    vc = to_chunks(v, GLA_DV)
    gc = to_chunks(g_log, GLA_DK)
    bcum = jnp.cumsum(gc, axis=3)
    b_last = bcum[..., -1:, :]
    q_dec = qc * jnp.exp(bcum)
    k_inv = kc * jnp.exp(-bcum)
    k_end = kc * jnp.exp(b_last - bcum)
    causal = jnp.tril(jnp.ones((CHUNK, CHUNK), dtype=bool))
    attn = jnp.where(causal, jnp.einsum('bhnid,bhnjd->bhnij', q_dec, k_inv), 0.0)
    o_intra = jnp.einsum('bhnij,bhnjv->bhniv', attn, vc)
    u = jnp.einsum('bhnjd,bhnjv->nbhdv', k_end, vc)
    decay = jnp.exp(b_last[..., 0, :]).transpose(2, 0, 1, 3)

    def step(state, inp):
        dec, uc = inp
        return dec[..., None] * state + uc, state

    s0 = jnp.zeros(u.shape[1:], jnp.float32)
    _, s_in = lax.scan(step, s0, (decay, u))
    o_inter = jnp.einsum('bhnid,nbhdv->bhniv', q_dec, s_in)
    o = (o_intra + o_inter).transpose(0, 2, 3, 1, 4).reshape(B, S, GLA_HEADS, GLA_DV)
    o = rmsnorm(o, norm_w).reshape(B, S, GLA_V) * jax.nn.silu(r.astype(jnp.float32))
    return o


def dsa_mixer(q, k, v, qi, ki, wi):
    B, S = q.shape[0], q.shape[1]
    n_sel = min(TOPK_MAX, S // 4)
    nb = S // Q_BLOCK
    key_chunk = jnp.arange(S) // CHUNK
    kf = ki.astype(jnp.float32)

    def blocks(t):
        return t.reshape((B, nb, Q_BLOCK) + t.shape[2:]).swapaxes(0, 1)

    def one_block(args):
        qb, qib, wib, qchunk = args
        allowed = key_chunk[None, :] <= qchunk[:, None]
        idx_logits = jnp.einsum('bqhd,bsd->bqhs', qib.astype(jnp.float32), kf)
        score = jnp.einsum('bqh,bqhs->bqs', wib.astype(jnp.float32), jax.nn.relu(idx_logits))
        score = jnp.where(allowed[None], score, -jnp.inf)
        _, sel = lax.top_k(score, n_sel)
        valid = key_chunk[sel] <= qchunk[None, :, None]
        k_sel = jax.vmap(lambda kb, ib: kb[ib])(k, sel)
        v_sel = jax.vmap(lambda vb, ib: vb[ib])(v, sel)
        logits = jnp.einsum('bqhd,bqkd->bqhk', qb.astype(jnp.float32), k_sel.astype(jnp.float32)) * (DSA_HEAD_DIM ** -0.5)
        logits = jnp.where(valid[:, :, None, :], logits, -jnp.inf)
        p = jax.nn.softmax(logits, axis=-1)
        return jnp.einsum('bqhk,bqkd->bqhd', p, v_sel.astype(jnp.float32))

    out = lax.map(one_block, (blocks(q), blocks(qi), blocks(wi), key_chunk.reshape(nb, Q_BLOCK)))
    return out.swapaxes(0, 1).reshape(B, S, DSA_Q)


def setup_inputs(seed: int = 0) -> dict:
    key = jax.random.key(seed)
    ks = jax.random.split(key, 16)
    f32 = jnp.float32

    def gain(k, shape):
        return 1.0 + 0.02 * jax.random.normal(k, shape, f32)

    return {
        'x': jax.random.normal(ks[0], (BATCH, SEQ, D_MODEL), f32),
        'norm_mix_pre': gain(ks[1], (DEPTH, D_MODEL)),
        'w_in': jax.random.normal(ks[2], (DEPTH, D_MODEL, D_IN), f32) * D_MODEL ** -0.5,
        'gla_gate_w2': jax.random.normal(ks[3], (DEPTH, GLA_GATE_RANK, GLA_QK), f32) * GLA_GATE_RANK ** -0.5,
        'gla_gate_b': 0.1 * jax.random.normal(ks[4], (DEPTH, GLA_QK), f32),
        'gla_norm_w': gain(ks[5], (DEPTH, GLA_DV)),
        'idx_k_norm_w': gain(ks[6], (DEPTH, IDX_DIM)),
        'idx_k_norm_b': 0.02 * jax.random.normal(ks[7], (DEPTH, IDX_DIM), f32),
        'w_out': jax.random.normal(ks[8], (DEPTH, D_MIX, D_MODEL), f32) * D_MIX ** -0.5,
        'norm_mix_post': gain(ks[9], (DEPTH, D_MODEL)),
        'norm_ffn_pre': gain(ks[10], (DEPTH, D_MODEL)),
        'w_ff1': jax.random.normal(ks[11], (DEPTH, D_MODEL, D_FF), f32) * D_MODEL ** -0.5,
        'w_ff2': jax.random.normal(ks[12], (DEPTH, D_FF, D_MODEL), f32) * D_FF ** -0.5,
        'norm_ffn_post': gain(ks[13], (DEPTH, D_MODEL)),
    }


def reference(x, norm_mix_pre, w_in, gla_gate_w2, gla_gate_b, gla_norm_w, idx_k_norm_w, idx_k_norm_b,
              w_out, norm_mix_post, norm_ffn_pre, w_ff1, w_ff2, norm_ffn_post):
    B, S = x.shape[0], x.shape[1]
    pos = jnp.arange(S)
    offsets = [int(o) for o in np.cumsum(SPLITS)[:-1]]
    for l in range(DEPTH):
        h = rmsnorm(x, norm_mix_pre[l])
        proj = h @ w_in[l]
        (g_q, g_k, g_v, g_lr, g_r, d_q, d_k, d_v, i_q, i_k, i_w) = jnp.split(proj, offsets, axis=-1)
        g_log = jax.nn.log_sigmoid((g_lr @ gla_gate_w2[l] + gla_gate_b[l]).astype(jnp.float32)) / GLA_TAU
        gla_out = gla_mixer(g_q.reshape(B, S, GLA_HEADS, GLA_DK), g_k.reshape(B, S, GLA_HEADS, GLA_DK), g_v,
                            g_log.reshape(B, S, GLA_HEADS, GLA_DK), g_r, gla_norm_w[l])
        d_q = rope(d_q.reshape(B, S, DSA_HEADS, DSA_HEAD_DIM), pos)
        d_k = rope(d_k[:, :, None, :], pos)[:, :, 0, :]
        i_q = rope(i_q.reshape(B, S, IDX_HEADS, IDX_DIM), pos)
        i_k = rope(layernorm(i_k, idx_k_norm_w[l], idx_k_norm_b[l])[:, :, None, :], pos)[:, :, 0, :]
        i_w = i_w * (IDX_HEADS ** -0.5 * IDX_DIM ** -0.5)
        dsa_out = dsa_mixer(d_q, d_k, d_v, i_q, i_k, i_w)
        mixed = jnp.concatenate([gla_out, dsa_out], axis=-1).astype(x.dtype) @ w_out[l]
        x = x + rmsnorm(mixed, norm_mix_post[l])
        hf = rmsnorm(x, norm_ffn_pre[l]) @ w_ff1[l]
        ff = jnp.square(jax.nn.relu(hf)) @ w_ff2[l]
        x = x + rmsnorm(ff, norm_ffn_post[l])
    return x
```

```cpp
#include <hip/hip_runtime.h>
#include <cstdio>
#include <cstdint>
#include <cmath>
namespace pg8 {
#define PG8_LAS __attribute__((address_space(3)))
typedef unsigned short bf16_t;
typedef short bf16x8 __attribute__((ext_vector_type(8)));
typedef float f32x4 __attribute__((ext_vector_type(4)));
typedef unsigned u32x4 __attribute__((ext_vector_type(4)));
constexpr int BM = 256, BK = 64, HALF = 128, HTB = HALF * BK * 2  , STAGE_BYTES = 8 * HTB, NXCD = 8, WGM = 8;

__host__ __device__ __forceinline__ int lds_byte(int r, int c) { const int st = (r >> 4) * 2 + (c >> 5), rr = r & 15, cc = c & 31, ob = rr * 64 + cc * 2; return st * 1024 + (ob ^ (((ob >> 9) & 1) << 5)); }
__host__ __device__ __forceinline__ void stage_rc(int b, int& R, int& C) { const int st = b / 1024, sb = b % 1024, swz = sb ^ (((sb >> 9) & 1) << 5); R = (st >> 1) * 16 + swz / 64; C = (st & 1) * 32 + (swz % 64) / 2; }
__host__ __device__ __forceinline__ int perm32(int rho) { const int n = rho >> 4, i = rho & 15; return 8 * (i >> 2) + 4 * n + (i & 3); }

struct Unit { int pm, pn; };
struct Gemm { const bf16_t* A; const bf16_t* Bt; int M, N, K, lda, ldb, awrap; };

struct StaticOrder {
    int nM, nN, nwg, G, c;
    __host__ __device__ void init(int M, int N, int G_, int c_) { nM = M / BM; nN = N / BM; nwg = nM * nN; G = G_; c = c_; }
    __host__ __device__ bool next(int i, Unit& u) const {
        const long L = (long)i * G + c; if (L >= nwg) return false;
        int wgid = (int)L; { const int q = nwg / NXCD, r = nwg % NXCD, xcd = wgid % NXCD, off = wgid / NXCD; wgid = (xcd < r ? xcd * (q + 1) : r * (q + 1) + (xcd - r) * q) + off; }
        const int nig = WGM * nN, gid = wgid / nig, fm = gid * WGM, gsz = (nM - fm) < WGM ? (nM - fm) : WGM;
        u.pm = fm + ((wgid % nig) % gsz); u.pn = (wgid % nig) / gsz; return true;
    }
    __device__ __forceinline__ void a_ready(const Unit&) const {}
    __device__ __forceinline__ void done(const Unit&) const {}
};

__device__ __forceinline__ unsigned cvt_pk_bf16(float lo, float hi) { unsigned r; asm volatile("v_cvt_pk_bf16_f32 %0, %1, %2" : "=v"(r) : "v"(lo), "v"(hi)); return r; }
template <int ACT  , bool SS> struct EpiBf16X {
    static constexpr bool PERM = true, AFTER_DRAIN = false;
    bf16_t* O; int ldc; float* ss;
    __device__ __forceinline__ void operator()(const f32x4 (&acc)[2][2][4][2], const Unit& u, int wr, int wc, int fr, int fq) const {
        const int row0 = u.pm * BM + wr * 64 + fr; const int col0 = u.pn * BM + wc * 32 + 8 * fq;
#pragma unroll
        for (int ai = 0; ai < 2; ++ai)
#pragma unroll
            for (int m = 0; m < 4; ++m) { const int row = row0 + ai * HALF + m * 16; bf16_t* rowp = O + (size_t)row * ldc + col0; float s = 0.f;
#pragma unroll
                for (int bj = 0; bj < 2; ++bj) { f32x4 v0 = acc[ai][bj][m][0], v1 = acc[ai][bj][m][1];
                    if (ACT == 2) {
#pragma unroll
                        for (int e = 0; e < 4; ++e) { const float a = fmaxf(v0[e], 0.f), b = fmaxf(v1[e], 0.f); v0[e] = a * a; v1[e] = b * b; } }
                    if (SS) s += (v0[0] * v0[0] + v0[1] * v0[1]) + (v0[2] * v0[2] + v0[3] * v0[3]) + (v1[0] * v1[0] + v1[1] * v1[1]) + (v1[2] * v1[2] + v1[3] * v1[3]);
                    u32x4 w; w.x = cvt_pk_bf16(v0[0], v0[1]); w.y = cvt_pk_bf16(v0[2], v0[3]); w.z = cvt_pk_bf16(v1[0], v1[1]); w.w = cvt_pk_bf16(v1[2], v1[3]);
                    *(u32x4*)(rowp + bj * HALF) = w; }
                if (SS) { s += __shfl_xor(s, 16); s += __shfl_xor(s, 32); if (fq == 0) atomicAdd(ss + row, s); } }
    }
};
struct EpiF32 {
    static constexpr bool PERM = false, AFTER_DRAIN = false;
    float* O; int ldc;
    __device__ __forceinline__ void operator()(const f32x4 (&acc)[2][2][4][2], const Unit& u, int wr, int wc, int fr, int fq) const {
        const int row0 = u.pm * BM + wr * 64 + fr; const int col0 = u.pn * BM + wc * 32 + 4 * fq;
#pragma unroll
        for (int ai = 0; ai < 2; ++ai)
#pragma unroll
            for (int m = 0; m < 4; ++m) { float* rowp = O + (size_t)(row0 + ai * HALF + m * 16) * ldc + col0;
#pragma unroll
                for (int bj = 0; bj < 2; ++bj)
#pragma unroll
                    for (int n = 0; n < 2; ++n) *(f32x4*)(rowp + bj * HALF + n * 16) = acc[ai][bj][m][n]; }
    }
};
template <class Epi, class Sched, bool ALIGN_EPI = false, bool SP2 = false>
__device__ __forceinline__ void gemm_phase(PG8_LAS unsigned char* lds, const Gemm g, const Sched& S, const Epi& E) {
    const int tid = threadIdx.x, wid = __builtin_amdgcn_readfirstlane(tid >> 6), lane = tid & 63, wr = wid >> 2, wc = wid & 3, fr = lane & 15, fq = lane >> 4;
    const int K = g.K, nt = K / BK;
    unsigned voffA[2], voffB[2];
#pragma unroll
    for (int i = 0; i < 2; ++i) { int R, C; stage_rc(tid * 16 + i * 8192, R, C); const int Rb = Epi::PERM ? ((R & ~31) + perm32(R & 31)) : R;
        voffA[i] = (unsigned)(R * g.lda + C) * 2u; voffB[i] = (unsigned)(Rb * g.ldb + C) * 2u; }
    const size_t kstep = (size_t)(BK * 2);
    const size_t hstepA = (size_t)HALF * g.lda * 2, hstepB = (size_t)HALF * g.ldb * 2;
    const size_t tstepA = 2 * hstepA, tstepB = 2 * hstepB; const int awrap = g.awrap;
    const unsigned ldsw = (unsigned)wid * 1024u;
    const int aoff = lds_byte(wr * 64 + fr, fq * 8), boff = lds_byte(wc * 32 + fr, fq * 8);
#define PG8_SA(b, h) (((b) * 2 + (h)) * HTB)
#define PG8_SB(b, h) ((4 + (b) * 2 + (h)) * HTB)
#define PG8_STAGE(bufoff, gbase, voff) do { _Pragma("unroll") for (int _i = 0; _i < 2; ++_i) \
        __builtin_amdgcn_global_load_lds((const unsigned*)((const char*)(gbase) + (voff)[_i]), (PG8_LAS unsigned*)(lds + (bufoff) + ldsw + _i * 8192), 16, 0, 0); } while (0)
#define PG8_LDA(dst, b, h) do { _Pragma("unroll") for (int m = 0; m < 4; ++m) _Pragma("unroll") for (int k = 0; k < 2; ++k) dst[m][k] = *(const PG8_LAS bf16x8*)(lds + PG8_SA(b, h) + aoff + m * 2048 + k * 1024); } while (0)
#define PG8_LDB(dst, b, h) do { _Pragma("unroll") for (int n = 0; n < 2; ++n) _Pragma("unroll") for (int k = 0; k < 2; ++k) dst[n][k] = *(const PG8_LAS bf16x8*)(lds + PG8_SB(b, h) + boff + n * 2048 + k * 1024); } while (0)
#define PG8_MMA(ai, bj, At, Bt) do { __builtin_amdgcn_s_setprio(1); _Pragma("unroll") for (int m = 0; m < 4; ++m) _Pragma("unroll") for (int n = 0; n < 2; ++n) _Pragma("unroll") for (int k = 0; k < 2; ++k) \
        acc[ai][bj][m][n] = __builtin_amdgcn_mfma_f32_16x16x32_bf16(Bt[n][k], At[m][k], acc[ai][bj][m][n], 0, 0, 0); __builtin_amdgcn_s_setprio(0); } while (0)
#define PG8_WAIT_V(n) asm volatile("s_waitcnt vmcnt(" #n ")" ::: "memory")
#define PG8_WAIT_L(n) asm volatile("s_waitcnt lgkmcnt(" #n ")" ::: "memory")
#define PG8_BAR __builtin_amdgcn_s_barrier()
#define PG8_SCHED __builtin_amdgcn_sched_barrier(0)
    Unit cur, nxt; int ui = 0;
    if (!S.next(0, cur)) return;
    f32x4 acc[2][2][4][2];
#pragma unroll
    for (int a = 0; a < 2; ++a)
#pragma unroll
        for (int b = 0; b < 2; ++b)
#pragma unroll
            for (int m = 0; m < 4; ++m)
#pragma unroll
                for (int n = 0; n < 2; ++n) acc[a][b][m][n] = (f32x4){0.f, 0.f, 0.f, 0.f};
    bf16x8 At[4][2], B0[2][2], B1[2][2];
    const char* cA = (const char*)g.A + (size_t)cur.pm * tstepA; const char* cB = (const char*)g.Bt + (size_t)cur.pn * tstepB;
    S.a_ready(cur);
    if constexpr (SP2) {
        PG8_STAGE(PG8_SB(0, 0), cB, voffB); PG8_STAGE(PG8_SB(0, 1), cB + hstepB, voffB); PG8_STAGE(PG8_SA(0, 0), cA, voffA); PG8_STAGE(PG8_SA(0, 1), cA + hstepA, voffA);
        if (wr == 1) PG8_BAR;
        PG8_WAIT_V(2); PG8_BAR;
        PG8_STAGE(PG8_SB(1, 0), cB + kstep, voffB); PG8_STAGE(PG8_SA(1, 0), cA + kstep, voffA); PG8_STAGE(PG8_SB(1, 1), cB + hstepB + kstep, voffB);
        PG8_WAIT_V(6); PG8_BAR;
    } else {
        PG8_STAGE(PG8_SB(0, 0), cB, voffB); PG8_STAGE(PG8_SA(0, 0), cA, voffA); PG8_STAGE(PG8_SB(0, 1), cB + hstepB, voffB); PG8_STAGE(PG8_SA(0, 1), cA + hstepA, voffA);
        if (wr == 1) PG8_BAR;
        PG8_WAIT_V(4); PG8_BAR;
        PG8_STAGE(PG8_SB(1, 0), cB + kstep, voffB); PG8_STAGE(PG8_SA(1, 0), cA + kstep, voffA); PG8_STAGE(PG8_SB(1, 1), cB + hstepB + kstep, voffB);
        PG8_WAIT_V(6); PG8_BAR;
    }
    for (;;) {
        const bool has_next = S.next(ui + 1, nxt);
        const char* nA = has_next ? (const char*)g.A + (size_t)nxt.pm * tstepA : cA; const char* nB = has_next ? (const char*)g.Bt + (size_t)nxt.pn * tstepB : cB;
        for (int t = 0; t < nt; t += 2) {
            const bool last = (t == nt - 2);
            const int t1 = t + 1, t2 = t + 2; const char* a1 = cA + (size_t)(t1 >= awrap ? t1 - awrap : t1) * kstep;
            const char* a2 = last ? nA : cA + (size_t)(t2 >= awrap ? t2 - awrap : t2) * kstep; const char* b2 = last ? nB : cB + (size_t)(t + 2) * kstep;
            const char* a3 = a2 + kstep; const char* b3 = b2 + kstep;
            if (last && has_next) S.a_ready(nxt);
            if constexpr (SP2) {
            PG8_LDB(B0, 0, 0); PG8_LDB(B1, 0, 1); PG8_SCHED; PG8_LDA(At, 0, 0); PG8_STAGE(PG8_SA(1, 1), a1 + hstepA, voffA);
            PG8_WAIT_V(8); PG8_WAIT_L(0); PG8_BAR; PG8_MMA(0, 0, At, B0); PG8_MMA(0, 1, At, B1); PG8_BAR; PG8_SCHED;
            PG8_LDA(At, 0, 1); PG8_STAGE(PG8_SB(0, 0), b2, voffB); PG8_STAGE(PG8_SB(0, 1), b2 + hstepB, voffB); PG8_STAGE(PG8_SA(0, 0), a2, voffA);
            PG8_WAIT_V(8); PG8_WAIT_L(0); PG8_BAR; PG8_MMA(1, 0, At, B0); PG8_MMA(1, 1, At, B1); PG8_BAR; PG8_SCHED;
            PG8_LDB(B0, 1, 0); PG8_LDB(B1, 1, 1); PG8_SCHED; PG8_LDA(At, 1, 0); PG8_STAGE(PG8_SA(0, 1), a2 + hstepA, voffA);
            PG8_WAIT_V(8); PG8_WAIT_L(0); PG8_BAR; PG8_MMA(0, 0, At, B0); PG8_MMA(0, 1, At, B1); PG8_BAR; PG8_SCHED;
            PG8_LDA(At, 1, 1); PG8_STAGE(PG8_SB(1, 0), b3, voffB); PG8_STAGE(PG8_SB(1, 1), b3 + hstepB, voffB); PG8_STAGE(PG8_SA(1, 0), a3, voffA);
            PG8_WAIT_V(8); PG8_WAIT_L(0); PG8_BAR; PG8_MMA(1, 0, At, B0); PG8_MMA(1, 1, At, B1); PG8_BAR; PG8_SCHED;
            } else {
            PG8_LDB(B0, 0, 0); PG8_SCHED; PG8_LDA(At, 0, 0); PG8_STAGE(PG8_SA(1, 1), a1 + hstepA, voffA);
            PG8_WAIT_L(8); PG8_BAR; PG8_WAIT_L(0); PG8_MMA(0, 0, At, B0); PG8_BAR; PG8_SCHED;
            PG8_LDB(B1, 0, 1); PG8_STAGE(PG8_SB(0, 0), b2, voffB);
            PG8_BAR; PG8_WAIT_L(0); PG8_MMA(0, 1, At, B1); PG8_BAR;
            PG8_LDA(At, 0, 1); PG8_STAGE(PG8_SA(0, 0), a2, voffA);
            PG8_BAR; PG8_WAIT_L(0); PG8_MMA(1, 0, At, B0); PG8_BAR; PG8_SCHED;
            PG8_STAGE(PG8_SB(0, 1), b2 + hstepB, voffB);
            PG8_WAIT_V(6); PG8_BAR; PG8_MMA(1, 1, At, B1); PG8_BAR;
            PG8_LDB(B0, 1, 0); PG8_SCHED; PG8_LDA(At, 1, 0); PG8_STAGE(PG8_SA(0, 1), a2 + hstepA, voffA);
            PG8_WAIT_L(8); PG8_BAR; PG8_WAIT_L(0); PG8_MMA(0, 0, At, B0); PG8_BAR; PG8_SCHED;
            PG8_LDB(B1, 1, 1); PG8_STAGE(PG8_SB(1, 0), b3, voffB);
            PG8_BAR; PG8_WAIT_L(0); PG8_MMA(0, 1, At, B1); PG8_BAR;
            PG8_LDA(At, 1, 1); PG8_STAGE(PG8_SA(1, 0), a3, voffA);
            PG8_BAR; PG8_WAIT_L(0); PG8_MMA(1, 0, At, B0); PG8_BAR; PG8_SCHED;
            PG8_STAGE(PG8_SB(1, 1), b3 + hstepB, voffB);
            PG8_WAIT_V(6); PG8_BAR; PG8_MMA(1, 1, At, B1); PG8_BAR;
            }
        }
        if constexpr (ALIGN_EPI) { if (wr == 0) PG8_BAR; }
        if constexpr (!Epi::AFTER_DRAIN) { E(acc, cur, wr, wc, fr, fq); S.done(cur); }
        if (!has_next) break;
#pragma unroll
        for (int a = 0; a < 2; ++a)
#pragma unroll
            for (int b = 0; b < 2; ++b)
#pragma unroll
                for (int m = 0; m < 4; ++m)
#pragma unroll
                    for (int n = 0; n < 2; ++n) acc[a][b][m][n] = (f32x4){0.f, 0.f, 0.f, 0.f};
        cur = nxt; cA = nA; cB = nB; ++ui;
        if constexpr (ALIGN_EPI) { if (wr == 1) PG8_BAR; }
    }
    PG8_WAIT_V(0);
    if constexpr (!ALIGN_EPI) { if (wr == 0) PG8_BAR; }
    PG8_BAR;
    if constexpr (Epi::AFTER_DRAIN) { E.fused(acc, cur, wr, wc, fr, fq, lds, wid, lane); S.done(cur); }
#undef PG8_SA
#undef PG8_SB
#undef PG8_STAGE
#undef PG8_LDA
#undef PG8_LDB
#undef PG8_MMA
#undef PG8_WAIT_V
#undef PG8_WAIT_L
#undef PG8_BAR
#undef PG8_SCHED
}
}
constexpr int BATCH = 8, SEQ = 4096, DM = 1024, M = BATCH * SEQ;
constexpr int D_IN = 2644, NMAIN = 2304, NSPLIT = 512, KSPLIT = 3072, DFF = 4096;
constexpr int PM_GQ = 0, PM_GK = 256, PM_GV = 512, PM_GR = 1024, PM_DQ = 1536, PM_DK = 2048, PM_DV = 2176;
constexpr int PS_IQ = 0, PS_IK = 256, PS_IW = 320, PS_GLR = 324;
constexpr float EPS = 1e-6f;
constexpr int NWAVES = 8, NTHR = 512;
constexpr int NUNIT_GLA = BATCH * 4 * 64;
constexpr int TOPK = 256;

constexpr size_t MiB = 1u << 20;
constexpr size_t WS_CTL = 0, CTL_ZERO_BYTES = 1 * MiB;
constexpr int CW_BAR = 4096, CW_SS1 = 65536, CW_SS2 = 98304;
constexpr size_t WS_IW = 1 * MiB, WS_DECAY = 1 * MiB + 512 * 1024;
constexpr size_t WS_WINM = 2 * MiB, WS_WSPL = 7 * MiB, WS_WO = 10 * MiB, WS_W1 = 12 * MiB, WS_W2 = 20 * MiB;
constexpr size_t WS_TAB128 = 28 * MiB, WS_TAB64 = 30 * MiB;
constexpr size_t WS_HCAT = 32 * MiB;
constexpr size_t WS_QR = 32 * MiB, WS_KR = 64 * MiB, WS_IKH = 72 * MiB, WS_IKL = 76 * MiB, WS_IQH = 80 * MiB, WS_IQL = 96 * MiB, WS_MASK = 112 * MiB, WS_SIN = 128 * MiB;
constexpr size_t WS_PMAIN = 160 * MiB, WS_PSPL = 304 * MiB, WS_UT = 368 * MiB, WS_MIX = 432 * MiB;
constexpr size_t WS_ORAW = 160 * MiB, WS_HN = 32 * MiB, WS_HID = 256 * MiB, WS_FFRAW = 96 * MiB;
constexpr size_t WS_END = 512 * MiB;
constexpr int RING_BYTES = 131072, LDS_BYTES = 147456, MISC_OFF = LDS_BYTES - 256;

#define LAS __attribute__((address_space(3)))
typedef unsigned short bf16;
typedef unsigned v4u __attribute__((ext_vector_type(4)));
typedef unsigned v2u __attribute__((ext_vector_type(2)));
typedef float f32x4 __attribute__((ext_vector_type(4)));
typedef float f32x2 __attribute__((ext_vector_type(2)));
typedef short bf16x8 __attribute__((ext_vector_type(8)));
#define LDS_WAIT() asm volatile("s_waitcnt lgkmcnt(0)" ::: "memory")
__device__ __forceinline__ unsigned f2bf(float f) { unsigned u = __float_as_uint(f); return (u + 0x7fffu + ((u >> 16) & 1u)) >> 16; }
__device__ __forceinline__ float bf2f(unsigned h) { return __uint_as_float(h << 16); }
__device__ __forceinline__ unsigned pk2(float lo, float hi) { return f2bf(lo) | (f2bf(hi) << 16); }
__device__ __forceinline__ float wave_sum(float v) {
#pragma unroll
    for (int o = 1; o < 64; o <<= 1) v += __shfl_xor(v, o);
    return v;
}
__device__ __forceinline__ f32x4 mfma16(bf16x8 a, bf16x8 b, f32x4 c) { return __builtin_amdgcn_mfma_f32_16x16x32_bf16(a, b, c, 0, 0, 0); }
#define XB_TMO      128
#define XB_XCNT(j)  (256  + 64 * (j))
#define XB_XSUB(j)  (1280 + 64 * (j))
#define XB_XGEN(j)  (2304 + 64 * (j))
#define XB_TOP      3328
#define XB_TOPGEN   3392
#define XCD_BAR_WORDS 3456
#define XB_SPIN_CAP (1u << 18)

__device__ __forceinline__ unsigned xb_ld(unsigned* p)              { return __hip_atomic_load(p, __ATOMIC_RELAXED, __HIP_MEMORY_SCOPE_AGENT); }
__device__ __forceinline__ unsigned xb_add(unsigned* p, unsigned v) { return __hip_atomic_fetch_add(p, v, __ATOMIC_RELAXED, __HIP_MEMORY_SCOPE_AGENT); }
__device__ __forceinline__ unsigned xb_xcc_id() { return (unsigned)__builtin_amdgcn_s_getreg((3 << 11) | 20) & 0xFu; }
#define XB_SPIN(cond, bar) do { unsigned _sp = 0; while (cond) { __builtin_amdgcn_s_sleep(1); \
    if ((++_sp & 255u) == 0u) { if (xb_ld(&(bar)[XB_TMO])) break; if (_sp > XB_SPIN_CAP) { atomicAdd(&(bar)[XB_TMO], 1u); break; } } } } while (0)

struct XcdBarrier {
    unsigned* bar; unsigned x;
    volatile LAS unsigned* st;
};

__device__ __forceinline__ XcdBarrier xcd_barrier_post(unsigned* bar, volatile LAS unsigned* st) {
    XcdBarrier b; b.bar = bar; b.x = xb_xcc_id(); b.st = st;
    if (threadIdx.x == 0) (void)xb_add(&bar[XB_XCNT(b.x)], 1u);
    return b;
}
__device__ __forceinline__ void xcd_barrier_complete(unsigned* bar, unsigned x, unsigned& nloc, unsigned& nx) {
    const unsigned G = gridDim.x * gridDim.y * gridDim.z;
    unsigned sum, cnt, mine, sp = 0u;
    for (;;) {
        sum = 0u; cnt = 0u; mine = 0u;
#pragma unroll
        for (unsigned j = 0; j < 16; ++j) { const unsigned c = xb_ld(&bar[XB_XCNT(j)]); sum += c; cnt += (c > 0u) ? 1u : 0u; mine = (j == x) ? c : mine; }
        if (sum == G) break;
        __builtin_amdgcn_s_sleep(1);
        if ((++sp & 255u) == 0u) { if (xb_ld(&bar[XB_TMO])) break; if (sp > XB_SPIN_CAP) { atomicAdd(&bar[XB_TMO], 1u); break; } }
    }
    nloc = mine > 0u ? mine : 1u; nx = cnt > 0u ? cnt : 1u;
}

__device__ __forceinline__ void xcd_barrier(const XcdBarrier& b) {
    asm volatile("s_waitcnt vmcnt(0)" ::: "memory");
    __syncthreads();
    if (threadIdx.x == 0) {
        unsigned* bar = b.bar;
        __builtin_amdgcn_s_waitcnt(0);
        unsigned nloc = b.st[0], nx = b.st[1];
        if (nloc == 0u) { xcd_barrier_complete(bar, b.x, nloc, nx); b.st[0] = nloc; b.st[1] = nx; }
        const unsigned old = xb_add(&bar[XB_XSUB(b.x)], 1u);
        const unsigned gen = old / nloc;
        if (old + 1u == (gen + 1u) * nloc) {
            __builtin_amdgcn_fence(__ATOMIC_RELEASE, "agent");
            asm volatile("s_waitcnt vmcnt(0)" ::: "memory");
            const unsigned og = xb_add(&bar[XB_TOP], 1u);
            const unsigned tg = og / nx;
            if (og + 1u == (tg + 1u) * nx) xb_add(&bar[XB_TOPGEN], 1u);
            else XB_SPIN(xb_ld(&bar[XB_TOPGEN]) == tg, bar);
            __builtin_amdgcn_fence(__ATOMIC_ACQUIRE, "agent");
            xb_add(&bar[XB_XGEN(b.x)], 1u);
            asm volatile("s_waitcnt vmcnt(0)" ::: "memory");
        } else {
            XB_SPIN(xb_ld(&bar[XB_XGEN(b.x)]) == gen, bar);
            __builtin_amdgcn_fence(__ATOMIC_ACQUIRE, "agent");
            asm volatile("s_waitcnt vmcnt(0)" ::: "memory");
        }
    }
    __syncthreads();
}

__device__ __forceinline__ int win_src_main(int j) { return j < 1024 ? j : j + 16; }
__device__ __forceinline__ int win_src_split(int j) { return j < 256 ? 2320 + j : (j < 320 ? 2576 + (j - 256) : (j < 324 ? 2640 + (j - 320) : (j < 340 ? 1024 + (j - 324) : -1))); }
template <int MODE>
__device__ __forceinline__ void p0_transpose_item(const float* W, int ldw, bf16* WT, int ldo, float* scr, int item, int nblk, int lane) {
    const int kb = item / nblk, nb = item % nblk, k0 = 64 * kb, n0 = 32 * nb;
    const int n = n0 + (lane & 31);
    const int sc = MODE == 0 ? n : (MODE == 1 ? win_src_main(n) : win_src_split(n));
#pragma unroll 8
    for (int i = 0; i < 32; ++i) { const int kk = 2 * i + (lane >> 5); scr[kk * 33 + (lane & 31)] = sc >= 0 ? W[(size_t)(k0 + kk) * ldw + sc] : 0.f; }
    LDS_WAIT();
    const int c = lane & 7;
#pragma unroll
    for (int j = 0; j < 4; ++j) { const int nn = (lane >> 3) + 8 * j; const float* s = scr + (8 * c) * 33 + nn;
        const float v0 = s[0 * 33], v1 = s[1 * 33], v2 = s[2 * 33], v3 = s[3 * 33], v4 = s[4 * 33], v5 = s[5 * 33], v6 = s[6 * 33], v7 = s[7 * 33];
        v4u o; o.x = pk2(v0, v1); o.y = pk2(v2, v3); o.z = pk2(v4, v5); o.w = pk2(v6, v7);
        bf16* dst = WT + (size_t)(n0 + nn) * ldo + k0 + 8 * c;
        *(v4u*)dst = o;
        if (MODE == 2) { *(v4u*)(dst + 1024) = o;
            v4u l; l.x = pk2(v0 - bf2f(o.x & 0xffffu), v1 - bf2f(o.x >> 16)); l.y = pk2(v2 - bf2f(o.y & 0xffffu), v3 - bf2f(o.y >> 16));
            l.z = pk2(v4 - bf2f(o.z & 0xffffu), v5 - bf2f(o.z >> 16)); l.w = pk2(v6 - bf2f(o.w & 0xffffu), v7 - bf2f(o.w >> 16));
            *(v4u*)(dst + 2048) = l; } }
    LDS_WAIT();
}
__device__ __forceinline__ void p0_rms_row(const float* xrow, const float* w, bf16* orow, int lane) {
    const f32x4* xr = (const f32x4*)xrow + lane; const f32x4* wr = (const f32x4*)w + lane;
    f32x4 v[4]; float s = 0.f;
#pragma unroll
    for (int j = 0; j < 4; ++j) { v[j] = xr[64 * j]; s += (v[j].x * v[j].x + v[j].y * v[j].y) + (v[j].z * v[j].z + v[j].w * v[j].w); }
    const float r = 1.0f / sqrtf(wave_sum(s) * (1.f / DM) + EPS);
    unsigned long long* oh = (unsigned long long*)orow + lane; unsigned long long* ol = (unsigned long long*)(orow + 1024) + lane;
#pragma unroll
    for (int j = 0; j < 4; ++j) { const f32x4 y = (v[j] * r) * wr[64 * j];
        const unsigned h0 = pk2(y.x, y.y), h1 = pk2(y.z, y.w);
        const unsigned l0 = pk2(y.x - bf2f(h0 & 0xffffu), y.y - bf2f(h0 >> 16)), l1 = pk2(y.z - bf2f(h1 & 0xffffu), y.w - bf2f(h1 >> 16));
        oh[64 * j] = (unsigned long long)h0 | ((unsigned long long)h1 << 32); ol[64 * j] = (unsigned long long)l0 | ((unsigned long long)l1 << 32); }
}
__device__ __forceinline__ void sincos_f64(double a, double& sn, double& cs) {
    const double kd = rint(a * 0.63661977236758134308);
    const double r = (a - kd * 1.57079632673412561417e+00) - kd * 6.07710050650619224932e-11;
    const double z = r * r;
    const double ps = 8.33333333332248946124e-03 + z * (-1.98412698298579493134e-04 + z * (2.75573137070700676789e-06 + z * (-2.50507602534068634195e-08 + z * 1.58969099521155010221e-10)));
    const double s = r + (z * r) * (-1.66666666666666324348e-01 + z * ps);
    const double pc = z * (4.16666666666666019037e-02 + z * (-1.38888888888741095749e-03 + z * (2.48015872894767294178e-05 + z * (-2.75573143513906633035e-07 + z * (2.08757232129817482790e-09 + z * -1.13596475577881948265e-11)))));
    const double c = 1.0 - (0.5 * z - z * pc);
    const int q = ((int)kd) & 3;
    sn = (q == 0) ? s : (q == 1) ? c : (q == 2) ? -s : -c;
    cs = (q == 0) ? c : (q == 1) ? -s : (q == 2) ? -c : s;
}
struct P0Args { const float *x, *nw, *w_in, *w_out, *w1, *w2; bf16 *hcat, *winm, *wspl, *wo, *w1t, *w2t; f32x2 *tab128, *tab64; };
__device__ __forceinline__ void p0_prologue(const P0Args& a, char* ldsg, int bid, int G, int tid) {
    const int lane = tid & 63, wave = tid >> 6;
    float* scr = (float*)(ldsg + wave * 16384);
    const int gw = bid * NWAVES + wave, NGW = G * NWAVES;
    constexpr int I_M = 16 * (NMAIN / 32), I_S = 16 * (NSPLIT / 32), I_O = 16 * (DM / 32), I_1 = 16 * (DFF / 32), I_2 = 64 * (DM / 32);
    for (int it = gw; it < I_M + I_S + I_O + I_1 + I_2; it += NGW) {
        int r = it;
        if (r < I_M) { p0_transpose_item<1>(a.w_in, D_IN, a.winm, 1024, scr, r, NMAIN / 32, lane); continue; } r -= I_M;
        if (r < I_S) { p0_transpose_item<2>(a.w_in, D_IN, a.wspl, KSPLIT, scr, r, NSPLIT / 32, lane); continue; } r -= I_S;
        if (r < I_O) { p0_transpose_item<0>(a.w_out, DM, a.wo, 1024, scr, r, DM / 32, lane); continue; } r -= I_O;
        if (r < I_1) { p0_transpose_item<0>(a.w1, DFF, a.w1t, 1024, scr, r, DFF / 32, lane); continue; } r -= I_1;
        p0_transpose_item<0>(a.w2, DM, a.w2t, DFF, scr, r, DM / 32, lane);
    }
    for (int m = gw; m < M; m += NGW) p0_rms_row(a.x + (size_t)m * DM, a.nw, a.hcat + (size_t)m * 2048, lane);
    for (int e = bid * NTHR + tid; e < SEQ * 96; e += G * NTHR) {
        const int s = e / 96, j = e % 96; const bool big = j < 64; const int i = big ? j : j - 64;
        const double base = big ? 0.8659643233600653 : 0.7498942093324558;
        double p = 1.0; for (int k = 0; k < i; ++k) p *= base;
        const double ang = (double)s * (double)(float)p; double sn, cs; sincos_f64(ang, sn, cs);
        const f32x2 o = {(float)cs, (float)sn};
        if (big) a.tab128[s * 64 + i] = o; else a.tab64[s * 32 + i] = o;
    }
}

struct P2Args { const bf16* pmain; const float* pspl; const f32x2 *tab128, *tab64; const float *lnw, *lnb; bf16 *qr, *kr, *ikh, *ikl, *iqh, *iql; float* iw; };
__device__ __forceinline__ void p2_post_row(const P2Args& a, int m, int lane) {
    const int s = m & (SEQ - 1);
    const bf16* pm = a.pmain + (size_t)m * NMAIN; const float* ps = a.pspl + (size_t)m * NSPLIT;
    const f32x2 cs = a.tab128[s * 64 + lane];
    { const float x1 = bf2f(pm[PM_DK + lane]), x2 = bf2f(pm[PM_DK + 64 + lane]);
      a.kr[(size_t)m * 128 + lane] = (bf16)f2bf(x1 * cs.x - x2 * cs.y); a.kr[(size_t)m * 128 + 64 + lane] = (bf16)f2bf(x2 * cs.x + x1 * cs.y); }
#pragma unroll
    for (int h = 0; h < 4; ++h) { const float x1 = bf2f(pm[PM_DQ + h * 128 + lane]), x2 = bf2f(pm[PM_DQ + h * 128 + 64 + lane]);
      a.qr[(size_t)m * 512 + h * 128 + lane] = (bf16)f2bf(x1 * cs.x - x2 * cs.y); a.qr[(size_t)m * 512 + h * 128 + 64 + lane] = (bf16)f2bf(x2 * cs.x + x1 * cs.y); }
    const f32x2 c2 = a.tab64[s * 32 + (lane & 31)];
#pragma unroll
    for (int e = 0; e < 2; ++e) { const int h = 2 * e + (lane >> 5), i = lane & 31;
      const float x1 = ps[PS_IQ + h * 64 + i], x2 = ps[PS_IQ + h * 64 + 32 + i];
      const float o1 = x1 * c2.x - x2 * c2.y, o2 = x2 * c2.x + x1 * c2.y;
      const unsigned h1 = f2bf(o1), h2 = f2bf(o2); const size_t p = ((size_t)m * 4 + h) * 64 + i;
      a.iqh[p] = (bf16)h1; a.iqh[p + 32] = (bf16)h2; a.iql[p] = (bf16)f2bf(o1 - bf2f(h1)); a.iql[p + 32] = (bf16)f2bf(o2 - bf2f(h2)); }
    { const float v = ps[PS_IK + lane]; const float mu = wave_sum(v) * (1.f / 64.f); const float d = v - mu; const float var = wave_sum(d * d) * (1.f / 64.f);
      const float y = d * (1.0f / sqrtf(var + EPS)) * a.lnw[lane] + a.lnb[lane];
      const float other = __shfl_xor(y, 32);
      const float o = lane < 32 ? (y * c2.x - other * c2.y) : (y * c2.x + other * c2.y);
      const unsigned hh = f2bf(o); a.ikh[(size_t)m * 64 + lane] = (bf16)hh; a.ikl[(size_t)m * 64 + lane] = (bf16)f2bf(o - bf2f(hh)); }
    if (lane < 4) a.iw[(size_t)m * 4 + lane] = ps[PS_IW + lane] * 0.0625f;
}

__device__ __forceinline__ void gla_bcum(const float* pspl, const float* gw2, const float* gb, int m0, int h, float* Gs, float* glr, float* w2s, int tid) {
    for (int i = tid; i < 1024; i += NTHR) { const int t = i >> 4, j = i & 15; glr[i] = pspl[(size_t)(m0 + t) * NSPLIT + PS_GLR + j]; }
    for (int i = tid; i < 1024; i += NTHR) { const int j = i >> 6, d = i & 63; w2s[i] = gw2[j * 256 + h * 64 + d]; }
    __syncthreads();
    for (int i = tid; i < 4096; i += NTHR) { const int t = i >> 6, d = i & 63; float z = 0.f;
#pragma unroll
        for (int j = 0; j < 16; ++j) z += glr[t * 16 + j] * w2s[j * 64 + d];
        z += gb[h * 64 + d];
        Gs[i] = (fminf(z, 0.f) - log1pf(expf(-fabsf(z)))) * (1.f / 16.f); }
    __syncthreads();
    if (tid < 64) { float acc = 0.f; for (int t = 0; t < 64; ++t) { acc += Gs[t * 64 + tid]; Gs[t * 64 + tid] = acc; } }
    __syncthreads();
}
constexpr int GLA_LD = 72;
struct GlaArgs { const bf16* pmain; const float* pspl; const float *gw2, *gb, *gnw; float* ut; float* decay; bf16* sin_; bf16* mix; };
__device__ __forceinline__ void gla_local_unit(const GlaArgs& a, int u, char* ldsg, int tid) {
    const int lane = tid & 63, w = tid >> 6, quad = lane >> 4, l15 = lane & 15;
    const int b = u >> 8, h = (u >> 6) & 3, n = u & 63, m0 = b * SEQ + n * 64;
    float* Gs = (float*)ldsg; float* glr = Gs + 4096; float* w2s = glr + 1024; bf16* kT = (bf16*)(w2s + 1024); bf16* vT = kT + 64 * GLA_LD;
    __syncthreads();
    gla_bcum(a.pspl, a.gw2, a.gb, m0, h, Gs, glr, w2s, tid);
    for (int i = tid; i < 4096; i += NTHR) { const int t = i >> 6, d = i & 63; const float kv = bf2f(a.pmain[(size_t)(m0 + t) * NMAIN + PM_GK + h * 64 + d]);
        kT[d * GLA_LD + t] = (bf16)f2bf(kv * expf(Gs[63 * 64 + d] - Gs[i])); }
    for (int i = tid; i < 8192; i += NTHR) { const int t = i >> 7, v = i & 127; vT[v * GLA_LD + t] = a.pmain[(size_t)(m0 + t) * NMAIN + PM_GV + h * 128 + v]; }
    if (tid < 64) a.decay[(size_t)u * 64 + tid] = expf(Gs[63 * 64 + tid]);
    __syncthreads();
    f32x4 acc[4];
#pragma unroll
    for (int dt = 0; dt < 4; ++dt) acc[dt] = (f32x4){0.f, 0.f, 0.f, 0.f};
#pragma unroll
    for (int ks = 0; ks < 2; ++ks) { const bf16x8 af = *(const bf16x8*)(vT + (16 * w + l15) * GLA_LD + ks * 32 + 8 * quad);
#pragma unroll
        for (int dt = 0; dt < 4; ++dt) { const bf16x8 bfr = *(const bf16x8*)(kT + (16 * dt + l15) * GLA_LD + ks * 32 + 8 * quad); acc[dt] = mfma16(af, bfr, acc[dt]); } }
    float* uo = a.ut + (size_t)u * 8192;
#pragma unroll
    for (int dt = 0; dt < 4; ++dt)
#pragma unroll
        for (int r = 0; r < 4; ++r) uo[(16 * w + 4 * quad + r) * 64 + 16 * dt + l15] = acc[dt][r];
}
__device__ __forceinline__ void gla_scan(const GlaArgs& a, int bid, int G, int tid) {
    for (int idx = bid * NTHR + tid; idx < 32 * 8192; idx += G * NTHR) {
        const int bh = idx >> 13, e = idx & 8191, d = e & 63; float st = 0.f;
        for (int n = 0; n < 64; ++n) { const size_t u = (size_t)bh * 64 + n; const float uv = a.ut[u * 8192 + e], dc = a.decay[u * 64 + d];
            a.sin_[u * 8192 + e] = (bf16)f2bf(st); st = dc * st + uv; }
    }
}
__device__ __forceinline__ void gla_out_unit(const GlaArgs& a, int u, char* ldsg, int tid) {
    const int lane = tid & 63, w = tid >> 6, quad = lane >> 4, l15 = lane & 15;
    const int b = u >> 8, h = (u >> 6) & 3, n = u & 63, m0 = b * SEQ + n * 64;
    float* Gs = (float*)ldsg; float* glr = Gs + 4096; float* w2s = glr + 1024; bf16* Qd = (bf16*)(w2s + 1024); bf16* Ki = Qd + 64 * GLA_LD; bf16* vT = Ki + 64 * GLA_LD; bf16* At = vT + 128 * GLA_LD;
    float* part = (float*)(At + 64 * GLA_LD);
    __syncthreads();
    gla_bcum(a.pspl, a.gw2, a.gb, m0, h, Gs, glr, w2s, tid);
    for (int i = tid; i < 4096; i += NTHR) { const int t = i >> 6, d = i & 63; const bf16* row = a.pmain + (size_t)(m0 + t) * NMAIN + h * 64 + d;
        const float g = Gs[i]; Qd[t * GLA_LD + d] = (bf16)f2bf(bf2f(row[PM_GQ]) * 0.125f * expf(g)); Ki[t * GLA_LD + d] = (bf16)f2bf(bf2f(row[PM_GK]) * expf(-g)); }
    for (int i = tid; i < 8192; i += NTHR) { const int t = i >> 7, v = i & 127; vT[v * GLA_LD + t] = a.pmain[(size_t)(m0 + t) * NMAIN + PM_GV + h * 128 + v]; }
    __syncthreads();
    const int rt = w & 3, ch = w >> 2;
    {
        f32x4 s2[2] = {(f32x4){0.f, 0.f, 0.f, 0.f}, (f32x4){0.f, 0.f, 0.f, 0.f}};
#pragma unroll
        for (int ks = 0; ks < 2; ++ks) { const bf16x8 af = *(const bf16x8*)(Qd + (16 * rt + l15) * GLA_LD + ks * 32 + 8 * quad);
#pragma unroll
            for (int j2 = 0; j2 < 2; ++j2) { const bf16x8 bfr = *(const bf16x8*)(Ki + (16 * (2 * ch + j2) + l15) * GLA_LD + ks * 32 + 8 * quad); s2[j2] = mfma16(af, bfr, s2[j2]); } }
#pragma unroll
        for (int j2 = 0; j2 < 2; ++j2)
#pragma unroll
            for (int r = 0; r < 4; ++r) { const int i = 16 * rt + 4 * quad + r, j = 16 * (2 * ch + j2) + l15; At[i * GLA_LD + j] = (bf16)f2bf(j <= i ? s2[j2][r] : 0.f); }
    }
    __syncthreads();
    f32x4 o[4];
#pragma unroll
    for (int vt = 0; vt < 4; ++vt) o[vt] = (f32x4){0.f, 0.f, 0.f, 0.f};
    const bf16* Sg = a.sin_ + (size_t)u * 8192;
#pragma unroll
    for (int ks = 0; ks < 2; ++ks) {
        const bf16x8 a1 = *(const bf16x8*)(At + (16 * rt + l15) * GLA_LD + ks * 32 + 8 * quad);
        const bf16x8 a2 = *(const bf16x8*)(Qd + (16 * rt + l15) * GLA_LD + ks * 32 + 8 * quad);
#pragma unroll
        for (int vt = 0; vt < 4; ++vt) { const int vrow = 16 * (4 * ch + vt) + l15;
            const bf16x8 b1 = *(const bf16x8*)(vT + vrow * GLA_LD + ks * 32 + 8 * quad);
            const bf16x8 b2 = *(const bf16x8*)(Sg + vrow * 64 + ks * 32 + 8 * quad);
            o[vt] = mfma16(a1, b1, o[vt]); o[vt] = mfma16(a2, b2, o[vt]); } }
#pragma unroll
    for (int r = 0; r < 4; ++r) { float s = 0.f;
#pragma unroll
        for (int vt = 0; vt < 4; ++vt) s += o[vt][r] * o[vt][r];
        s += __shfl_xor(s, 1); s += __shfl_xor(s, 2); s += __shfl_xor(s, 4); s += __shfl_xor(s, 8);
        if (l15 == 0) part[ch * 64 + 16 * rt + 4 * quad + r] = s; }
    __syncthreads();
#pragma unroll
    for (int r = 0; r < 4; ++r) { const int i = 16 * rt + 4 * quad + r; const float rstd = 1.0f / sqrtf((part[i] + part[64 + i]) * (1.f / 128.f) + EPS);
#pragma unroll
        for (int vt = 0; vt < 4; ++vt) { const int v = 16 * (4 * ch + vt) + l15;
            const float rg = bf2f(a.pmain[(size_t)(m0 + i) * NMAIN + PM_GR + h * 128 + v]);
            const float y = o[vt][r] * rstd * a.gnw[v] * (rg / (1.f + expf(-rg)));
            a.mix[(size_t)(m0 + i) * 1024 + h * 128 + v] = (bf16)f2bf(y); } }
}

__device__ __forceinline__ void p6_row(const float* xrow, const bf16* raw, float ss, const float* wpost, const float* wpre, float* orow, bf16* hn, int lane) {
    const float r1 = 1.0f / sqrtf(ss * (1.f / DM) + EPS);
    f32x4 v[4]; float s = 0.f;
#pragma unroll
    for (int j = 0; j < 4; ++j) { const f32x4 xv = ((const f32x4*)xrow)[lane + 64 * j]; const f32x4 wv = ((const f32x4*)wpost)[lane + 64 * j];
        const v2u rw = ((const v2u*)raw)[lane + 64 * j];
        const f32x4 ov = {bf2f(rw.x & 0xffffu), bf2f(rw.x >> 16), bf2f(rw.y & 0xffffu), bf2f(rw.y >> 16)};
        v[j] = xv + (ov * r1) * wv; ((f32x4*)orow)[lane + 64 * j] = v[j];
        s += (v[j].x * v[j].x + v[j].y * v[j].y) + (v[j].z * v[j].z + v[j].w * v[j].w); }
    const float r2 = 1.0f / sqrtf(wave_sum(s) * (1.f / DM) + EPS);
#pragma unroll
    for (int j = 0; j < 4; ++j) { const f32x4 wv = ((const f32x4*)wpre)[lane + 64 * j]; const f32x4 y = (v[j] * r2) * wv;
        v2u o; o.x = pk2(y.x, y.y); o.y = pk2(y.z, y.w); ((v2u*)hn)[lane + 64 * j] = o; }
}
__device__ __forceinline__ void p9_row(float* orow, const bf16* raw, float ss, const float* wpost, int lane) {
    const float r1 = 1.0f / sqrtf(ss * (1.f / DM) + EPS);
#pragma unroll
    for (int j = 0; j < 4; ++j) { const f32x4 xv = ((const f32x4*)orow)[lane + 64 * j]; const f32x4 wv = ((const f32x4*)wpost)[lane + 64 * j];
        const v2u rw = ((const v2u*)raw)[lane + 64 * j];
        const f32x4 ov = {bf2f(rw.x & 0xffffu), bf2f(rw.x >> 16), bf2f(rw.y & 0xffffu), bf2f(rw.y >> 16)};
        ((f32x4*)orow)[lane + 64 * j] = xv + (ov * r1) * wv; }
}
__device__ __forceinline__ unsigned okey_of(float s) { const unsigned u = __float_as_uint(s); return (u & 0x80000000u) ? ~u : (u | 0x80000000u); }
__device__ __forceinline__ void cnt_ge(unsigned& n, unsigned k, unsigned c) { asm volatile("v_cmp_ge_u32 vcc, %1, %2\n\tv_addc_co_u32 %0, vcc, 0, %0, vcc" : "+v"(n) : "v"(k), "v"(c) : "vcc"); }
__device__ __forceinline__ void cnt_gt(unsigned& n, unsigned k, unsigned c) { asm volatile("v_cmp_gt_u32 vcc, %1, %2\n\tv_addc_co_u32 %0, vcc, 0, %0, vcc" : "+v"(n) : "v"(k), "v"(c) : "vcc"); }
__device__ __forceinline__ void cnt_tie(unsigned& n, unsigned k, unsigned T, unsigned lo, unsigned c) { unsigned tmp;
    asm volatile("v_cmp_eq_u32 vcc, %2, %3\n\tv_cndmask_b32 %1, 0, %4, vcc\n\tv_cmp_ge_u32 vcc, %1, %5\n\tv_addc_co_u32 %0, vcc, 0, %0, vcc" : "+v"(n), "=&v"(tmp) : "v"(k), "v"(T), "v"(lo), "v"(c) : "vcc"); }
struct IdxArgs { const bf16 *iqh, *iql, *ikh, *ikl; const float* iw; unsigned short* mask16; };
constexpr int IDX_ROUNDS = 45;
__device__ __forceinline__ void indexer_unit(const IdxArgs& a, int b, int c, int g, unsigned* cnt  , int tid) {
    const int lane = tid & 63, w = __builtin_amdgcn_readfirstlane(tid >> 6), quad = lane >> 4, l15 = lane & 15;
    const int q0 = b * SEQ + c * 64 + g * 8, ntile = 4 * (c + 1), nloc = (ntile - w + 7) >> 3;
    __syncthreads();
    for (int i = tid; i < IDX_ROUNDS * 8; i += NTHR) cnt[i] = 0u;
    bf16x8 aqh[2][2], aql[2][2]; f32x4 wq[2];
#pragma unroll
    for (int rt = 0; rt < 2; ++rt) {
#pragma unroll
        for (int ks = 0; ks < 2; ++ks) { const size_t p = ((size_t)(q0 + rt * 4 + (l15 >> 2)) * 4 + (l15 & 3)) * 64 + ks * 32 + 8 * quad;
            aqh[rt][ks] = *(const bf16x8*)(a.iqh + p); aql[rt][ks] = *(const bf16x8*)(a.iql + p); }
        wq[rt] = *(const f32x4*)(a.iw + (size_t)(q0 + rt * 4 + quad) * 4); }
    unsigned key[32][2];
#pragma unroll
    for (int i = 0; i < 32; ++i) {
        const int t = w + 8 * i;
        if (i < nloc) {
            const size_t kp = (size_t)(b * SEQ + 16 * t + l15) * 64 + 8 * quad;
            const bf16x8 bh0 = *(const bf16x8*)(a.ikh + kp), bh1 = *(const bf16x8*)(a.ikh + kp + 32), bl0 = *(const bf16x8*)(a.ikl + kp), bl1 = *(const bf16x8*)(a.ikl + kp + 32);
#pragma unroll
            for (int rt = 0; rt < 2; ++rt) { f32x4 acc = {0.f, 0.f, 0.f, 0.f};
                acc = mfma16(aqh[rt][0], bh0, acc); acc = mfma16(aqh[rt][1], bh1, acc);
                acc = mfma16(aqh[rt][0], bl0, acc); acc = mfma16(aqh[rt][1], bl1, acc);
                acc = mfma16(aql[rt][0], bh0, acc); acc = mfma16(aql[rt][1], bh1, acc);
                const float s = ((wq[rt][0] * fmaxf(acc[0], 0.f) + wq[rt][1] * fmaxf(acc[1], 0.f)) + wq[rt][2] * fmaxf(acc[2], 0.f)) + wq[rt][3] * fmaxf(acc[3], 0.f);
                key[i][rt] = okey_of(s); }
        } else { key[i][0] = 0u; key[i][1] = 0u; }
    }
    __syncthreads();
    unsigned T0 = 0u, T1 = 0u;
    for (int rd = 0; rd < 32; ++rd) {
        const unsigned c0v = T0 | (0x80000000u >> rd), c1v = T1 | (0x80000000u >> rd); unsigned n0 = 0u, n1 = 0u;
#pragma unroll
        for (int i = 0; i < 32; ++i) { cnt_ge(n0, key[i][0], c0v); cnt_ge(n1, key[i][1], c1v); }
#pragma unroll
        for (int o = 1; o < 16; o <<= 1) { n0 += __shfl_xor(n0, o); n1 += __shfl_xor(n1, o); }
        if (l15 == 0) { atomicAdd(&cnt[rd * 8 + quad], n0); atomicAdd(&cnt[rd * 8 + 4 + quad], n1); }
        __syncthreads();
        if (cnt[rd * 8 + quad] >= (unsigned)TOPK) T0 = c0v;
        if (cnt[rd * 8 + 4 + quad] >= (unsigned)TOPK) T1 = c1v;
    }
    { unsigned n0 = 0u, n1 = 0u;
#pragma unroll
      for (int i = 0; i < 32; ++i) { cnt_gt(n0, key[i][0], T0); cnt_gt(n1, key[i][1], T1); }
#pragma unroll
      for (int o = 1; o < 16; o <<= 1) { n0 += __shfl_xor(n0, o); n1 += __shfl_xor(n1, o); }
      if (l15 == 0) { atomicAdd(&cnt[32 * 8 + quad], n0); atomicAdd(&cnt[32 * 8 + 4 + quad], n1); }
      __syncthreads(); }
    const unsigned need0 = (unsigned)TOPK - cnt[32 * 8 + quad], need1 = (unsigned)TOPK - cnt[32 * 8 + 4 + quad];
    const unsigned lo_base = 4095u - (unsigned)(16 * w + l15);
    unsigned L0 = 0u, L1 = 0u;
    for (int rd = 0; rd < 12; ++rd) {
        const unsigned c0v = L0 | (0x800u >> rd), c1v = L1 | (0x800u >> rd); unsigned n0 = 0u, n1 = 0u;
#pragma unroll
        for (int i = 0; i < 32; ++i) { const unsigned lo = lo_base - 128u * (unsigned)i; cnt_tie(n0, key[i][0], T0, lo, c0v); cnt_tie(n1, key[i][1], T1, lo, c1v); }
#pragma unroll
        for (int o = 1; o < 16; o <<= 1) { n0 += __shfl_xor(n0, o); n1 += __shfl_xor(n1, o); }
        if (l15 == 0) { atomicAdd(&cnt[(33 + rd) * 8 + quad], n0); atomicAdd(&cnt[(33 + rd) * 8 + 4 + quad], n1); }
        __syncthreads();
        if (cnt[(33 + rd) * 8 + quad] >= need0) L0 = c0v;
        if (cnt[(33 + rd) * 8 + 4 + quad] >= need1) L1 = c1v;
    }
#pragma unroll
    for (int i = 0; i < 32; ++i) {
        const int t = w + 8 * i;
        if (i < nloc) { const unsigned lo = lo_base - 128u * (unsigned)i;
#pragma unroll
            for (int rt = 0; rt < 2; ++rt) { const unsigned k = key[i][rt], T = rt ? T1 : T0, L = rt ? L1 : L0;
                const bool sel = (k > T) || (k == T && lo >= L);
                const unsigned long long bal = __ballot(sel);
                if (lane < 4) a.mask16[(size_t)(q0 + rt * 4 + lane) * 256 + t] = (unsigned short)((bal >> (16 * lane)) & 0xffffull); } }
        __builtin_amdgcn_sched_barrier(0);
    }
}

namespace att {
using s16x4  = __attribute__((ext_vector_type(4))) short;
using f32x16 = __attribute__((ext_vector_type(16))) float;
using u32x4  = __attribute__((ext_vector_type(4))) unsigned;
constexpr int D = 128, NW = 8, QBLK = 32, KVBLK = 64;
constexpr float SCALE = 0.088388347648318440f, THR = 8.f;
constexpr int SHM_V = KVBLK * D * 2, SHM_K = KVBLK * D * 2, SHM_Q0 = 2 * SHM_V + 2 * SHM_K + NW * 64 * 4, SHM_ATTN = SHM_Q0 + 256 * D * 2;
constexpr int LDK = 128, LDV = NMAIN;
#define KSWZ(row, colB) ((row) * 256 + ((colB) ^ (((row) & 7) << 4)))
#define SBAR() __builtin_amdgcn_sched_barrier(0)
__device__ __forceinline__ int crow(int r, int hi) { return (r & 3) + 8 * (r >> 2) + 4 * hi; }
__device__ __forceinline__ unsigned cvtpk(float lo, float hi) { unsigned r; asm volatile("v_cvt_pk_bf16_f32 %0, %1, %2" : "=v"(r) : "v"(lo), "v"(hi)); return r; }
__device__ __forceinline__ void partialSM(f32x16& p0, f32x16& p1, float& m_reg, float& mn, float& alpha, unsigned ml) {
  constexpr float C = SCALE * 1.4426950408889634f;
  float pmax = p0[0];
#pragma unroll
  for (int r = 1; r < 16; ++r) pmax = fmaxf(pmax, p0[r]);
#pragma unroll
  for (int r = 0; r < 16; ++r) pmax = fmaxf(pmax, p1[r]);
  { auto rr = __builtin_amdgcn_permlane32_swap(__float_as_uint(pmax), __float_as_uint(pmax), false, false);
    pmax = fmaxf(__uint_as_float(rr[0]), __uint_as_float(rr[1])); }
  if (__builtin_expect(__all(pmax - m_reg <= THR / SCALE), 1)) { mn = m_reg; alpha = 1.f; }
  else { mn = fmaxf(m_reg, pmax); alpha = __builtin_amdgcn_exp2f((m_reg - mn) * C); m_reg = mn; }
  const float mnC = -mn * C;
#pragma unroll
  for (int r = 0; r < 16; ++r) p0[r] = fmaf(p0[r], C, mnC);
#pragma unroll
  for (int r = 0; r < 16; ++r) p1[r] = fmaf(p1[r], C, mnC);
#pragma unroll
  for (int r = 0; r < 16; ++r) { const float e = __builtin_amdgcn_exp2f(p0[r]); const int t = __builtin_amdgcn_sbfe((int)ml, (r & 3) + 8 * (r >> 2), 1); p0[r] = __uint_as_float(__float_as_uint(e) & (unsigned)t); }
}
__device__ __forceinline__ void finishSM(f32x16& p0, f32x16& p1, float alpha, float& l_reg, bf16x8& pa0, bf16x8& pa1, bf16x8& pa2, bf16x8& pa3, unsigned mh) {
#pragma unroll
  for (int r = 0; r < 16; ++r) { const float e = __builtin_amdgcn_exp2f(p1[r]); const int t = __builtin_amdgcn_sbfe((int)mh, (r & 3) + 8 * (r >> 2), 1); p1[r] = __uint_as_float(__float_as_uint(e) & (unsigned)t); }
  float ps = 0;
#pragma unroll
  for (int r = 0; r < 16; ++r) ps += p0[r];
#pragma unroll
  for (int r = 0; r < 16; ++r) ps += p1[r];
  { auto rr = __builtin_amdgcn_permlane32_swap(__float_as_uint(ps), __float_as_uint(ps), false, false);
    ps = __uint_as_float(rr[0]) + __uint_as_float(rr[1]); }
  l_reg = l_reg * alpha + ps;
#define PK4(P, BASE, OUT) do { unsigned a0 = cvtpk(P[BASE + 0], P[BASE + 1]), a1 = cvtpk(P[BASE + 2], P[BASE + 3]);   \
    unsigned b0 = cvtpk(P[BASE + 4], P[BASE + 5]), b1 = cvtpk(P[BASE + 6], P[BASE + 7]);                              \
    auto r0 = __builtin_amdgcn_permlane32_swap(a0, b0, false, false); auto r1 = __builtin_amdgcn_permlane32_swap(a1, b1, false, false); \
    u32x4 w = {r0[0], r1[0], r0[1], r1[1]}; OUT = *reinterpret_cast<bf16x8*>(&w); } while (0)
  PK4(p0, 0, pa0); PK4(p0, 8, pa1); PK4(p1, 0, pa2); PK4(p1, 8, pa3);
#undef PK4
}
__device__ __forceinline__ void qkt(f32x16& p0, f32x16& p1, const bf16* Ks, const char* Qs, int r32, int hi) {
  p0 = f32x16{}; p1 = f32x16{};
#pragma unroll
  for (int d0 = 0; d0 < 8; ++d0) { int cb = (d0 * 16 + hi * 8) * 2;
    bf16x8 b0 = *reinterpret_cast<const bf16x8*>((const char*)Ks + KSWZ(r32, cb));
    bf16x8 b1 = *reinterpret_cast<const bf16x8*>((const char*)Ks + KSWZ(32 + r32, cb));
    bf16x8 q = *reinterpret_cast<const bf16x8*>(Qs + KSWZ(r32, cb));
    p0 = __builtin_amdgcn_mfma_f32_32x32x16_bf16(b0, q, p0, 0, 0, 0);
    p1 = __builtin_amdgcn_mfma_f32_32x32x16_bf16(b1, q, p1, 0, 0, 0); }
}
__device__ __forceinline__ int v_st(int k, int c) { const int kk = (k & ~0xC) | ((k & 4) << 1) | ((k & 8) >> 1); return ((kk >> 3) * 4 + (c >> 5)) * 512 + ((kk & 7) * 32 + (c & 31)) * 2; }
__device__ __forceinline__ int v_rd_base(int lane) { return ((lane & 3) << 3) | (((lane >> 2) & 3) << 6) | (((lane >> 4) & 1) << 5) | (((lane >> 5) & 1) << 8); }
constexpr int v_rd_off(int d0, int ks, int half) { return d0 * 512 + ks * 4096 + half * 2048; }
template <int OFF> __device__ __forceinline__ s16x4 tr_read(int vb) {
  s16x4 r; asm volatile("ds_read_b64_tr_b16 %0, %1 offset:%2" : "=&v"(r) : "v"(vb), "i"(OFF) : "memory"); return r;
}
template <int D0> __device__ __forceinline__ void pv_one(f32x16& od, int vb, bf16x8 pa0, bf16x8 pa1, bf16x8 pa2, bf16x8 pa3) {
  const s16x4 l0 = tr_read<v_rd_off(D0, 0, 0)>(vb), h0 = tr_read<v_rd_off(D0, 0, 1)>(vb), l1 = tr_read<v_rd_off(D0, 1, 0)>(vb), h1 = tr_read<v_rd_off(D0, 1, 1)>(vb);
  const s16x4 l2 = tr_read<v_rd_off(D0, 2, 0)>(vb), h2 = tr_read<v_rd_off(D0, 2, 1)>(vb), l3 = tr_read<v_rd_off(D0, 3, 0)>(vb), h3 = tr_read<v_rd_off(D0, 3, 1)>(vb);
  asm volatile("s_waitcnt lgkmcnt(0)" ::: "memory"); SBAR();
#define PK(L, H) (bf16x8){L[0], L[1], L[2], L[3], H[0], H[1], H[2], H[3]}
  od = __builtin_amdgcn_mfma_f32_32x32x16_bf16(pa0, PK(l0, h0), od, 0, 0, 0);
  od = __builtin_amdgcn_mfma_f32_32x32x16_bf16(pa1, PK(l1, h1), od, 0, 0, 0);
  od = __builtin_amdgcn_mfma_f32_32x32x16_bf16(pa2, PK(l2, h2), od, 0, 0, 0);
  od = __builtin_amdgcn_mfma_f32_32x32x16_bf16(pa3, PK(l3, h3), od, 0, 0, 0);
#undef PK
}
__device__ __forceinline__ void pv_d0(f32x16* o, int vb, bf16x8 pa0, bf16x8 pa1, bf16x8 pa2, bf16x8 pa3) {
  pv_one<0>(o[0], vb, pa0, pa1, pa2, pa3); pv_one<1>(o[1], vb, pa0, pa1, pa2, pa3); pv_one<2>(o[2], vb, pa0, pa1, pa2, pa3); pv_one<3>(o[3], vb, pa0, pa1, pa2, pa3);
}
__device__ __forceinline__ void attn_unit(const bf16* __restrict__ QR, const bf16* __restrict__ KR, const bf16* __restrict__ PMAIN, const unsigned long long* __restrict__ MASK,
                                          bf16* __restrict__ MIX, int b, int c, char* lds) {
  const int tid = threadIdx.x, wid = tid >> 6, lane = tid & 63, r32 = lane & 31, hi = lane >> 5;
  bf16* V_lds = (bf16*)lds; bf16* K_lds = (bf16*)(lds + 2 * SHM_V);
  float* ws = (float*)(lds + 2 * SHM_V + 2 * SHM_K) + wid * 64; float* li_l = ws; float* al_l = ws + 32;
  float m_reg = -1e30f, l_reg = 0; f32x16 o[4] = {};
  const char* qr = lds + SHM_Q0 + wid * (QBLK * 256);
  const int tok0 = b * SEQ + c * 64, qloc = 8 * wid + (r32 >> 2);
  const bf16* Kh = KR + (size_t)b * SEQ * LDK; const bf16* Vh = PMAIN + (size_t)b * SEQ * LDV + PM_DV;
  const char* mb = (const char*)MASK + (size_t)tok0 * 512; const unsigned moff = (unsigned)qloc * 512u; const bool allsel = (c <= 3);
  const int NTR = c + 1, NT = (NTR + 1) & ~1;
#define GETMASK(kt, ML, MH) do { unsigned long long mm_ = allsel ? ~0ull : *(const unsigned long long*)(mb + (moff + 8u * (unsigned)(kt))); if ((kt) >= NTR) mm_ = 0ull; ML = (unsigned)mm_ >> (4 * hi); MH = (unsigned)(mm_ >> 32) >> (4 * hi); } while (0)
  const int sr = tid >> 4, sc = (tid & 15) * 8, vst0 = v_st(sr, sc), vst1 = v_st(32 + sr, sc);
  const int vb0 = (int)(uintptr_t)V_lds + v_rd_base(lane);
  struct { bf16x8 vs0, vs1, ks0, ks1; } sr_[1];
const unsigned offV0 = (unsigned)(sr * LDV + sc) * 2u, offV1 = offV0 + 32u * LDV * 2u, offK0 = (unsigned)(sr * LDK + sc) * 2u, offK1 = offK0 + 32u * LDK * 2u;
#define SLOAD(i, k0) do { const char* vb_ = (const char*)Vh + (size_t)(k0) * (LDV * 2); const char* kb_ = (const char*)Kh + (size_t)(k0) * (LDK * 2); \
    sr_[i].vs0 = *(const bf16x8*)(vb_ + offV0); sr_[i].vs1 = *(const bf16x8*)(vb_ + offV1); sr_[i].ks0 = *(const bf16x8*)(kb_ + offK0); sr_[i].ks1 = *(const bf16x8*)(kb_ + offK1); } while (0)
#define SWRITE(bb, i) do { *(bf16x8*)((char*)V_lds + (bb) * SHM_V + vst0) = sr_[i].vs0;          \
    *(bf16x8*)((char*)V_lds + (bb) * SHM_V + vst1) = sr_[i].vs1; int kc = sc * 2;               \
    *(bf16x8*)((char*)K_lds + (bb) * SHM_K + KSWZ(sr, kc)) = sr_[i].ks0;                       \
    *(bf16x8*)((char*)K_lds + (bb) * SHM_K + KSWZ(32 + sr, kc)) = sr_[i].ks1; } while (0)
#define SWAIT() asm volatile("s_waitcnt vmcnt(0)" ::: "memory")
#define RESC(a) do { if (__any((a) < 1.f)) { if (hi == 0) al_l[r32] = (a); asm volatile("s_waitcnt lgkmcnt(0)" ::: "memory"); \
    _Pragma("unroll") for (int d = 0; d < 4; ++d) _Pragma("unroll") for (int r = 0; r < 16; ++r) o[d][r] *= al_l[crow(r, hi)]; } } while (0)
  f32x16 pA0, pA1, pB0, pB1; float mnA, mnB, alA, alB; bf16x8 pa0, pa1, pa2, pa3; unsigned mlA, mhA, mlB, mhB;
  constexpr int SE = 0, SO = 0;
  __syncthreads();
  { const char* qb = (const char*)QR + (size_t)tok0 * 1024; const unsigned qoff = (unsigned)(qloc * 512 + (r32 & 3) * 128 + hi * 8) * 2u;
#pragma unroll
    for (int d0 = 0; d0 < 8; ++d0) { const bf16x8 t = *reinterpret_cast<const bf16x8*>(qb + (qoff + 32u * d0)); *(bf16x8*)(const_cast<char*>(qr) + KSWZ(r32, (d0 * 16 + hi * 8) * 2)) = t; }
    asm volatile("s_waitcnt lgkmcnt(0)" ::: "memory"); }
  SLOAD(SE, 0); asm volatile("s_waitcnt vmcnt(0)" ::: "memory"); SWRITE(0, SE); __syncthreads();
  GETMASK(0, mlA, mhA);
  qkt(pA0, pA1, K_lds, qr, r32, hi); partialSM(pA0, pA1, m_reg, mnA, alA, mlA);
  SLOAD(SO, KVBLK);
  SWAIT(); SWRITE(1, SO); __syncthreads();
  for (int j = 1; j + 1 < NT; j += 2) {
    GETMASK(j, mlB, mhB);
    SBAR(); qkt(pB0, pB1, (bf16*)((char*)K_lds + SHM_K), qr, r32, hi);
    finishSM(pA0, pA1, alA, l_reg, pa0, pa1, pa2, pa3, mhA); SBAR();
    SLOAD(SO, (j + 1) * KVBLK); SBAR();
    pv_d0(o, vb0, pa0, pa1, pa2, pa3); partialSM(pB0, pB1, m_reg, mnB, alB, mlB);
    __syncthreads(); SWAIT(); SWRITE(0, SE);
    RESC(alB); __syncthreads();
    GETMASK(j + 1, mlA, mhA);
    SBAR(); qkt(pA0, pA1, K_lds, qr, r32, hi);
    finishSM(pB0, pB1, alB, l_reg, pa0, pa1, pa2, pa3, mhB); SBAR();
    SLOAD(SE, (j + 2) * KVBLK); SBAR();
    pv_d0(o, vb0 + (int)SHM_V, pa0, pa1, pa2, pa3); partialSM(pA0, pA1, m_reg, mnA, alA, mlA);
    __syncthreads(); SWAIT(); SWRITE(1, SO);
    RESC(alA); __syncthreads();
  }
  GETMASK(NT - 1, mlB, mhB);
  SBAR(); qkt(pB0, pB1, (bf16*)((char*)K_lds + SHM_K), qr, r32, hi);
  finishSM(pA0, pA1, alA, l_reg, pa0, pa1, pa2, pa3, mhA); SBAR();
  pv_d0(o, vb0, pa0, pa1, pa2, pa3); partialSM(pB0, pB1, m_reg, mnB, alB, mlB);
  __syncthreads(); RESC(alB);
  finishSM(pB0, pB1, alB, l_reg, pa0, pa1, pa2, pa3, mhB); SBAR();
  pv_d0(o, vb0 + (int)SHM_V, pa0, pa1, pa2, pa3);
  if (hi == 0) li_l[r32] = l_reg; asm volatile("s_waitcnt lgkmcnt(0)" ::: "memory");
  float rli[16];
#pragma unroll
  for (int r = 0; r < 16; ++r) rli[r] = __builtin_amdgcn_rcpf(li_l[crow(r, hi)]);
  { char* ob = (char*)MIX + (size_t)tok0 * 2048; const unsigned ooff = (unsigned)((8 * wid + hi) * 1024 + 512 + r32) * 2u;
#pragma unroll
    for (int r = 0; r < 16; ++r)
#pragma unroll
      for (int d0 = 0; d0 < 4; ++d0) *(bf16*)(ob + (size_t)((2 * (r >> 2) * 1024 + (r & 3) * 128 + d0 * 32) * 2) + ooff) = (bf16)f2bf(o[d0][r] * rli[r]); }
#undef GETMASK
#undef SLOAD
#undef SWRITE
#undef SWAIT
#undef RESC
}
}
#ifndef MK_ONE_LAUNCH
#define MK_ONE_LAUNCH 0
#endif
constexpr int NPHASE = 10;
static_assert(att::SHM_ATTN <= MISC_OFF && pg8::STAGE_BYTES <= MISC_OFF, "LDS map");
struct Args { const float* in[14]; float* out; unsigned char* ws; int ph_lo, ph_hi, li, pad; };
__global__ void __launch_bounds__(NTHR, 2) fwd_kernel(Args args) {
    extern __shared__ __attribute__((aligned(16))) unsigned char lds[];
    const int tid = threadIdx.x, lane = tid & 63, wave = __builtin_amdgcn_readfirstlane(tid >> 6), bid = blockIdx.x, G = gridDim.x;
    typedef const __attribute__((address_space(4))) Args* KArgs;
    const KArgs ka = (KArgs)__builtin_amdgcn_kernarg_segment_ptr(); (void)args;
    unsigned char* ws = ka->ws; char* ldsg = (char*)lds; LAS unsigned char* ldsl = (LAS unsigned char*)lds;
    if (tid < 64) ((LAS unsigned*)(ldsl + MISC_OFF))[tid] = 0u;
    __syncthreads();
    volatile LAS unsigned* MISC = (volatile LAS unsigned*)(ldsl + MISC_OFF);
    unsigned* ctl = (unsigned*)(ws + WS_CTL);
    const int lo = ka->ph_lo, hi = ka->ph_hi;
    XcdBarrier bar; bar.bar = ctl + CW_BAR + ka->li * XCD_BAR_WORDS; bar.x = 0; bar.st = nullptr;
    if (hi - lo > 1) bar = xcd_barrier_post(ctl + CW_BAR + ka->li * XCD_BAR_WORDS, MISC + 8);
#ifndef PH_ENABLE
#define PH_ENABLE 0x3ff
#endif
#define IN(k) (((PH_ENABLE >> (k)) & 1) && lo <= (k) && (k) < hi)
#define SEAM(k) do { if (IN(k) && IN((k) + 1)) xcd_barrier(bar); } while (0)
#define hcat ((bf16*)(ws + WS_HCAT))
#define winm ((bf16*)(ws + WS_WINM))
#define wspl ((bf16*)(ws + WS_WSPL))
#define wo ((bf16*)(ws + WS_WO))
#define w1t ((bf16*)(ws + WS_W1))
#define w2t ((bf16*)(ws + WS_W2))
#define tab128 ((f32x2*)(ws + WS_TAB128))
#define tab64 ((f32x2*)(ws + WS_TAB64))
#define pmain ((bf16*)(ws + WS_PMAIN))
#define pspl ((float*)(ws + WS_PSPL))
#define mix ((bf16*)(ws + WS_MIX))
#define oraw ((bf16*)(ws + WS_ORAW))
#define hn ((bf16*)(ws + WS_HN))
#define hid ((bf16*)(ws + WS_HID))
#define ffraw ((bf16*)(ws + WS_FFRAW))
#define ss1 ((float*)(ctl + CW_SS1))
#define ss2 ((float*)(ctl + CW_SS2))
#define GLA_ARGS GlaArgs ga{pmain, pspl, ka->in[3], ka->in[4], ka->in[5], (float*)(ws + WS_UT), (float*)(ws + WS_DECAY), (bf16*)(ws + WS_SIN), mix}
    const int gw = bid * NWAVES + wave, NGW = G * NWAVES;

    if (IN(0)) {
        P0Args a{ka->in[0], ka->in[1], ka->in[2], ka->in[8], ka->in[11], ka->in[12], hcat, winm, wspl, wo, w1t, w2t, tab128, tab64};
        p0_prologue(a, ldsg, bid, G, tid);
        SEAM(0);
    }
    if (IN(1)) {
        { pg8::Gemm g{hcat, winm, M, NMAIN, 1024, 2048, 1024, 1 << 30}; pg8::StaticOrder S; S.init(M, NMAIN, G, bid);
          pg8::EpiBf16X<0, false> E{pmain, NMAIN, nullptr};
          pg8::gemm_phase<pg8::EpiBf16X<0, false>, pg8::StaticOrder, true, true>(ldsl, g, S, E); }
        __syncthreads();
        { pg8::Gemm g{hcat, wspl, M, NSPLIT, KSPLIT, 2048, KSPLIT, 32}; pg8::StaticOrder S; S.init(M, NSPLIT, G, bid);
          pg8::EpiF32 E{pspl, NSPLIT};
          pg8::gemm_phase<pg8::EpiF32, pg8::StaticOrder, true, true>(ldsl, g, S, E); }
        SEAM(1);
    }
    if (IN(2)) {
        GLA_ARGS;
        P2Args a{pmain, pspl, tab128, tab64, ka->in[6], ka->in[7], (bf16*)(ws + WS_QR), (bf16*)(ws + WS_KR), (bf16*)(ws + WS_IKH), (bf16*)(ws + WS_IKL), (bf16*)(ws + WS_IQH), (bf16*)(ws + WS_IQL), (float*)(ws + WS_IW)};
        for (int m = gw; m < M; m += NGW) p2_post_row(a, m, lane);
        for (int u = bid; u < NUNIT_GLA; u += G) gla_local_unit(ga, u, ldsg, tid);
        SEAM(2);
    }
    if (IN(3)) {
        GLA_ARGS;
        gla_scan(ga, bid, G, tid);
        IdxArgs a{(const bf16*)(ws + WS_IQH), (const bf16*)(ws + WS_IQL), (const bf16*)(ws + WS_IKH), (const bf16*)(ws + WS_IKL), (const float*)(ws + WS_IW), (unsigned short*)(ws + WS_MASK)};
        for (int it = bid; it < BATCH * 30 * 8; it += G) {
            const int b = it / 240, rem = it % 240, p = rem >> 3, g = rem & 7;
            indexer_unit(a, b, 4 + p, g, (unsigned*)ldsg, tid);
            indexer_unit(a, b, 63 - p, g, (unsigned*)ldsg, tid);
        }
        SEAM(3);
    }
    if (IN(4)) {
        GLA_ARGS;
        for (int u = bid; u < NUNIT_GLA; u += G) gla_out_unit(ga, u, ldsg, tid);
        for (int it = bid; it < BATCH * 32; it += G) {
            const int b = it >> 5, p = it & 31;
            for (int half = 0; half < 2; ++half)
                att::attn_unit((const bf16*)(ws + WS_QR), (const bf16*)(ws + WS_KR), pmain, (const unsigned long long*)(ws + WS_MASK), mix, b, half ? p : 63 - p, ldsg);
        }
        SEAM(4);
    }
    if (IN(5)) {
        __syncthreads();
        pg8::Gemm g{mix, wo, M, DM, 1024, 1024, 1024, 1 << 30}; pg8::StaticOrder S; S.init(M, DM, G, bid);
        pg8::EpiBf16X<0, true> E{oraw, DM, ss1};
        pg8::gemm_phase<pg8::EpiBf16X<0, true>, pg8::StaticOrder, true, true>(ldsl, g, S, E);
        SEAM(5);
    }
    if (IN(6)) {
        for (int m = gw; m < M; m += NGW) p6_row(ka->in[0] + (size_t)m * DM, oraw + (size_t)m * DM, ss1[m], ka->in[9], ka->in[10], ka->out + (size_t)m * DM, hn + (size_t)m * DM, lane);
        SEAM(6);
    }
    if (IN(7)) {
        pg8::Gemm g{hn, w1t, M, DFF, 1024, 1024, 1024, 1 << 30}; pg8::StaticOrder S; S.init(M, DFF, G, bid);
        pg8::EpiBf16X<2, false> E{hid, DFF, nullptr};
        pg8::gemm_phase<pg8::EpiBf16X<2, false>, pg8::StaticOrder, true, true>(ldsl, g, S, E);
        SEAM(7);
    }
    if (IN(8)) {
        pg8::Gemm g{hid, w2t, M, DM, DFF, DFF, DFF, 1 << 30}; pg8::StaticOrder S; S.init(M, DM, G, bid);
        pg8::EpiBf16X<0, true> E{ffraw, DM, ss2};
        pg8::gemm_phase<pg8::EpiBf16X<0, true>, pg8::StaticOrder, true, true>(ldsl, g, S, E);
        SEAM(8);
    }
    if (IN(9)) {
        for (int m = gw; m < M; m += NGW) p9_row(ka->out + (size_t)m * DM, ffraw + (size_t)m * DM, ss2[m], ka->in[13], lane);
    }
#undef IN
#undef SEAM
#undef hcat
#undef winm
#undef wspl
#undef wo
#undef w1t
#undef w2t
#undef tab128
#undef tab64
#undef pmain
#undef pspl
#undef mix
#undef oraw
#undef hn
#undef hid
#undef ffraw
#undef ss1
#undef ss2
#undef GLA_ARGS
}

extern "C" void kernel_launch(void* const* d_in, const int* in_sizes, int n_in, void* d_out, int out_size, void* d_ws, size_t ws_size, hipStream_t stream) {
    static int grid = 0;
    if (grid == 0) {
        if (n_in != 14 || in_sizes[0] != M * DM || out_size != M * DM || ws_size < WS_END) { fprintf(stderr, "kernel_launch: shape/workspace mismatch (n_in %d, in0 %d, out %d, ws %zu < %zu); nothing launched\n", n_in, n_in > 0 ? in_sizes[0] : -1, out_size, ws_size, (size_t)WS_END); grid = -1; return; }
        int dev = 0, cus = 0, per_cu = 0;
        if (hipGetDevice(&dev) != hipSuccess || hipDeviceGetAttribute(&cus, hipDeviceAttributeMultiprocessorCount, dev) != hipSuccess) { fprintf(stderr, "kernel_launch: device query failed\n"); grid = -1; return; }
        if (hipFuncSetAttribute((const void*)fwd_kernel, hipFuncAttributeMaxDynamicSharedMemorySize, LDS_BYTES) != hipSuccess) { fprintf(stderr, "kernel_launch: hipFuncSetAttribute(%d B LDS) failed\n", LDS_BYTES); grid = -1; return; }
        if (hipOccupancyMaxActiveBlocksPerMultiprocessor(&per_cu, (const void*)fwd_kernel, NTHR, LDS_BYTES) != hipSuccess || per_cu < 1) fprintf(stderr, "kernel_launch: note: occupancy query reports %d workgroups per CU\n", per_cu);
        (void)hipGetLastError();
        grid = cus;
    }
    if (grid < 0) return;
    if (hipMemsetAsync((char*)d_ws + WS_CTL, 0, CTL_ZERO_BYTES, stream) != hipSuccess) { fprintf(stderr, "kernel_launch: memset failed\n"); return; }
    Args a{};
    for (int i = 0; i < 14; ++i) a.in[i] = (const float*)d_in[i];
    a.out = (float*)d_out; a.ws = (unsigned char*)d_ws;
#if MK_ONE_LAUNCH
    a.ph_lo = 0; a.ph_hi = NPHASE; a.li = 0;
    hipLaunchKernelGGL(fwd_kernel, dim3(grid), dim3(NTHR), LDS_BYTES, stream, a);
#else
    for (int ph = 0; ph < NPHASE; ++ph) { a.ph_lo = ph; a.ph_hi = ph + 1; a.li = ph;
        hipLaunchKernelGGL(fwd_kernel, dim3(grid), dim3(NTHR), LDS_BYTES, stream, a); }
#endif
    const hipError_t le = hipPeekAtLastError();
    if (le != hipSuccess) fprintf(stderr, "kernel_launch: launch failed: %s\n", hipGetErrorName(le));
}
```

```cpp
#include <hip/hip_runtime.h>
#include <cstdio>
#include <cstdint>
#include <cmath>
namespace pg8 {
#define PG8_LAS __attribute__((address_space(3)))
typedef unsigned short bf16_t;
typedef short bf16x8 __attribute__((ext_vector_type(8)));
typedef _Float16 f16x8_t __attribute__((ext_vector_type(8)));
typedef float f32x4 __attribute__((ext_vector_type(4)));
typedef unsigned u32x4 __attribute__((ext_vector_type(4)));
constexpr int BM = 256, BK = 64, HALF = 128, HTB = HALF * BK * 2  , STAGE_BYTES = 8 * HTB, NXCD = 8, WGM = 8;

__host__ __device__ __forceinline__ int lds_byte(int r, int c) { const int st = (r >> 4) * 2 + (c >> 5), rr = r & 15, cc = c & 31, ob = rr * 64 + cc * 2; return st * 1024 + (ob ^ (((ob >> 9) & 1) << 5)); }
__host__ __device__ __forceinline__ void stage_rc(int b, int& R, int& C) { const int st = b / 1024, sb = b % 1024, swz = sb ^ (((sb >> 9) & 1) << 5); R = (st >> 1) * 16 + swz / 64; C = (st & 1) * 32 + (swz % 64) / 2; }
__host__ __device__ __forceinline__ int perm32(int rho) { const int n = rho >> 4, i = rho & 15; return 8 * (i >> 2) + 4 * n + (i & 3); }

struct Unit { int pm, pn; };
struct Gemm { const bf16_t* A; const bf16_t* Bt; int M, N, K, lda, ldb, awrap; };

struct StaticOrder {
    int nM, nN, nwg, G, c;
    __host__ __device__ void init(int M, int N, int G_, int c_) { nM = M / BM; nN = N / BM; nwg = nM * nN; G = G_; c = c_; }
    __host__ __device__ bool next(int i, Unit& u) const {
        const long L = (long)i * G + c; if (L >= nwg) return false;
        int wgid = (int)L; { const int q = nwg / NXCD, r = nwg % NXCD, xcd = wgid % NXCD, off = wgid / NXCD; wgid = (xcd < r ? xcd * (q + 1) : r * (q + 1) + (xcd - r) * q) + off; }
        const int nig = WGM * nN, gid = wgid / nig, fm = gid * WGM, gsz = (nM - fm) < WGM ? (nM - fm) : WGM;
        u.pm = fm + ((wgid % nig) % gsz); u.pn = (wgid % nig) / gsz; return true;
    }
    __device__ __forceinline__ void a_ready(const Unit&) const {}
    __device__ __forceinline__ void done(const Unit&) const {}
};

__device__ __forceinline__ unsigned cvt_pk_bf16(float lo, float hi) { unsigned r; asm volatile("v_cvt_pk_bf16_f32 %0, %1, %2" : "=v"(r) : "v"(lo), "v"(hi)); return r; }
template <int ACT  , bool SS> struct EpiBf16X {
    static constexpr bool PERM = true, AFTER_DRAIN = false;
    bf16_t* O; int ldc; float* ss;
    __device__ __forceinline__ void operator()(const f32x4 (&acc)[2][2][4][2], const Unit& u, int wr, int wc, int fr, int fq) const {
        const int row0 = u.pm * BM + wr * 64 + fr; const int col0 = u.pn * BM + wc * 32 + 8 * fq;
#pragma unroll
        for (int ai = 0; ai < 2; ++ai)
#pragma unroll
            for (int m = 0; m < 4; ++m) { const int row = row0 + ai * HALF + m * 16; bf16_t* rowp = O + (size_t)row * ldc + col0; float s = 0.f;
#pragma unroll
                for (int bj = 0; bj < 2; ++bj) { f32x4 v0 = acc[ai][bj][m][0], v1 = acc[ai][bj][m][1];
                    if (ACT == 2) {
#pragma unroll
                        for (int e = 0; e < 4; ++e) { const float a = fmaxf(v0[e], 0.f), b = fmaxf(v1[e], 0.f); v0[e] = a * a; v1[e] = b * b; } }
                    if (SS) s += (v0[0] * v0[0] + v0[1] * v0[1]) + (v0[2] * v0[2] + v0[3] * v0[3]) + (v1[0] * v1[0] + v1[1] * v1[1]) + (v1[2] * v1[2] + v1[3] * v1[3]);
                    u32x4 w; w.x = cvt_pk_bf16(v0[0], v0[1]); w.y = cvt_pk_bf16(v0[2], v0[3]); w.z = cvt_pk_bf16(v1[0], v1[1]); w.w = cvt_pk_bf16(v1[2], v1[3]);
                    *(u32x4*)(rowp + bj * HALF) = w; }
                if (SS) { s += __shfl_xor(s, 16); s += __shfl_xor(s, 32); if (fq == 0) atomicAdd(ss + row, s); } }
    }
};
struct EpiF32 {
    static constexpr bool PERM = false, AFTER_DRAIN = false;
    float* O; int ldc;
    __device__ __forceinline__ void operator()(const f32x4 (&acc)[2][2][4][2], const Unit& u, int wr, int wc, int fr, int fq) const {
        const int row0 = u.pm * BM + wr * 64 + fr; const int col0 = u.pn * BM + wc * 32 + 4 * fq;
#pragma unroll
        for (int ai = 0; ai < 2; ++ai)
#pragma unroll
            for (int m = 0; m < 4; ++m) { float* rowp = O + (size_t)(row0 + ai * HALF + m * 16) * ldc + col0;
#pragma unroll
                for (int bj = 0; bj < 2; ++bj)
#pragma unroll
                    for (int n = 0; n < 2; ++n) *(f32x4*)(rowp + bj * HALF + n * 16) = acc[ai][bj][m][n]; }
    }
};
template <class Epi, class Sched, bool ALIGN_EPI = false, bool SP2 = false, bool F16 = false>
__device__ __forceinline__ void gemm_phase(PG8_LAS unsigned char* lds, const Gemm g, const Sched& S, const Epi& E) {
    const int tid = threadIdx.x, wid = __builtin_amdgcn_readfirstlane(tid >> 6), lane = tid & 63, wr = wid >> 2, wc = wid & 3, fr = lane & 15, fq = lane >> 4;
    const int K = g.K, nt = K / BK;
    unsigned voffA[2], voffB[2];
#pragma unroll
    for (int i = 0; i < 2; ++i) { int R, C; stage_rc(tid * 16 + i * 8192, R, C); const int Rb = Epi::PERM ? ((R & ~31) + perm32(R & 31)) : R;
        voffA[i] = (unsigned)(R * g.lda + C) * 2u; voffB[i] = (unsigned)(Rb * g.ldb + C) * 2u; }
    const size_t kstep = (size_t)(BK * 2);
    const size_t hstepA = (size_t)HALF * g.lda * 2, hstepB = (size_t)HALF * g.ldb * 2;
    const size_t tstepA = 2 * hstepA, tstepB = 2 * hstepB; const int awrap = g.awrap;
    const unsigned ldsw = (unsigned)wid * 1024u;
    const int aoff = lds_byte(wr * 64 + fr, fq * 8), boff = lds_byte(wc * 32 + fr, fq * 8);
#define PG8_SA(b, h) (((b) * 2 + (h)) * HTB)
#define PG8_SB(b, h) ((4 + (b) * 2 + (h)) * HTB)
#define PG8_STAGE(bufoff, gbase, voff) do { _Pragma("unroll") for (int _i = 0; _i < 2; ++_i) \
        __builtin_amdgcn_global_load_lds((const unsigned*)((const char*)(gbase) + (voff)[_i]), (PG8_LAS unsigned*)(lds + (bufoff) + ldsw + _i * 8192), 16, 0, 0); } while (0)
#define PG8_LDA(dst, b, h) do { _Pragma("unroll") for (int m = 0; m < 4; ++m) _Pragma("unroll") for (int k = 0; k < 2; ++k) dst[m][k] = *(const PG8_LAS bf16x8*)(lds + PG8_SA(b, h) + aoff + m * 2048 + k * 1024); } while (0)
#define PG8_LDB(dst, b, h) do { _Pragma("unroll") for (int n = 0; n < 2; ++n) _Pragma("unroll") for (int k = 0; k < 2; ++k) dst[n][k] = *(const PG8_LAS bf16x8*)(lds + PG8_SB(b, h) + boff + n * 2048 + k * 1024); } while (0)
#define PG8_MMA(ai, bj, At, Bt) do { __builtin_amdgcn_s_setprio(1); _Pragma("unroll") for (int m = 0; m < 4; ++m) _Pragma("unroll") for (int n = 0; n < 2; ++n) _Pragma("unroll") for (int k = 0; k < 2; ++k) \
        acc[ai][bj][m][n] = F16 ? __builtin_amdgcn_mfma_f32_16x16x32_f16(__builtin_bit_cast(f16x8_t, Bt[n][k]), __builtin_bit_cast(f16x8_t, At[m][k]), acc[ai][bj][m][n], 0, 0, 0) \
                                : __builtin_amdgcn_mfma_f32_16x16x32_bf16(Bt[n][k], At[m][k], acc[ai][bj][m][n], 0, 0, 0); __builtin_amdgcn_s_setprio(0); } while (0)
#define PG8_WAIT_V(n) asm volatile("s_waitcnt vmcnt(" #n ")" ::: "memory")
#define PG8_WAIT_L(n) asm volatile("s_waitcnt lgkmcnt(" #n ")" ::: "memory")
#define PG8_BAR __builtin_amdgcn_s_barrier()
#define PG8_SCHED __builtin_amdgcn_sched_barrier(0)
    Unit cur, nxt; int ui = 0;
    if (!S.next(0, cur)) return;
    f32x4 acc[2][2][4][2];
#pragma unroll
    for (int a = 0; a < 2; ++a)
#pragma unroll
        for (int b = 0; b < 2; ++b)
#pragma unroll
            for (int m = 0; m < 4; ++m)
#pragma unroll
                for (int n = 0; n < 2; ++n) acc[a][b][m][n] = (f32x4){0.f, 0.f, 0.f, 0.f};
    bf16x8 At[4][2], B0[2][2], B1[2][2];
    const char* cA = (const char*)g.A + (size_t)cur.pm * tstepA; const char* cB = (const char*)g.Bt + (size_t)cur.pn * tstepB;
    S.a_ready(cur);
    if constexpr (SP2) {
        PG8_STAGE(PG8_SB(0, 0), cB, voffB); PG8_STAGE(PG8_SB(0, 1), cB + hstepB, voffB); PG8_STAGE(PG8_SA(0, 0), cA, voffA); PG8_STAGE(PG8_SA(0, 1), cA + hstepA, voffA);
        if (wr == 1) PG8_BAR;
        PG8_WAIT_V(2); PG8_BAR;
        PG8_STAGE(PG8_SB(1, 0), cB + kstep, voffB); PG8_STAGE(PG8_SA(1, 0), cA + kstep, voffA); PG8_STAGE(PG8_SB(1, 1), cB + hstepB + kstep, voffB);
        PG8_WAIT_V(6); PG8_BAR;
    } else {
        PG8_STAGE(PG8_SB(0, 0), cB, voffB); PG8_STAGE(PG8_SA(0, 0), cA, voffA); PG8_STAGE(PG8_SB(0, 1), cB + hstepB, voffB); PG8_STAGE(PG8_SA(0, 1), cA + hstepA, voffA);
        if (wr == 1) PG8_BAR;
        PG8_WAIT_V(4); PG8_BAR;
        PG8_STAGE(PG8_SB(1, 0), cB + kstep, voffB); PG8_STAGE(PG8_SA(1, 0), cA + kstep, voffA); PG8_STAGE(PG8_SB(1, 1), cB + hstepB + kstep, voffB);
        PG8_WAIT_V(6); PG8_BAR;
    }
    for (;;) {
        const bool has_next = S.next(ui + 1, nxt);
        const char* nA = has_next ? (const char*)g.A + (size_t)nxt.pm * tstepA : cA; const char* nB = has_next ? (const char*)g.Bt + (size_t)nxt.pn * tstepB : cB;
        for (int t = 0; t < nt; t += 2) {
            const bool last = (t == nt - 2);
            const int t1 = t + 1, t2 = t + 2; const char* a1 = cA + (size_t)(t1 >= awrap ? t1 - awrap : t1) * kstep;
            const char* a2 = last ? nA : cA + (size_t)(t2 >= awrap ? t2 - awrap : t2) * kstep; const char* b2 = last ? nB : cB + (size_t)(t + 2) * kstep;
            const char* a3 = a2 + kstep; const char* b3 = b2 + kstep;
            if (last && has_next) S.a_ready(nxt);
            if constexpr (SP2) {
            PG8_LDB(B0, 0, 0); PG8_LDB(B1, 0, 1); PG8_SCHED; PG8_LDA(At, 0, 0); PG8_STAGE(PG8_SA(1, 1), a1 + hstepA, voffA);
            PG8_WAIT_V(8); PG8_WAIT_L(0); PG8_BAR; PG8_MMA(0, 0, At, B0); PG8_MMA(0, 1, At, B1); PG8_BAR; PG8_SCHED;
            PG8_LDA(At, 0, 1); PG8_STAGE(PG8_SB(0, 0), b2, voffB); PG8_STAGE(PG8_SB(0, 1), b2 + hstepB, voffB); PG8_STAGE(PG8_SA(0, 0), a2, voffA);
            PG8_WAIT_V(8); PG8_WAIT_L(0); PG8_BAR; PG8_MMA(1, 0, At, B0); PG8_MMA(1, 1, At, B1); PG8_BAR; PG8_SCHED;
            PG8_LDB(B0, 1, 0); PG8_LDB(B1, 1, 1); PG8_SCHED; PG8_LDA(At, 1, 0); PG8_STAGE(PG8_SA(0, 1), a2 + hstepA, voffA);
            PG8_WAIT_V(8); PG8_WAIT_L(0); PG8_BAR; PG8_MMA(0, 0, At, B0); PG8_MMA(0, 1, At, B1); PG8_BAR; PG8_SCHED;
            PG8_LDA(At, 1, 1); PG8_STAGE(PG8_SB(1, 0), b3, voffB); PG8_STAGE(PG8_SB(1, 1), b3 + hstepB, voffB); PG8_STAGE(PG8_SA(1, 0), a3, voffA);
            PG8_WAIT_V(8); PG8_WAIT_L(0); PG8_BAR; PG8_MMA(1, 0, At, B0); PG8_MMA(1, 1, At, B1); PG8_BAR; PG8_SCHED;
            } else {
            PG8_LDB(B0, 0, 0); PG8_SCHED; PG8_LDA(At, 0, 0); PG8_STAGE(PG8_SA(1, 1), a1 + hstepA, voffA);
            PG8_WAIT_L(8); PG8_BAR; PG8_WAIT_L(0); PG8_MMA(0, 0, At, B0); PG8_BAR; PG8_SCHED;
            PG8_LDB(B1, 0, 1); PG8_STAGE(PG8_SB(0, 0), b2, voffB);
            PG8_BAR; PG8_WAIT_L(0); PG8_MMA(0, 1, At, B1); PG8_BAR;
            PG8_LDA(At, 0, 1); PG8_STAGE(PG8_SA(0, 0), a2, voffA);
            PG8_BAR; PG8_WAIT_L(0); PG8_MMA(1, 0, At, B0); PG8_BAR; PG8_SCHED;
            PG8_STAGE(PG8_SB(0, 1), b2 + hstepB, voffB);
            PG8_WAIT_V(6); PG8_BAR; PG8_MMA(1, 1, At, B1); PG8_BAR;
            PG8_LDB(B0, 1, 0); PG8_SCHED; PG8_LDA(At, 1, 0); PG8_STAGE(PG8_SA(0, 1), a2 + hstepA, voffA);
            PG8_WAIT_L(8); PG8_BAR; PG8_WAIT_L(0); PG8_MMA(0, 0, At, B0); PG8_BAR; PG8_SCHED;
            PG8_LDB(B1, 1, 1); PG8_STAGE(PG8_SB(1, 0), b3, voffB);
            PG8_BAR; PG8_WAIT_L(0); PG8_MMA(0, 1, At, B1); PG8_BAR;
            PG8_LDA(At, 1, 1); PG8_STAGE(PG8_SA(1, 0), a3, voffA);
            PG8_BAR; PG8_WAIT_L(0); PG8_MMA(1, 0, At, B0); PG8_BAR; PG8_SCHED;
            PG8_STAGE(PG8_SB(1, 1), b3 + hstepB, voffB);
            PG8_WAIT_V(6); PG8_BAR; PG8_MMA(1, 1, At, B1); PG8_BAR;
            }
        }
        if constexpr (ALIGN_EPI) { if (wr == 0) PG8_BAR; }
        if constexpr (!Epi::AFTER_DRAIN) { E(acc, cur, wr, wc, fr, fq); S.done(cur); }
        if (!has_next) break;
#pragma unroll
        for (int a = 0; a < 2; ++a)
#pragma unroll
            for (int b = 0; b < 2; ++b)
#pragma unroll
                for (int m = 0; m < 4; ++m)
#pragma unroll
                    for (int n = 0; n < 2; ++n) acc[a][b][m][n] = (f32x4){0.f, 0.f, 0.f, 0.f};
        cur = nxt; cA = nA; cB = nB; ++ui;
        if constexpr (ALIGN_EPI) { if (wr == 1) PG8_BAR; }
    }
    PG8_WAIT_V(0);
    if constexpr (!ALIGN_EPI) { if (wr == 0) PG8_BAR; }
    PG8_BAR;
    if constexpr (Epi::AFTER_DRAIN) { E.fused(acc, cur, wr, wc, fr, fq, lds, wid, lane); S.done(cur); }
#undef PG8_SA
#undef PG8_SB
#undef PG8_STAGE
#undef PG8_LDA
#undef PG8_LDB
#undef PG8_MMA
#undef PG8_WAIT_V
#undef PG8_WAIT_L
#undef PG8_BAR
#undef PG8_SCHED
}
}
constexpr int BATCH = 8, SEQ = 4096, DM = 1024, M = BATCH * SEQ;
constexpr int D_IN = 2644, NMAIN = 2304, NSPLIT = 512, KSPLIT = 2048, DFF = 4096;
constexpr int PM_GQ = 0, PM_GK = 256, PM_GV = 512, PM_GR = 1024, PM_DQ = 1536, PM_DK = 2048, PM_DV = 2176;
constexpr int PS_IQ = 0, PS_IK = 256, PS_IW = 320, PS_GLR = 324;
constexpr float EPS = 1e-6f;
constexpr int NWAVES = 8, NTHR = 512;
constexpr int NUNIT_GLA = BATCH * 4 * 64;
constexpr int TOPK = 256;

constexpr size_t MiB = 1u << 20;
constexpr size_t WS_CTL = 0, CTL_ZERO_BYTES = 256 * 1024;
constexpr int CW_BAR = 4096, CW_SS1 = 65536, CW_SS2 = 98304;
constexpr size_t WS_IW = 1 * MiB, WS_DECAY = 1 * MiB + 512 * 1024;
constexpr size_t WS_WINM = 2 * MiB, WS_WSPL = 7 * MiB, WS_WO = 10 * MiB, WS_W1 = 12 * MiB, WS_W2 = 20 * MiB;
constexpr size_t WS_TAB128 = 28 * MiB, WS_TAB64 = 30 * MiB, WS_QB = 31 * MiB;
constexpr size_t WS_HCAT = 32 * MiB;
constexpr size_t WS_QR = 32 * MiB, WS_KR = 64 * MiB, WS_IKH = 72 * MiB, WS_IKL = 76 * MiB, WS_IQH = 80 * MiB, WS_IQL = 96 * MiB, WS_MASK = 112 * MiB, WS_SIN = 128 * MiB;
constexpr size_t WS_PMAIN = 160 * MiB, WS_PSPL = 304 * MiB, WS_UT = 368 * MiB, WS_GQD = 400 * MiB, WS_GKI = 416 * MiB, WS_MIX = 432 * MiB;
constexpr size_t WS_ORAW = 160 * MiB, WS_HN = 32 * MiB, WS_HID = 256 * MiB, WS_FFRAW = 96 * MiB;
constexpr size_t WS_END = 512 * MiB;
constexpr int RING_BYTES = 131072, LDS_BYTES = 147456, MISC_OFF = LDS_BYTES - 256;

#define LAS __attribute__((address_space(3)))
typedef unsigned short bf16;
typedef unsigned v4u __attribute__((ext_vector_type(4)));
typedef unsigned v2u __attribute__((ext_vector_type(2)));
typedef float f32x4 __attribute__((ext_vector_type(4)));
typedef float f32x2 __attribute__((ext_vector_type(2)));
typedef short bf16x8 __attribute__((ext_vector_type(8)));
#define LDS_WAIT() asm volatile("s_waitcnt lgkmcnt(0)" ::: "memory")
__device__ __forceinline__ unsigned f2bf(float f) { unsigned u = __float_as_uint(f); return (u + 0x7fffu + ((u >> 16) & 1u)) >> 16; }
__device__ __forceinline__ float bf2f(unsigned h) { return __uint_as_float(h << 16); }
__device__ __forceinline__ unsigned pk2(float lo, float hi) { return f2bf(lo) | (f2bf(hi) << 16); }
__device__ __forceinline__ float wave_sum(float v) {
#pragma unroll
    for (int o = 1; o < 64; o <<= 1) v += __shfl_xor(v, o);
    return v;
}
__device__ __forceinline__ f32x4 mfma16(bf16x8 a, bf16x8 b, f32x4 c) { return __builtin_amdgcn_mfma_f32_16x16x32_bf16(a, b, c, 0, 0, 0); }
#define XB_TMO      128
#define XB_XCNT(j)  (256  + 64 * (j))
#define XB_XSUB(j)  (1280 + 64 * (j))
#define XB_XGEN(j)  (2304 + 64 * (j))
#define XB_TOP      3328
#define XB_TOPGEN   3392
#define XCD_BAR_WORDS 3456
#define XB_SPIN_CAP (1u << 18)

__device__ __forceinline__ unsigned xb_ld(unsigned* p)              { return __hip_atomic_load(p, __ATOMIC_RELAXED, __HIP_MEMORY_SCOPE_AGENT); }
__device__ __forceinline__ unsigned xb_add(unsigned* p, unsigned v) { return __hip_atomic_fetch_add(p, v, __ATOMIC_RELAXED, __HIP_MEMORY_SCOPE_AGENT); }
__device__ __forceinline__ unsigned xb_xcc_id() { return (unsigned)__builtin_amdgcn_s_getreg((3 << 11) | 20) & 0xFu; }
#define XB_SPIN(cond, bar) do { unsigned _sp = 0; while (cond) { __builtin_amdgcn_s_sleep(1); \
    if ((++_sp & 255u) == 0u) { if (xb_ld(&(bar)[XB_TMO])) break; if (_sp > XB_SPIN_CAP) { atomicAdd(&(bar)[XB_TMO], 1u); break; } } } } while (0)

struct XcdBarrier {
    unsigned* bar; unsigned x;
    volatile LAS unsigned* st;
};

__device__ __forceinline__ XcdBarrier xcd_barrier_post(unsigned* bar, volatile LAS unsigned* st) {
    XcdBarrier b; b.bar = bar; b.x = xb_xcc_id(); b.st = st;
    if (threadIdx.x == 0) (void)xb_add(&bar[XB_XCNT(b.x)], 1u);
    return b;
}
__device__ __forceinline__ void xcd_barrier_complete(unsigned* bar, unsigned x, unsigned& nloc, unsigned& nx) {
    const unsigned G = gridDim.x * gridDim.y * gridDim.z;
    unsigned sum, cnt, mine, sp = 0u;
    for (;;) {
        sum = 0u; cnt = 0u; mine = 0u;
#pragma unroll
        for (unsigned j = 0; j < 16; ++j) { const unsigned c = xb_ld(&bar[XB_XCNT(j)]); sum += c; cnt += (c > 0u) ? 1u : 0u; mine = (j == x) ? c : mine; }
        if (sum == G) break;
        __builtin_amdgcn_s_sleep(1);
        if ((++sp & 255u) == 0u) { if (xb_ld(&bar[XB_TMO])) break; if (sp > XB_SPIN_CAP) { atomicAdd(&bar[XB_TMO], 1u); break; } }
    }
    nloc = mine > 0u ? mine : 1u; nx = cnt > 0u ? cnt : 1u;
}

__device__ __forceinline__ void xcd_barrier(const XcdBarrier& b) {
    asm volatile("s_waitcnt vmcnt(0)" ::: "memory");
    __syncthreads();
    if (threadIdx.x == 0) {
        unsigned* bar = b.bar;
        __builtin_amdgcn_s_waitcnt(0);
        unsigned nloc = b.st[0], nx = b.st[1];
        if (nloc == 0u) { xcd_barrier_complete(bar, b.x, nloc, nx); b.st[0] = nloc; b.st[1] = nx; }
        const unsigned old = xb_add(&bar[XB_XSUB(b.x)], 1u);
        const unsigned gen = old / nloc;
        if (old + 1u == (gen + 1u) * nloc) {
            __builtin_amdgcn_fence(__ATOMIC_RELEASE, "agent");
            asm volatile("s_waitcnt vmcnt(0)" ::: "memory");
            const unsigned og = xb_add(&bar[XB_TOP], 1u);
            const unsigned tg = og / nx;
            if (og + 1u == (tg + 1u) * nx) xb_add(&bar[XB_TOPGEN], 1u);
            else XB_SPIN(xb_ld(&bar[XB_TOPGEN]) == tg, bar);
            __builtin_amdgcn_fence(__ATOMIC_ACQUIRE, "agent");
            xb_add(&bar[XB_XGEN(b.x)], 1u);
            asm volatile("s_waitcnt vmcnt(0)" ::: "memory");
        } else {
            XB_SPIN(xb_ld(&bar[XB_XGEN(b.x)]) == gen, bar);
            __builtin_amdgcn_fence(__ATOMIC_ACQUIRE, "agent");
            asm volatile("s_waitcnt vmcnt(0)" ::: "memory");
        }
    }
    __syncthreads();
}

__device__ __forceinline__ unsigned short f16bits(_Float16 h) { return __builtin_bit_cast(unsigned short, h); }
__device__ __forceinline__ unsigned pkh2(float lo, float hi) { return (unsigned)f16bits((_Float16)lo) | ((unsigned)f16bits((_Float16)hi) << 16); }
__device__ __forceinline__ float h2f(unsigned bits16) { return (float)__builtin_bit_cast(_Float16, (unsigned short)bits16); }
__device__ __forceinline__ int win_src_main(int j) { return j < 1024 ? j : j + 16; }
__device__ __forceinline__ int win_src_split(int j) { return j < 256 ? 2320 + j : (j < 320 ? 2576 + (j - 256) : (j < 324 ? 2640 + (j - 320) : (j < 340 ? 1024 + (j - 324) : -1))); }
template <int MODE>
__device__ __forceinline__ void p0_transpose_item(const float* W, int ldw, bf16* WT, int ldo, float* scr, int item, int nblk, int lane) {
    const int kb = item / nblk, nb = item % nblk, k0 = 64 * kb, n0 = 32 * nb;
    const int n = n0 + (lane & 31);
    const int sc = MODE == 0 ? n : (MODE == 1 ? win_src_main(n) : win_src_split(n));
    float wv[32];
#pragma unroll
    for (int i = 0; i < 32; ++i) { const int kk = 2 * i + (lane >> 5); wv[i] = sc >= 0 ? W[(size_t)(k0 + kk) * ldw + sc] : 0.f; }
#pragma unroll
    for (int i = 0; i < 32; ++i) { const int kk = 2 * i + (lane >> 5); scr[kk * 33 + (lane & 31)] = wv[i]; }
    LDS_WAIT();
    const int c = lane & 7;
#pragma unroll
    for (int j = 0; j < 4; ++j) { const int nn = (lane >> 3) + 8 * j; const float* s = scr + (8 * c) * 33 + nn;
        const float v0 = s[0 * 33], v1 = s[1 * 33], v2 = s[2 * 33], v3 = s[3 * 33], v4 = s[4 * 33], v5 = s[5 * 33], v6 = s[6 * 33], v7 = s[7 * 33];
        v4u o; if (MODE == 0) { o.x = pk2(v0, v1); o.y = pk2(v2, v3); o.z = pk2(v4, v5); o.w = pk2(v6, v7); } else { o.x = pkh2(v0, v1); o.y = pkh2(v2, v3); o.z = pkh2(v4, v5); o.w = pkh2(v6, v7); }
        bf16* dst = WT + (size_t)(n0 + nn) * ldo + k0 + 8 * c;
        *(v4u*)dst = o;
        if (MODE == 2) *(v4u*)(dst + 1024) = o; }
    LDS_WAIT();
}
__device__ __forceinline__ void p0_rms_finish(const f32x4 (&v)[4], const float* w, bf16* orow, int lane) {
    const f32x4* wr = (const f32x4*)w + lane; float s = 0.f;
#pragma unroll
    for (int j = 0; j < 4; ++j) s += (v[j].x * v[j].x + v[j].y * v[j].y) + (v[j].z * v[j].z + v[j].w * v[j].w);
    const float r = 1.0f / sqrtf(wave_sum(s) * (1.f / DM) + EPS);
    unsigned long long* oh = (unsigned long long*)orow + lane; unsigned long long* ol = (unsigned long long*)(orow + 1024) + lane;
#pragma unroll
    for (int j = 0; j < 4; ++j) { const f32x4 y = (v[j] * r) * wr[64 * j];
        const unsigned h0 = pkh2(y.x, y.y), h1 = pkh2(y.z, y.w);
        const unsigned l0 = pkh2(y.x - h2f(h0 & 0xffffu), y.y - h2f(h0 >> 16)), l1 = pkh2(y.z - h2f(h1 & 0xffffu), y.w - h2f(h1 >> 16));
        oh[64 * j] = (unsigned long long)h0 | ((unsigned long long)h1 << 32); ol[64 * j] = (unsigned long long)l0 | ((unsigned long long)l1 << 32); }
}
__device__ __forceinline__ void p0_rms_rows(const float* x, const float* w, bf16* hcat, int gw, int NGW, int lane) {
    if (gw >= M) return;
    f32x4 cur[4], nxt[4];
#pragma unroll
    for (int j = 0; j < 4; ++j) cur[j] = __builtin_nontemporal_load((const f32x4*)(x + (size_t)gw * DM) + lane + 64 * j);
    for (int m = gw; m < M; m += NGW) { const int mn = (m + NGW < M) ? m + NGW : m;
#pragma unroll
        for (int j = 0; j < 4; ++j) nxt[j] = __builtin_nontemporal_load((const f32x4*)(x + (size_t)mn * DM) + lane + 64 * j);
        p0_rms_finish(cur, w, hcat + (size_t)m * 2048, lane);
#pragma unroll
        for (int j = 0; j < 4; ++j) cur[j] = nxt[j]; }
}
__device__ __forceinline__ void sincos_f64(double a, double& sn, double& cs) {
    const double kd = rint(a * 0.63661977236758134308);
    const double r = (a - kd * 1.57079632673412561417e+00) - kd * 6.07710050650619224932e-11;
    const double z = r * r;
    const double ps = 8.33333333332248946124e-03 + z * (-1.98412698298579493134e-04 + z * (2.75573137070700676789e-06 + z * (-2.50507602534068634195e-08 + z * 1.58969099521155010221e-10)));
    const double s = r + (z * r) * (-1.66666666666666324348e-01 + z * ps);
    const double pc = z * (4.16666666666666019037e-02 + z * (-1.38888888888741095749e-03 + z * (2.48015872894767294178e-05 + z * (-2.75573143513906633035e-07 + z * (2.08757232129817482790e-09 + z * -1.13596475577881948265e-11)))));
    const double c = 1.0 - (0.5 * z - z * pc);
    const int q = ((int)kd) & 3;
    sn = (q == 0) ? s : (q == 1) ? c : (q == 2) ? -s : -c;
    cs = (q == 0) ? c : (q == 1) ? -s : (q == 2) ? -c : s;
}
struct P0Args { const float *x, *nw, *w_in, *w_out, *w1, *w2; bf16 *hcat, *winm, *wspl, *wo, *w1t, *w2t; f32x2 *tab128, *tab64; };
__device__ __forceinline__ void p0_prologue(const P0Args& a, char* ldsg, int bid, int G, int tid) {
    const int lane = tid & 63, wave = tid >> 6;
    float* scr = (float*)(ldsg + wave * 16384);
    const int gw = bid * NWAVES + wave, NGW = G * NWAVES;
    constexpr int I_M = 16 * (NMAIN / 32), I_S = 16 * (NSPLIT / 32), I_O = 16 * (DM / 32), I_1 = 16 * (DFF / 32), I_2 = 64 * (DM / 32);
    for (int it = gw; it < I_M + I_S + I_O + I_1 + I_2; it += NGW) {
        int r = it;
        if (r < I_M) { p0_transpose_item<1>(a.w_in, D_IN, a.winm, 1024, scr, r, NMAIN / 32, lane); continue; } r -= I_M;
        if (r < I_S) { p0_transpose_item<2>(a.w_in, D_IN, a.wspl, KSPLIT, scr, r, NSPLIT / 32, lane); continue; } r -= I_S;
        if (r < I_O) { p0_transpose_item<0>(a.w_out, DM, a.wo, 1024, scr, r, DM / 32, lane); continue; } r -= I_O;
        if (r < I_1) { p0_transpose_item<0>(a.w1, DFF, a.w1t, 1024, scr, r, DFF / 32, lane); continue; } r -= I_1;
        p0_transpose_item<0>(a.w2, DM, a.w2t, DFF, scr, r, DM / 32, lane);
    }
    p0_rms_rows(a.x, a.nw, a.hcat, gw, NGW, lane);
    for (int e = bid * NTHR + tid; e < SEQ * 96; e += G * NTHR) {
        const int s = e / 96, j = e % 96; const bool big = j < 64; const int i = big ? j : j - 64;
        const double base = big ? 0.8659643233600653 : 0.7498942093324558;
        double p = 1.0; for (int k = 0; k < i; ++k) p *= base;
        const double ang = (double)s * (double)(float)p; double sn, cs; sincos_f64(ang, sn, cs);
        const f32x2 o = {(float)cs, (float)sn};
        if (big) a.tab128[s * 64 + i] = o; else a.tab64[s * 32 + i] = o;
    }
}

struct P2Args { const bf16* pmain; const float* pspl; const f32x2 *tab128, *tab64; const float *lnw, *lnb; bf16 *qr, *kr, *ikh, *ikl, *iqh, *iql; float* iw; float* qb; };
struct P2In { unsigned short k1, k2, q1[4], q2[4]; float iq1[2], iq2[2], iwr[2], ik, iw4; f32x2 cs, c2; };
__device__ __forceinline__ void p2_load(P2In& r, const P2Args& a, int m, int lane) {
    const int s = m & (SEQ - 1);
    const bf16* pm = a.pmain + (size_t)m * NMAIN; const float* ps = a.pspl + (size_t)m * NSPLIT;
    r.cs = a.tab128[s * 64 + lane]; r.c2 = a.tab64[s * 32 + (lane & 31)];
    r.k1 = pm[PM_DK + lane]; r.k2 = pm[PM_DK + 64 + lane];
#pragma unroll
    for (int h = 0; h < 4; ++h) { r.q1[h] = pm[PM_DQ + h * 128 + lane]; r.q2[h] = pm[PM_DQ + h * 128 + 64 + lane]; }
#pragma unroll
    for (int e = 0; e < 2; ++e) { const int h = 2 * e + (lane >> 5), i = lane & 31; r.iq1[e] = ps[PS_IQ + h * 64 + i]; r.iq2[e] = ps[PS_IQ + h * 64 + 32 + i]; r.iwr[e] = ps[PS_IW + h]; }
    r.ik = ps[PS_IK + lane]; r.iw4 = ps[PS_IW + (lane & 3)];
}
__device__ __forceinline__ void p2_post_row(const P2In& r, const P2Args& a, int m, int lane) {
    const int s = m & (SEQ - 1);
    const f32x2 cs = r.cs;
    { const float x1 = bf2f(r.k1), x2 = bf2f(r.k2);
      a.kr[(size_t)m * 128 + lane] = (bf16)f2bf(x1 * cs.x - x2 * cs.y); a.kr[(size_t)m * 128 + 64 + lane] = (bf16)f2bf(x2 * cs.x + x1 * cs.y); }
#pragma unroll
    for (int h = 0; h < 4; ++h) { const float x1 = bf2f(r.q1[h]), x2 = bf2f(r.q2[h]);
      a.qr[(size_t)m * 512 + h * 128 + lane] = (bf16)f2bf(x1 * cs.x - x2 * cs.y); a.qr[(size_t)m * 512 + h * 128 + 64 + lane] = (bf16)f2bf(x2 * cs.x + x1 * cs.y); }
    const f32x2 c2 = r.c2;
    float qn = 0.f;
#pragma unroll
    for (int e = 0; e < 2; ++e) { const int h = 2 * e + (lane >> 5), i = lane & 31;
      const float x1 = r.iq1[e], x2 = r.iq2[e];
      const float wr = r.iwr[e];
      const float o1 = (x1 * c2.x - x2 * c2.y) * wr, o2 = (x2 * c2.x + x1 * c2.y) * wr;
      float sq = o1 * o1 + o2 * o2;
#pragma unroll
      for (int o = 1; o < 32; o <<= 1) sq += __shfl_xor(sq, o);
      qn += sqrtf(sq);
      const _Float16 h1 = (_Float16)o1, h2 = (_Float16)o2; const size_t p = ((size_t)m * 4 + h) * 64 + i;
      a.iqh[p] = f16bits(h1); a.iqh[p + 32] = f16bits(h2); a.iql[p] = f16bits((_Float16)(o1 - (float)h1)); a.iql[p + 32] = f16bits((_Float16)(o2 - (float)h2)); }
    qn += __shfl_xor(qn, 32);
    if (lane == 0) a.qb[m] = qn;
    { const float v = r.ik; const float mu = wave_sum(v) * (1.f / 64.f); const float d = v - mu; const float var = wave_sum(d * d) * (1.f / 64.f);
      const float y = d * (1.0f / sqrtf(var + EPS)) * a.lnw[lane] + a.lnb[lane];
      const float other = __shfl_xor(y, 32);
      const float o = lane < 32 ? (y * c2.x - other * c2.y) : (y * c2.x + other * c2.y);
      const size_t p = (size_t)(m >> 12) * (SEQ * 64) + (size_t)(s >> 4) * 1024 + (lane >> 5) * 512 + ((((lane & 31) >> 3) * 16 + (s & 15)) * 8) + (lane & 7);
      a.ikh[p] = f16bits((_Float16)o); }
    if (lane < 4) a.iw[(size_t)m * 4 + lane] = (r.iw4 < 0.f) ? -__builtin_inff() : __builtin_inff();
}
__device__ __forceinline__ void p2_post_rows(const P2Args& a, int gw, int NGW, int lane) {
    if (gw >= M) return;
    P2In cur, nxt; p2_load(cur, a, gw, lane);
    for (int m = gw; m < M; m += NGW) { const int mn = (m + NGW < M) ? m + NGW : m;
        p2_load(nxt, a, mn, lane); p2_post_row(cur, a, m, lane); cur = nxt; }
}

constexpr int GLA_LD = 72;
struct GlaArgs { const bf16* pmain; const float* pspl; const float *gw2, *gb, *gnw; bf16* ut; float* decay; bf16* sin_; bf16* mix; bf16* gqd; bf16* gki; };
struct GlaPre { f32x2 glr, w2; float gbv; v4u k, q, v0, v1; };
template <bool WITH_Q>
__device__ __forceinline__ void gla_prefetch(GlaPre& p, const GlaArgs& a, int u, int tid) {
    const int b = u >> 8, h = (u >> 6) & 3, n = u & 63, m0 = b * SEQ + n * 64;
    { const int i = 2 * tid, t = i >> 4, j = i & 15; p.glr = *(const f32x2*)(a.pspl + (size_t)(m0 + t) * NSPLIT + PS_GLR + j); }
    { const int i = 2 * tid, j = i >> 6, d = i & 63; p.w2 = *(const f32x2*)(a.gw2 + j * 256 + h * 64 + d); }
    p.gbv = a.gb[h * 64 + (tid & 63)];
    const bf16* row = a.pmain + (size_t)(m0 + (tid & 63)) * NMAIN;
    p.k = *(const v4u*)(row + PM_GK + h * 64 + 8 * (tid >> 6));
    if (WITH_Q) p.q = *(const v4u*)(row + PM_GQ + h * 64 + 8 * (tid >> 6));
    p.v0 = *(const v4u*)(row + PM_GV + h * 128 + 8 * (tid >> 6)); p.v1 = *(const v4u*)(row + PM_GV + h * 128 + 64 + 8 * (tid >> 6));
}
constexpr int GS_LD = 65;
__device__ __forceinline__ void gla_bcum(const GlaPre& p, float* Gs, float* glr, float* w2s, float* gbs, int tid) {
    *(f32x2*)(glr + 2 * tid) = p.glr; *(f32x2*)(w2s + 2 * tid) = p.w2; if (tid < 64) gbs[tid] = p.gbv;
    __syncthreads();
    { const int d = tid & 63; float wc[16];
#pragma unroll
      for (int j = 0; j < 16; ++j) wc[j] = w2s[j * 64 + d];
      const float bias = gbs[d];
#pragma unroll
      for (int e = 0; e < 8; ++e) { const int t = (tid >> 6) + 8 * e; const f32x4* g4 = (const f32x4*)(glr + t * 16); float z = 0.f;
#pragma unroll
          for (int j4 = 0; j4 < 4; ++j4) { const f32x4 gv = g4[j4]; z += gv.x * wc[4 * j4]; z += gv.y * wc[4 * j4 + 1]; z += gv.z * wc[4 * j4 + 2]; z += gv.w * wc[4 * j4 + 3]; }
          z += bias;
          Gs[t * GS_LD + d] = (fminf(z, 0.f) - __logf(1.f + __expf(-fabsf(z)))) * (1.f / 16.f); } }
    __syncthreads();
    if (tid < 64) { float c[64];
#pragma unroll
        for (int t = 0; t < 64; ++t) c[t] = Gs[t * GS_LD + tid];
#pragma unroll
        for (int t = 1; t < 64; ++t) c[t] += c[t - 1];
#pragma unroll
        for (int t = 0; t < 64; ++t) Gs[t * GS_LD + tid] = c[t]; }
    __syncthreads();
}
__device__ __forceinline__ float bfl(unsigned w) { return __uint_as_float(w << 16); }
__device__ __forceinline__ float bfh(unsigned w) { return __uint_as_float(w & 0xffff0000u); }
__device__ __forceinline__ void gla_local_phase(const GlaArgs& a, char* ldsg, int bid, int G, int tid) {
    const int lane = tid & 63, w = tid >> 6, quad = lane >> 4, l15 = lane & 15;
    float* Gs = (float*)ldsg; float* glr = Gs + 64 * GS_LD + 32; float* w2s = glr + 1024; float* gbs = w2s + 1024; bf16* kT = (bf16*)(gbs + 64); bf16* vT = kT + 64 * GLA_LD;
    if (bid >= NUNIT_GLA) return;
    GlaPre cur, nxt; gla_prefetch<true>(cur, a, bid, tid);
    for (int u = bid; u < NUNIT_GLA; u += G) {
        const int un = (u + G < NUNIT_GLA) ? u + G : u; gla_prefetch<true>(nxt, a, un, tid);
        __syncthreads();
        gla_bcum(cur, Gs, glr, w2s, gbs, tid);
        { const int t = tid & 63, d0 = 8 * (tid >> 6); const unsigned kw[4] = {cur.k.x, cur.k.y, cur.k.z, cur.k.w}, qw[4] = {cur.q.x, cur.q.y, cur.q.z, cur.q.w}; unsigned qo[4], ko[4]; const unsigned v0w[4] = {cur.v0.x, cur.v0.y, cur.v0.z, cur.v0.w}, v1w[4] = {cur.v1.x, cur.v1.y, cur.v1.z, cur.v1.w};
#pragma unroll
          for (int e = 0; e < 4; ++e) { const int d = d0 + 2 * e; const float g0 = Gs[t * GS_LD + d], g1 = Gs[t * GS_LD + d + 1];
              qo[e] = pk2(bfl(qw[e]) * 0.125f * __expf(g0), bfh(qw[e]) * 0.125f * __expf(g1)); ko[e] = pk2(bfl(kw[e]) * __expf(-g0), bfh(kw[e]) * __expf(-g1));
              kT[d * GLA_LD + t] = (bf16)f2bf(bfl(kw[e]) * __expf(Gs[63 * GS_LD + d] - Gs[t * GS_LD + d])); kT[(d + 1) * GLA_LD + t] = (bf16)f2bf(bfh(kw[e]) * __expf(Gs[63 * GS_LD + d + 1] - Gs[t * GS_LD + d + 1]));
              vT[d * GLA_LD + t] = (bf16)(v0w[e] & 0xffffu); vT[(d + 1) * GLA_LD + t] = (bf16)(v0w[e] >> 16);
              vT[(64 + d) * GLA_LD + t] = (bf16)(v1w[e] & 0xffffu); vT[(64 + d + 1) * GLA_LD + t] = (bf16)(v1w[e] >> 16); }
          *(v4u*)(a.gqd + (size_t)u * 4096 + t * 64 + d0) = (v4u){qo[0], qo[1], qo[2], qo[3]}; *(v4u*)(a.gki + (size_t)u * 4096 + t * 64 + d0) = (v4u){ko[0], ko[1], ko[2], ko[3]}; }
        if (tid < 64) a.decay[(size_t)u * 64 + tid] = __expf(Gs[63 * GS_LD + tid]);
        __syncthreads();
        f32x4 acc[4];
#pragma unroll
        for (int dt = 0; dt < 4; ++dt) acc[dt] = (f32x4){0.f, 0.f, 0.f, 0.f};
#pragma unroll
        for (int ks = 0; ks < 2; ++ks) { const bf16x8 af = *(const bf16x8*)(vT + (16 * w + l15) * GLA_LD + ks * 32 + 8 * quad);
#pragma unroll
            for (int dt = 0; dt < 4; ++dt) { const bf16x8 bfr = *(const bf16x8*)(kT + (16 * dt + l15) * GLA_LD + ks * 32 + 8 * quad); acc[dt] = mfma16(af, bfr, acc[dt]); } }
        bf16* uo = a.ut + (size_t)u * 8192;
#pragma unroll
        for (int dt = 0; dt < 4; ++dt)
#pragma unroll
            for (int r = 0; r < 4; ++r) uo[(16 * w + 4 * quad + r) * 64 + 16 * dt + l15] = (bf16)f2bf(acc[dt][r]);
        cur = nxt;
    }
}
__device__ __forceinline__ void gla_scan(const GlaArgs& a, int bid, int G, int tid) {
    for (int idx = bid * NTHR + tid; idx < 32 * 4096; idx += G * NTHR) {
        const int bh = idx >> 12, e = 2 * (idx & 4095), d = e & 63; float s0 = 0.f, s1 = 0.f;
        const bf16* up = a.ut + (size_t)bh * 64 * 8192 + e; const float* dp = a.decay + (size_t)bh * 64 * 64 + d; bf16* sp = a.sin_ + (size_t)bh * 64 * 8192 + e;
#pragma nounroll
        for (int n0 = 0; n0 < 64; n0 += 8) {
            unsigned uu[8]; f32x2 dc[8];
#pragma unroll
            for (int k = 0; k < 8; ++k) { uu[k] = *(const unsigned*)(up + (size_t)(n0 + k) * 8192); dc[k] = *(const f32x2*)(dp + (n0 + k) * 64); }
#pragma unroll
            for (int k = 0; k < 8; ++k) { *(unsigned*)(sp + (size_t)(n0 + k) * 8192) = pk2(s0, s1); s0 = dc[k].x * s0 + bfl(uu[k]); s1 = dc[k].y * s1 + bfh(uu[k]); }
        }
    }
}
struct GlaPreO { v4u qd, ki, v0, v1; };
__device__ __forceinline__ void gla_prefetch_o(GlaPreO& p, const GlaArgs& a, int u, int tid) {
    const int b = u >> 8, h = (u >> 6) & 3, n = u & 63, m0 = b * SEQ + n * 64, t = tid & 63, d0 = 8 * (tid >> 6);
    p.qd = *(const v4u*)(a.gqd + (size_t)u * 4096 + t * 64 + d0); p.ki = *(const v4u*)(a.gki + (size_t)u * 4096 + t * 64 + d0);
    const bf16* row = a.pmain + (size_t)(m0 + t) * NMAIN + PM_GV + h * 128;
    p.v0 = *(const v4u*)(row + d0); p.v1 = *(const v4u*)(row + 64 + d0);
}
__device__ __forceinline__ void gla_out_phase(const GlaArgs& a, char* ldsg, int bid, int G, int tid) {
    const int lane = tid & 63, w = tid >> 6, quad = lane >> 4, l15 = lane & 15;
    bf16* Qd = (bf16*)ldsg; bf16* Ki = Qd + 64 * GLA_LD; bf16* vT = Ki + 64 * GLA_LD; bf16* At = vT + 128 * GLA_LD;
    float* part = (float*)(At + 64 * GLA_LD);
    if (bid >= NUNIT_GLA) return;
    const int rt = w & 3, ch = w >> 2;
    GlaPreO cur, nxt; gla_prefetch_o(cur, a, bid, tid);
    for (int u = bid; u < NUNIT_GLA; u += G) {
        const int b = u >> 8, h = (u >> 6) & 3, n = u & 63, m0 = b * SEQ + n * 64;
        const int un = (u + G < NUNIT_GLA) ? u + G : u; gla_prefetch_o(nxt, a, un, tid);
        bf16x8 sfr[2][4]; unsigned short rg[4][4];
        { const bf16* Sg = a.sin_ + (size_t)u * 8192;
#pragma unroll
          for (int ks = 0; ks < 2; ++ks)
#pragma unroll
            for (int vt = 0; vt < 4; ++vt) sfr[ks][vt] = *(const bf16x8*)(Sg + (16 * (4 * ch + vt) + l15) * 64 + ks * 32 + 8 * quad);
#pragma unroll
          for (int r = 0; r < 4; ++r)
#pragma unroll
            for (int vt = 0; vt < 4; ++vt) rg[r][vt] = a.pmain[(size_t)(m0 + 16 * rt + 4 * quad + r) * NMAIN + PM_GR + h * 128 + 16 * (4 * ch + vt) + l15]; }
        __syncthreads();
        { const int t = tid & 63, d0 = 8 * (tid >> 6);
          const unsigned v0w[4] = {cur.v0.x, cur.v0.y, cur.v0.z, cur.v0.w}, v1w[4] = {cur.v1.x, cur.v1.y, cur.v1.z, cur.v1.w};
#pragma unroll
          for (int e = 0; e < 4; ++e) { const int d = d0 + 2 * e;
              vT[d * GLA_LD + t] = (bf16)(v0w[e] & 0xffffu); vT[(d + 1) * GLA_LD + t] = (bf16)(v0w[e] >> 16);
              vT[(64 + d) * GLA_LD + t] = (bf16)(v1w[e] & 0xffffu); vT[(64 + d + 1) * GLA_LD + t] = (bf16)(v1w[e] >> 16); }
          *(v4u*)(Qd + t * GLA_LD + d0) = cur.qd; *(v4u*)(Ki + t * GLA_LD + d0) = cur.ki; }
        __syncthreads();
        {
            f32x4 s2[2] = {(f32x4){0.f, 0.f, 0.f, 0.f}, (f32x4){0.f, 0.f, 0.f, 0.f}};
#pragma unroll
            for (int ks = 0; ks < 2; ++ks) { const bf16x8 af = *(const bf16x8*)(Qd + (16 * rt + l15) * GLA_LD + ks * 32 + 8 * quad);
#pragma unroll
                for (int j2 = 0; j2 < 2; ++j2) { const bf16x8 bfr = *(const bf16x8*)(Ki + (16 * (2 * ch + j2) + l15) * GLA_LD + ks * 32 + 8 * quad); s2[j2] = mfma16(af, bfr, s2[j2]); } }
#pragma unroll
            for (int j2 = 0; j2 < 2; ++j2)
#pragma unroll
                for (int r = 0; r < 4; ++r) { const int i = 16 * rt + 4 * quad + r, j = 16 * (2 * ch + j2) + l15; At[i * GLA_LD + j] = (bf16)f2bf(j <= i ? s2[j2][r] : 0.f); }
        }
        __syncthreads();
        f32x4 o[4];
#pragma unroll
        for (int vt = 0; vt < 4; ++vt) o[vt] = (f32x4){0.f, 0.f, 0.f, 0.f};
#pragma unroll
        for (int ks = 0; ks < 2; ++ks) {
            const bf16x8 a1 = *(const bf16x8*)(At + (16 * rt + l15) * GLA_LD + ks * 32 + 8 * quad);
            const bf16x8 a2 = *(const bf16x8*)(Qd + (16 * rt + l15) * GLA_LD + ks * 32 + 8 * quad);
#pragma unroll
            for (int vt = 0; vt < 4; ++vt) { const bf16x8 b1 = *(const bf16x8*)(vT + (16 * (4 * ch + vt) + l15) * GLA_LD + ks * 32 + 8 * quad);
                o[vt] = mfma16(a1, b1, o[vt]); o[vt] = mfma16(a2, sfr[ks][vt], o[vt]); } }
#pragma unroll
        for (int r = 0; r < 4; ++r) { float sq = 0.f;
#pragma unroll
            for (int vt = 0; vt < 4; ++vt) sq += o[vt][r] * o[vt][r];
            sq += __shfl_xor(sq, 1); sq += __shfl_xor(sq, 2); sq += __shfl_xor(sq, 4); sq += __shfl_xor(sq, 8);
            if (l15 == 0) part[ch * 64 + 16 * rt + 4 * quad + r] = sq; }
        __syncthreads();
#pragma unroll
        for (int r = 0; r < 4; ++r) { const int i = 16 * rt + 4 * quad + r; const float rstd = 1.0f / sqrtf((part[i] + part[64 + i]) * (1.f / 128.f) + EPS);
#pragma unroll
            for (int vt = 0; vt < 4; ++vt) { const int v = 16 * (4 * ch + vt) + l15; const float rgf = bf2f(rg[r][vt]);
                a.mix[(size_t)(m0 + i) * 1024 + h * 128 + v] = (bf16)f2bf(o[vt][r] * rstd * a.gnw[v] * (rgf / (1.f + __expf(-rgf)))); } }
        cur = nxt;
    }
}

template <class T> __device__ __forceinline__ T ntl(const T* p) { return __builtin_nontemporal_load(p); }
template <class T> __device__ __forceinline__ void nts(T* p, T v) { __builtin_nontemporal_store(v, p); }
struct RowBuf { f32x4 x[4]; v2u r[4]; };
__device__ __forceinline__ void row_load(RowBuf& b, const float* xrow, const bf16* raw, int lane) {
#pragma unroll
    for (int j = 0; j < 4; ++j) { b.x[j] = ntl((const f32x4*)xrow + lane + 64 * j); b.r[j] = ntl((const v2u*)raw + lane + 64 * j); }
}
__device__ __forceinline__ f32x4 bf4(v2u rw);
__device__ __forceinline__ float row_ss(const v2u (&r)[4]);
__device__ __forceinline__ f32x4 bf4(v2u rw) { return (f32x4){bf2f(rw.x & 0xffffu), bf2f(rw.x >> 16), bf2f(rw.y & 0xffffu), bf2f(rw.y >> 16)}; }
__device__ __forceinline__ void p6_finish(const RowBuf& b, const float* wpost, const float* wpre, bf16* x1b, bf16* hn, int lane) {
    const float r1 = 1.0f / sqrtf(row_ss(b.r) * (1.f / DM) + EPS);
    f32x4 v[4]; float s = 0.f;
#pragma unroll
    for (int j = 0; j < 4; ++j) { v[j] = b.x[j] + (bf4(b.r[j]) * r1) * ((const f32x4*)wpost)[lane + 64 * j];
        s += (v[j].x * v[j].x + v[j].y * v[j].y) + (v[j].z * v[j].z + v[j].w * v[j].w);
        v2u o; o.x = pk2(v[j].x, v[j].y); o.y = pk2(v[j].z, v[j].w); ((v2u*)x1b)[lane + 64 * j] = o; }
    const float r2 = 1.0f / sqrtf(wave_sum(s) * (1.f / DM) + EPS);
#pragma unroll
    for (int j = 0; j < 4; ++j) { const f32x4 wv = ((const f32x4*)wpre)[lane + 64 * j]; const f32x4 y = (v[j] * r2) * wv;
        v2u o; o.x = pk2(y.x, y.y); o.y = pk2(y.z, y.w); ((v2u*)hn)[lane + 64 * j] = o; }
}
__device__ __forceinline__ float row_ss(const v2u (&r)[4]) { float s = 0.f;
#pragma unroll
    for (int j = 0; j < 4; ++j) { const f32x4 o = bf4(r[j]); s += (o.x * o.x + o.y * o.y) + (o.z * o.z + o.w * o.w); }
    return wave_sum(s); }
__device__ __forceinline__ void p6_rows(const float* x, bf16* raw, const float* wpost, const float* wpre, bf16* hn, int gw, int NGW, int lane) {
    if (gw >= M) return;
    RowBuf cur, nxt; row_load(cur, x + (size_t)gw * DM, raw + (size_t)gw * DM, lane);
    for (int m = gw; m < M; m += NGW) { const int mn = (m + NGW < M) ? m + NGW : m;
        if (mn != m) row_load(nxt, x + (size_t)mn * DM, raw + (size_t)mn * DM, lane);
        p6_finish(cur, wpost, wpre, raw + (size_t)m * DM, hn + (size_t)m * DM, lane); cur = nxt; }
}
__device__ __forceinline__ void p9_rows(const bf16* x1b, const bf16* raw2, const float* wpost2, float* out, int gw, int NGW, int lane) {
    if (gw >= M) return;
    v2u cx[4], c2[4], nx[4], n2[4];
#pragma unroll
    for (int j = 0; j < 4; ++j) { cx[j] = ntl((const v2u*)(x1b + (size_t)gw * DM) + lane + 64 * j); c2[j] = ntl((const v2u*)(raw2 + (size_t)gw * DM) + lane + 64 * j); }
    for (int m = gw; m < M; m += NGW) { const int mn = (m + NGW < M) ? m + NGW : m;
#pragma unroll
        for (int j = 0; j < 4; ++j) { nx[j] = ntl((const v2u*)(x1b + (size_t)mn * DM) + lane + 64 * j); n2[j] = ntl((const v2u*)(raw2 + (size_t)mn * DM) + lane + 64 * j); }
        const float r2 = 1.0f / sqrtf(row_ss(c2) * (1.f / DM) + EPS);
#pragma unroll
        for (int j = 0; j < 4; ++j) nts((f32x4*)(out + (size_t)m * DM) + lane + 64 * j, bf4(cx[j]) + (bf4(c2[j]) * r2) * ((const f32x4*)wpost2)[lane + 64 * j]);
#pragma unroll
        for (int j = 0; j < 4; ++j) { cx[j] = nx[j]; c2[j] = n2[j]; } }
}
__device__ __forceinline__ unsigned okey_of(float s) { const unsigned u = __float_as_uint(s); return (u & 0x80000000u) ? ~u : (u | 0x80000000u); }
__device__ __forceinline__ void cnt_ge(unsigned& n, unsigned k, unsigned c) { asm volatile("v_cmp_ge_u32 vcc, %1, %2\n\tv_addc_co_u32 %0, vcc, 0, %0, vcc" : "+v"(n) : "v"(k), "v"(c) : "vcc"); }
__device__ __forceinline__ void cnt_gt(unsigned& n, unsigned k, unsigned c) { asm volatile("v_cmp_gt_u32 vcc, %1, %2\n\tv_addc_co_u32 %0, vcc, 0, %0, vcc" : "+v"(n) : "v"(k), "v"(c) : "vcc"); }
__device__ __forceinline__ void cnt_tie(unsigned& n, unsigned k, unsigned T, unsigned lo, unsigned c) { unsigned tmp;
    asm volatile("v_cmp_eq_u32 vcc, %2, %3\n\tv_cndmask_b32 %1, 0, %4, vcc\n\tv_cmp_ge_u32 vcc, %1, %5\n\tv_addc_co_u32 %0, vcc, 0, %0, vcc" : "+v"(n), "=&v"(tmp) : "v"(k), "v"(T), "v"(lo), "v"(c) : "vcc"); }
#ifndef PROBE_IDX
#define PROBE_IDX 0
#endif
typedef _Float16 f16x8 __attribute__((ext_vector_type(8)));
__device__ __forceinline__ f32x4 mfma16h(f16x8 a, f16x8 b, f32x4 c) { return __builtin_amdgcn_mfma_f32_16x16x32_f16(a, b, c, 0, 0, 0); }
struct IdxArgs { const bf16 *iqh, *iql, *ikh, *ikl; const float* iw; unsigned short* mask16; const float* qb; float kbound; };
constexpr int IDX_ROUNDS = 45;
constexpr int IDX_NB = 2048, IDX_CAP = 512;
constexpr int IDX_HIST = 0, IDX_CAND = 8 * IDX_NB * 4, IDX_SMALL = IDX_CAND + 8 * IDX_CAP * 8;
__device__ __forceinline__ float okey_to_f(unsigned k) { return __uint_as_float((k & 0x80000000u) ? (k & 0x7fffffffu) : ~k); }
__device__ __forceinline__ unsigned idx_bin(float s, float inv) { return min((unsigned)__builtin_fmaf(s, inv, 0.5f * IDX_NB), (unsigned)(IDX_NB - 1)); }
template <int NI, int PV>
__device__ __forceinline__ void indexer_unit_t(const IdxArgs& a, int b, int c, int g, char* ldsg, int tid, int probe) {
    int lane_ = tid & 63; asm volatile("" : "+v"(lane_));
    const int lane = lane_, w = __builtin_amdgcn_readfirstlane(tid >> 6), quad = lane >> 4, l15 = lane & 15;
    const int q0 = b * SEQ + c * 64 + g * 8, ntile = 4 * (c + 1), nloc = (ntile - w + 7) >> 3;
    unsigned* hist = (unsigned*)(ldsg + IDX_HIST); unsigned long long* cand = (unsigned long long*)(ldsg + IDX_CAND); unsigned* sm = (unsigned*)(ldsg + IDX_SMALL);
    unsigned* qmin = sm; unsigned* qmax = sm + 8; unsigned* bstar = sm + 16; unsigned* above = sm + 24; unsigned* candn = sm + 32; unsigned* Tq = sm + 40; unsigned* Lq = sm + 48; unsigned* ovf = sm + 56; unsigned* dump = sm + 60; unsigned* cnt = sm + 64;
    __syncthreads();
    { v4u z = {0u, 0u, 0u, 0u}; v4u* h4 = (v4u*)hist;
#pragma unroll
      for (int k = 0; k < 8; ++k) h4[tid + k * NTHR] = z;
      if (tid < 8) candn[tid] = 0u;
      if (tid == 8) ovf[0] = 0u; }
    f16x8 aqh[2][2], aql[2][2]; f32x4 wq[2];
#pragma unroll
    for (int rt = 0; rt < 2; ++rt) {
#pragma unroll
        for (int ks = 0; ks < 2; ++ks) { const size_t p = ((size_t)(q0 + rt * 4 + (l15 >> 2)) * 4 + (l15 & 3)) * 64 + ks * 32 + 8 * quad;
            aqh[rt][ks] = *(const f16x8*)(a.iqh + p); aql[rt][ks] = *(const f16x8*)(a.iql + p); }
        wq[rt] = *(const f32x4*)(a.iw + (size_t)(q0 + rt * 4 + quad) * 4); }
    float sc[NI][2];
    const float kmx = a.kbound * 0.125f; const float inv0 = (0.5f * IDX_NB) / (a.qb[q0 + quad] * kmx), inv1 = (0.5f * IDX_NB) / (a.qb[q0 + 4 + quad] * kmx);
    __syncthreads();
    const char* khb = (const char*)a.ikh + (size_t)b * SEQ * 128;
    const unsigned koff = (unsigned)lane * 16u;
    constexpr int RING = 8;
    f16x8 kb[RING][2];
#define IDX_LOAD(i) do { const int tc_ = (probe >= 4) ? 0 : min(w + 8 * (i), ntile - 1); const unsigned o_ = koff + (unsigned)tc_ * 2048u; kb[(i) % RING][0] = *(const f16x8*)(khb + o_); kb[(i) % RING][1] = *(const f16x8*)(khb + (o_ + 1024u)); } while (0)
#pragma unroll
    for (int i = 0; i < RING - 1; ++i) IDX_LOAD(i);
#pragma unroll
    for (int i = 0; i < NI; ++i) {
        if (i + RING - 1 < NI) IDX_LOAD(i + RING - 1);
        const f16x8 bh0 = kb[i % RING][0], bh1 = kb[i % RING][1];
#pragma unroll
        for (int rt = 0; rt < 2; ++rt) { f32x4 acc = {0.f, 0.f, 0.f, 0.f};
            acc = mfma16h(aqh[rt][0], bh0, acc); acc = mfma16h(aqh[rt][1], bh1, acc); acc = mfma16h(aql[rt][0], bh0, acc); acc = mfma16h(aql[rt][1], bh1, acc);
            if constexpr (PV == 5) sc[i][rt] = acc[0] + acc[1] + acc[2] + acc[3]; else
            sc[i][rt] = ((__builtin_amdgcn_fmed3f(acc[0], 0.f, wq[rt][0]) + __builtin_amdgcn_fmed3f(acc[1], 0.f, wq[rt][1])) + __builtin_amdgcn_fmed3f(acc[2], 0.f, wq[rt][2])) + __builtin_amdgcn_fmed3f(acc[3], 0.f, wq[rt][3]); }
        { const unsigned one = (i < nloc) ? 1u : 0u;
          atomicAdd(&hist[quad * IDX_NB + idx_bin(sc[i][0], inv0)], one); atomicAdd(&hist[(4 + quad) * IDX_NB + idx_bin(sc[i][1], inv1)], one); }
        __builtin_amdgcn_sched_barrier(0);
    }
#undef IDX_LOAD
    if (probe == 1 || probe >= 4) return;
    __syncthreads();
    { const v4u* hq = (const v4u*)(hist + w * IDX_NB) + lane * 8; unsigned cntv[32]; unsigned tot = 0u;
#pragma unroll
      for (int k = 0; k < 8; ++k) { const v4u v = hq[k]; cntv[4 * k] = v.x; cntv[4 * k + 1] = v.y; cntv[4 * k + 2] = v.z; cntv[4 * k + 3] = v.w; tot += (v.x + v.y) + (v.z + v.w); }
      unsigned suf = tot;
#pragma unroll
      for (int o = 1; o < 64; o <<= 1) { const unsigned t = __shfl_down(suf, o); if (lane + o < 64) suf += t; }
      unsigned run = suf - tot;
      int bj = -1; unsigned ab = 0u;
#pragma unroll
      for (int j = 31; j >= 0; --j) { const unsigned cj = cntv[j]; const bool hit = (run < (unsigned)TOPK) && (run + cj >= (unsigned)TOPK); bj = hit ? j : bj; ab = hit ? run : ab; run += cj; }
      if (bj >= 0) { bstar[w] = (unsigned)(lane * 32 + bj); above[w] = ab; } }
    __syncthreads();
    if (probe == 2) return;
    const unsigned lo_base = 4095u - (unsigned)(16 * w + l15);
    { const unsigned bs0 = bstar[quad], bs1 = bstar[4 + quad];
#pragma unroll
      for (int i = 0; i < NI; ++i) { const unsigned lo = lo_base - 128u * (unsigned)i; const bool act = (i < nloc);
          if (act && idx_bin(sc[i][0], inv0) == bs0) { const unsigned slot = atomicAdd(&candn[quad], 1u); if (slot < (unsigned)IDX_CAP) cand[quad * IDX_CAP + slot] = ((unsigned long long)okey_of(sc[i][0]) << 12) | lo; }
          if (act && idx_bin(sc[i][1], inv1) == bs1) { const unsigned slot = atomicAdd(&candn[4 + quad], 1u); if (slot < (unsigned)IDX_CAP) cand[(4 + quad) * IDX_CAP + slot] = ((unsigned long long)okey_of(sc[i][1]) << 12) | lo; } } }
    __syncthreads();
    if (probe == 7) return;
    { const unsigned L = candn[w], need = (unsigned)TOPK - above[w];
      if (L > (unsigned)IDX_CAP) { if (lane == 0) ovf[0] = 1u; }
      else if (L <= 64u) {
        const unsigned long long mine = ((unsigned)lane < L) ? cand[w * IDX_CAP + lane] : 0ull; const unsigned mlo = (unsigned)mine, mhi = (unsigned)(mine >> 32); unsigned rank = 0u;
        for (unsigned i = 0; i < L; ++i) { const unsigned long long o = ((unsigned long long)(unsigned)__builtin_amdgcn_readlane((int)mhi, (int)i) << 32) | (unsigned)__builtin_amdgcn_readlane((int)mlo, (int)i); rank += (o > mine) ? 1u : 0u; }
        const unsigned long long bal = __ballot((unsigned)lane < L && rank + 1u == need); const int src = (int)__ffsll((long long)bal) - 1;
        const unsigned klo = (unsigned)__builtin_amdgcn_readlane((int)mlo, src), khi = (unsigned)__builtin_amdgcn_readlane((int)mhi, src);
        if (lane == 0) { Tq[w] = (khi << 20) | (klo >> 12); Lq[w] = klo & 0xfffu; } }
      else { unsigned long long ck[8];
#pragma unroll
        for (int j = 0; j < 8; ++j) ck[j] = ((unsigned)(j * 64 + lane) < L) ? cand[w * IDX_CAP + j * 64 + lane] : 0ull;
        unsigned long long Kth = 0ull;
#pragma nounroll
        for (int bit = 43; bit >= 0; --bit) { const unsigned long long cv = Kth | (1ull << bit); unsigned n = 0u;
#pragma unroll
            for (int j = 0; j < 8; ++j) if ((unsigned)(j * 64) < L) n += (unsigned)__popcll(__ballot(ck[j] >= cv));
            if (n >= need) Kth = cv; }
        if (lane == 0) { Tq[w] = (unsigned)(Kth >> 12); Lq[w] = (unsigned)Kth & 0xfffu; } } }
    __syncthreads();
    if (probe == 3) return;
    unsigned T0, T1, L0, L1; float Tf0, Tf1;
    if (ovf[0] == 0u) { Tf0 = okey_to_f(Tq[quad]); Tf1 = okey_to_f(Tq[4 + quad]); L0 = Lq[quad]; L1 = Lq[4 + quad];
    } else {
#pragma unroll
        for (int i = 0; i < NI; ++i) { sc[i][0] = (i < nloc) ? __uint_as_float(okey_of(sc[i][0])) : 0.f; sc[i][1] = (i < nloc) ? __uint_as_float(okey_of(sc[i][1])) : 0.f; }
        for (int i = tid; i < IDX_ROUNDS * 8; i += NTHR) cnt[i] = 0u;
        __syncthreads();
        T0 = 0u; T1 = 0u;
#pragma nounroll
        for (int rd = 0; rd < 32; ++rd) {
            const unsigned c0v = T0 | (0x80000000u >> rd), c1v = T1 | (0x80000000u >> rd); unsigned n0 = 0u, n1 = 0u;
#pragma unroll
            for (int i = 0; i < NI; ++i) { cnt_ge(n0, __float_as_uint(sc[i][0]), c0v); cnt_ge(n1, __float_as_uint(sc[i][1]), c1v); }
#pragma unroll
            for (int o = 1; o < 16; o <<= 1) { n0 += __shfl_xor(n0, o); n1 += __shfl_xor(n1, o); }
            if (l15 == 0) { atomicAdd(&cnt[rd * 8 + quad], n0); atomicAdd(&cnt[rd * 8 + 4 + quad], n1); }
            __syncthreads();
            if (cnt[rd * 8 + quad] >= (unsigned)TOPK) T0 = c0v;
            if (cnt[rd * 8 + 4 + quad] >= (unsigned)TOPK) T1 = c1v;
        }
        { unsigned n0 = 0u, n1 = 0u;
#pragma unroll
          for (int i = 0; i < NI; ++i) { cnt_gt(n0, __float_as_uint(sc[i][0]), T0); cnt_gt(n1, __float_as_uint(sc[i][1]), T1); }
#pragma unroll
          for (int o = 1; o < 16; o <<= 1) { n0 += __shfl_xor(n0, o); n1 += __shfl_xor(n1, o); }
          if (l15 == 0) { atomicAdd(&cnt[32 * 8 + quad], n0); atomicAdd(&cnt[32 * 8 + 4 + quad], n1); }
          __syncthreads(); }
        const unsigned need0 = (unsigned)TOPK - cnt[32 * 8 + quad], need1 = (unsigned)TOPK - cnt[32 * 8 + 4 + quad];
        L0 = 0u; L1 = 0u;
#pragma nounroll
        for (int rd = 0; rd < 12; ++rd) {
            const unsigned c0v = L0 | (0x800u >> rd), c1v = L1 | (0x800u >> rd); unsigned n0 = 0u, n1 = 0u;
#pragma unroll
            for (int i = 0; i < NI; ++i) { const unsigned lo = lo_base - 128u * (unsigned)i; cnt_tie(n0, __float_as_uint(sc[i][0]), T0, lo, c0v); cnt_tie(n1, __float_as_uint(sc[i][1]), T1, lo, c1v); }
#pragma unroll
            for (int o = 1; o < 16; o <<= 1) { n0 += __shfl_xor(n0, o); n1 += __shfl_xor(n1, o); }
            if (l15 == 0) { atomicAdd(&cnt[(33 + rd) * 8 + quad], n0); atomicAdd(&cnt[(33 + rd) * 8 + 4 + quad], n1); }
            __syncthreads();
            if (cnt[(33 + rd) * 8 + quad] >= need0) L0 = c0v;
            if (cnt[(33 + rd) * 8 + 4 + quad] >= need1) L1 = c1v;
        }
        Tf0 = okey_to_f(T0); Tf1 = okey_to_f(T1);
#pragma unroll
        for (int i = 0; i < NI; ++i) { sc[i][0] = okey_to_f(__float_as_uint(sc[i][0])); sc[i][1] = okey_to_f(__float_as_uint(sc[i][1])); }
    }
#pragma unroll
    for (int i = 0; i < NI; ++i) {
        const int t = w + 8 * i; const unsigned lo = lo_base - 128u * (unsigned)i; const bool act = (i < nloc);
#pragma unroll
        for (int rt = 0; rt < 2; ++rt) { const float k = sc[i][rt], T = rt ? Tf1 : Tf0; const unsigned L = rt ? L1 : L0;
            const bool sel = (k > T) || (k == T && lo >= L);
            const unsigned long long bal = __ballot(sel);
            if (lane < 4 && act) a.mask16[(size_t)(q0 + rt * 4 + lane) * 256 + t] = (unsigned short)((bal >> (16 * lane)) & 0xffffull); }
        __builtin_amdgcn_sched_barrier(0);
    }
}
template <int PV>
__device__ __forceinline__ void indexer_unit(const IdxArgs& a, int b, int c, int g, char* ldsg, int tid, int probe) {
    if (c < 16) indexer_unit_t<8, PV>(a, b, c, g, ldsg, tid, probe); else if (c < 32) indexer_unit_t<16, PV>(a, b, c, g, ldsg, tid, probe); else if (c < 48) indexer_unit_t<24, PV>(a, b, c, g, ldsg, tid, probe); else indexer_unit_t<32, PV>(a, b, c, g, ldsg, tid, probe);
}

namespace att {
using s16x4  = __attribute__((ext_vector_type(4))) short;
using f32x16 = __attribute__((ext_vector_type(16))) float;
using u32x4  = __attribute__((ext_vector_type(4))) unsigned;
constexpr int D = 128, NW = 8, QBLK = 32, KVBLK = 64;
constexpr float SCALE = 0.088388347648318440f, THR = 8.f;
constexpr int SHM_V = KVBLK * D * 2, SHM_K = KVBLK * D * 2, SHM_Q0 = 2 * SHM_V + 2 * SHM_K + NW * 64 * 4, SHM_ATTN = SHM_Q0 + 256 * D * 2;
constexpr int LDK = 128, LDV = NMAIN;
#define KSWZ(row, colB) ((row) * 256 + ((colB) ^ (((row) & 7) << 4)))
#define SBAR() __builtin_amdgcn_sched_barrier(0)
__device__ __forceinline__ int crow(int r, int hi) { return (r & 3) + 8 * (r >> 2) + 4 * hi; }
__device__ __forceinline__ unsigned cvtpk(float lo, float hi) { unsigned r; asm volatile("v_cvt_pk_bf16_f32 %0, %1, %2" : "=v"(r) : "v"(lo), "v"(hi)); return r; }
__device__ __forceinline__ float mask_and(float e, unsigned m, int pos) { float r; asm("v_bfe_i32 %0, %1, %2, 1\n\tv_and_b32 %0, %0, %3" : "=&v"(r) : "v"(m), "n"(pos), "v"(e)); return r; }
__device__ __forceinline__ void partialSM(f32x16& p0, f32x16& p1, float& m_reg, float& mn, float& alpha, unsigned ml) {
  constexpr float C = SCALE * 1.4426950408889634f;
  float pmax = p0[0];
#pragma unroll
  for (int r = 1; r < 16; ++r) pmax = fmaxf(pmax, p0[r]);
#pragma unroll
  for (int r = 0; r < 16; ++r) pmax = fmaxf(pmax, p1[r]);
  { auto rr = __builtin_amdgcn_permlane32_swap(__float_as_uint(pmax), __float_as_uint(pmax), false, false);
    pmax = fmaxf(__uint_as_float(rr[0]), __uint_as_float(rr[1])); }
  if (__builtin_expect(__all(pmax - m_reg <= THR / SCALE), 1)) { mn = m_reg; alpha = 1.f; }
  else { mn = fmaxf(m_reg, pmax); alpha = __builtin_amdgcn_exp2f((m_reg - mn) * C); m_reg = mn; }
  const float mnC = -mn * C;
#pragma unroll
  for (int r = 0; r < 16; ++r) p0[r] = fmaf(p0[r], C, mnC);
#pragma unroll
  for (int r = 0; r < 16; ++r) p1[r] = fmaf(p1[r], C, mnC);
#pragma unroll
  for (int r = 0; r < 16; ++r) p0[r] = mask_and(__builtin_amdgcn_exp2f(p0[r]), ml, (r & 3) + 8 * (r >> 2));
}
__device__ __forceinline__ void finishSM(f32x16& p0, f32x16& p1, float alpha, float& l_reg, bf16x8& pa0, bf16x8& pa1, bf16x8& pa2, bf16x8& pa3, unsigned mh) {
#pragma unroll
  for (int r = 0; r < 16; ++r) p1[r] = mask_and(__builtin_amdgcn_exp2f(p1[r]), mh, (r & 3) + 8 * (r >> 2));
  float ps = 0;
#pragma unroll
  for (int r = 0; r < 16; ++r) ps += p0[r];
#pragma unroll
  for (int r = 0; r < 16; ++r) ps += p1[r];
  { auto rr = __builtin_amdgcn_permlane32_swap(__float_as_uint(ps), __float_as_uint(ps), false, false);
    ps = __uint_as_float(rr[0]) + __uint_as_float(rr[1]); }
  l_reg = l_reg * alpha + ps;
#define PK4(P, BASE, OUT) do { unsigned a0 = cvtpk(P[BASE + 0], P[BASE + 1]), a1 = cvtpk(P[BASE + 2], P[BASE + 3]);   \
    unsigned b0 = cvtpk(P[BASE + 4], P[BASE + 5]), b1 = cvtpk(P[BASE + 6], P[BASE + 7]);                              \
    auto r0 = __builtin_amdgcn_permlane32_swap(a0, b0, false, false); auto r1 = __builtin_amdgcn_permlane32_swap(a1, b1, false, false); \
    u32x4 w = {r0[0], r1[0], r0[1], r1[1]}; OUT = *reinterpret_cast<bf16x8*>(&w); } while (0)
  PK4(p0, 0, pa0); PK4(p0, 8, pa1); PK4(p1, 0, pa2); PK4(p1, 8, pa3);
#undef PK4
}
__device__ __forceinline__ void qkt(f32x16& p0, f32x16& p1, const bf16* Ks, const char* Qs, int r32, int hi) {
  p0 = f32x16{}; p1 = f32x16{};
#pragma unroll
  for (int d0 = 0; d0 < 8; ++d0) { int cb = (d0 * 16 + hi * 8) * 2;
    bf16x8 b0 = *reinterpret_cast<const bf16x8*>((const char*)Ks + KSWZ(r32, cb));
    bf16x8 b1 = *reinterpret_cast<const bf16x8*>((const char*)Ks + KSWZ(32 + r32, cb));
    bf16x8 q = *reinterpret_cast<const bf16x8*>(Qs + KSWZ(r32, cb));
    p0 = __builtin_amdgcn_mfma_f32_32x32x16_bf16(b0, q, p0, 0, 0, 0);
    p1 = __builtin_amdgcn_mfma_f32_32x32x16_bf16(b1, q, p1, 0, 0, 0); }
}
__device__ __forceinline__ int v_st(int k, int c) { const int kk = (k & ~0xC) | ((k & 4) << 1) | ((k & 8) >> 1); return ((kk >> 3) * 4 + (c >> 5)) * 512 + ((kk & 7) * 32 + (c & 31)) * 2; }
__device__ __forceinline__ int v_rd_base(int lane) { return ((lane & 3) << 3) | (((lane >> 2) & 3) << 6) | (((lane >> 4) & 1) << 5) | (((lane >> 5) & 1) << 8); }
constexpr int v_rd_off(int d0, int ks, int half) { return d0 * 512 + ks * 4096 + half * 2048; }
template <int OFF> __device__ __forceinline__ s16x4 tr_read(int vb) {
  s16x4 r; asm volatile("ds_read_b64_tr_b16 %0, %1 offset:%2" : "=&v"(r) : "v"(vb), "i"(OFF) : "memory"); return r;
}
template <int D0> __device__ __forceinline__ void pv_one(f32x16& od, int vb, bf16x8 pa0, bf16x8 pa1, bf16x8 pa2, bf16x8 pa3) {
  const s16x4 l0 = tr_read<v_rd_off(D0, 0, 0)>(vb), h0 = tr_read<v_rd_off(D0, 0, 1)>(vb), l1 = tr_read<v_rd_off(D0, 1, 0)>(vb), h1 = tr_read<v_rd_off(D0, 1, 1)>(vb);
  const s16x4 l2 = tr_read<v_rd_off(D0, 2, 0)>(vb), h2 = tr_read<v_rd_off(D0, 2, 1)>(vb), l3 = tr_read<v_rd_off(D0, 3, 0)>(vb), h3 = tr_read<v_rd_off(D0, 3, 1)>(vb);
  asm volatile("s_waitcnt lgkmcnt(0)" ::: "memory"); SBAR();
#define PK(L, H) (bf16x8){L[0], L[1], L[2], L[3], H[0], H[1], H[2], H[3]}
  od = __builtin_amdgcn_mfma_f32_32x32x16_bf16(pa0, PK(l0, h0), od, 0, 0, 0);
  od = __builtin_amdgcn_mfma_f32_32x32x16_bf16(pa1, PK(l1, h1), od, 0, 0, 0);
  od = __builtin_amdgcn_mfma_f32_32x32x16_bf16(pa2, PK(l2, h2), od, 0, 0, 0);
  od = __builtin_amdgcn_mfma_f32_32x32x16_bf16(pa3, PK(l3, h3), od, 0, 0, 0);
#undef PK
}
__device__ __forceinline__ void pv_d0(f32x16* o, int vb, bf16x8 pa0, bf16x8 pa1, bf16x8 pa2, bf16x8 pa3) {
  pv_one<0>(o[0], vb, pa0, pa1, pa2, pa3); pv_one<1>(o[1], vb, pa0, pa1, pa2, pa3); pv_one<2>(o[2], vb, pa0, pa1, pa2, pa3); pv_one<3>(o[3], vb, pa0, pa1, pa2, pa3);
}
__device__ __forceinline__ void attn_unit(const bf16* __restrict__ QR, const bf16* __restrict__ KR, const bf16* __restrict__ PMAIN, const unsigned long long* __restrict__ MASK,
                                          bf16* __restrict__ MIX, int b, int c, char* lds) {
  const int tid = threadIdx.x, wid = tid >> 6, lane = tid & 63, r32 = lane & 31, hi = lane >> 5;
  bf16* V_lds = (bf16*)lds; bf16* K_lds = (bf16*)(lds + 2 * SHM_V);
  float* ws = (float*)(lds + 2 * SHM_V + 2 * SHM_K) + wid * 64; float* li_l = ws; float* al_l = ws + 32;
  float m_reg = -1e30f, l_reg = 0; f32x16 o[4] = {};
  const char* qr = lds + SHM_Q0 + wid * (QBLK * 256);
  const int tok0 = b * SEQ + c * 64, qloc = 8 * wid + (r32 >> 2);
  const bf16* Kh = KR + (size_t)b * SEQ * LDK; const bf16* Vh = PMAIN + (size_t)b * SEQ * LDV + PM_DV;
  const char* mb = (const char*)MASK + (size_t)tok0 * 512; const unsigned moff = (unsigned)qloc * 512u; const bool allsel = (c <= 3);
  const int NTR = c + 1, NT = (NTR + 1) & ~1;
#define GETMASK(kt, ML, MH) do { unsigned long long mm_ = allsel ? ~0ull : *(const unsigned long long*)(mb + (moff + 8u * (unsigned)(kt))); if ((kt) >= NTR) mm_ = 0ull; ML = (unsigned)mm_ >> (4 * hi); MH = (unsigned)(mm_ >> 32) >> (4 * hi); } while (0)
  const int sr = tid >> 4, sc = (tid & 15) * 8, vst0 = v_st(sr, sc), vst1 = v_st(32 + sr, sc);
  const int vb0 = (int)(uintptr_t)V_lds + v_rd_base(lane);
  struct { bf16x8 vs0, vs1, ks0, ks1; } sr_[1];
const unsigned offV0 = (unsigned)(sr * LDV + sc) * 2u, offV1 = offV0 + 32u * LDV * 2u, offK0 = (unsigned)(sr * LDK + sc) * 2u, offK1 = offK0 + 32u * LDK * 2u;
#define SLOAD(i, k0) do { const char* vb_ = (const char*)Vh + (size_t)(k0) * (LDV * 2); const char* kb_ = (const char*)Kh + (size_t)(k0) * (LDK * 2); \
    sr_[i].vs0 = *(const bf16x8*)(vb_ + offV0); sr_[i].vs1 = *(const bf16x8*)(vb_ + offV1); sr_[i].ks0 = *(const bf16x8*)(kb_ + offK0); sr_[i].ks1 = *(const bf16x8*)(kb_ + offK1); } while (0)
#define SWRITE(bb, i) do { *(bf16x8*)((char*)V_lds + (bb) * SHM_V + vst0) = sr_[i].vs0;          \
    *(bf16x8*)((char*)V_lds + (bb) * SHM_V + vst1) = sr_[i].vs1; int kc = sc * 2;               \
    *(bf16x8*)((char*)K_lds + (bb) * SHM_K + KSWZ(sr, kc)) = sr_[i].ks0;                       \
    *(bf16x8*)((char*)K_lds + (bb) * SHM_K + KSWZ(32 + sr, kc)) = sr_[i].ks1; } while (0)
#define SWAIT() asm volatile("s_waitcnt vmcnt(0)" ::: "memory")
#define RESC(a) do { if (__any((a) < 1.f)) { if (hi == 0) al_l[r32] = (a); asm volatile("s_waitcnt lgkmcnt(0)" ::: "memory"); \
    _Pragma("unroll") for (int d = 0; d < 4; ++d) _Pragma("unroll") for (int r = 0; r < 16; ++r) o[d][r] *= al_l[crow(r, hi)]; } } while (0)
  f32x16 pA0, pA1, pB0, pB1; float mnA, mnB, alA, alB; bf16x8 pa0, pa1, pa2, pa3; unsigned mlA, mhA, mlB, mhB;
  constexpr int SE = 0, SO = 0;
  __syncthreads();
  { const char* qb = (const char*)QR + (size_t)tok0 * 1024; const unsigned qoff = (unsigned)(qloc * 512 + (r32 & 3) * 128 + hi * 8) * 2u;
#pragma unroll
    for (int d0 = 0; d0 < 8; ++d0) { const bf16x8 t = *reinterpret_cast<const bf16x8*>(qb + (qoff + 32u * d0)); *(bf16x8*)(const_cast<char*>(qr) + KSWZ(r32, (d0 * 16 + hi * 8) * 2)) = t; }
    asm volatile("s_waitcnt lgkmcnt(0)" ::: "memory"); }
  SLOAD(SE, 0); asm volatile("s_waitcnt vmcnt(0)" ::: "memory"); SWRITE(0, SE); __syncthreads();
  GETMASK(0, mlA, mhA);
  qkt(pA0, pA1, K_lds, qr, r32, hi); partialSM(pA0, pA1, m_reg, mnA, alA, mlA);
  SLOAD(SO, KVBLK);
  SWAIT(); SWRITE(1, SO); __syncthreads();
  for (int j = 1; j + 1 < NT; j += 2) {
    GETMASK(j, mlB, mhB);
    SBAR(); qkt(pB0, pB1, (bf16*)((char*)K_lds + SHM_K), qr, r32, hi);
    finishSM(pA0, pA1, alA, l_reg, pa0, pa1, pa2, pa3, mhA); SBAR();
    SLOAD(SO, (j + 1) * KVBLK); SBAR();
    pv_d0(o, vb0, pa0, pa1, pa2, pa3); partialSM(pB0, pB1, m_reg, mnB, alB, mlB);
    __syncthreads(); SWAIT(); SWRITE(0, SE);
    RESC(alB); __syncthreads();
    GETMASK(j + 1, mlA, mhA);
    SBAR(); qkt(pA0, pA1, K_lds, qr, r32, hi);
    finishSM(pB0, pB1, alB, l_reg, pa0, pa1, pa2, pa3, mhB); SBAR();
    SLOAD(SE, (j + 2) * KVBLK); SBAR();
    pv_d0(o, vb0 + (int)SHM_V, pa0, pa1, pa2, pa3); partialSM(pA0, pA1, m_reg, mnA, alA, mlA);
    __syncthreads(); SWAIT(); SWRITE(1, SO);
    RESC(alA); __syncthreads();
  }
  GETMASK(NT - 1, mlB, mhB);
  SBAR(); qkt(pB0, pB1, (bf16*)((char*)K_lds + SHM_K), qr, r32, hi);
  finishSM(pA0, pA1, alA, l_reg, pa0, pa1, pa2, pa3, mhA); SBAR();
  pv_d0(o, vb0, pa0, pa1, pa2, pa3); partialSM(pB0, pB1, m_reg, mnB, alB, mlB);
  __syncthreads(); RESC(alB);
  finishSM(pB0, pB1, alB, l_reg, pa0, pa1, pa2, pa3, mhB); SBAR();
  pv_d0(o, vb0 + (int)SHM_V, pa0, pa1, pa2, pa3);
  if (hi == 0) li_l[r32] = l_reg; asm volatile("s_waitcnt lgkmcnt(0)" ::: "memory");
  float rli[16];
#pragma unroll
  for (int r = 0; r < 16; ++r) rli[r] = __builtin_amdgcn_rcpf(li_l[crow(r, hi)]);
  { char* ob = (char*)MIX + (size_t)tok0 * 2048; const unsigned ooff = (unsigned)((8 * wid + hi) * 1024 + 512 + r32) * 2u;
#pragma unroll
    for (int r = 0; r < 16; ++r)
#pragma unroll
      for (int d0 = 0; d0 < 4; ++d0) *(bf16*)(ob + (size_t)((2 * (r >> 2) * 1024 + (r & 3) * 128 + d0 * 32) * 2) + ooff) = (bf16)f2bf(o[d0][r] * rli[r]); }
#undef GETMASK
#undef SLOAD
#undef SWRITE
#undef SWAIT
#undef RESC
}
}
#ifndef MK_ONE_LAUNCH
#define MK_ONE_LAUNCH 1
#endif
constexpr int NPHASE = 10;
static_assert(att::SHM_ATTN <= MISC_OFF && pg8::STAGE_BYTES <= MISC_OFF, "LDS map");
struct Args { const float* in[14]; float* out; unsigned char* ws; int ph_lo, ph_hi, li, pad; };
__global__ void __launch_bounds__(NTHR, 2) fwd_kernel(Args args) {
    extern __shared__ __attribute__((aligned(16))) unsigned char lds[];
    const int tid = threadIdx.x, lane = tid & 63, wave = __builtin_amdgcn_readfirstlane(tid >> 6), bid = blockIdx.x, G = gridDim.x;
    typedef const __attribute__((address_space(4))) Args* KArgs;
    const KArgs ka = (KArgs)__builtin_amdgcn_kernarg_segment_ptr(); (void)args;
    unsigned char* ws = ka->ws; char* ldsg = (char*)lds; LAS unsigned char* ldsl = (LAS unsigned char*)lds;
    if (tid < 64) ((LAS unsigned*)(ldsl + MISC_OFF))[tid] = 0u;
    __syncthreads();
    volatile LAS unsigned* MISC = (volatile LAS unsigned*)(ldsl + MISC_OFF);
    unsigned* ctl = (unsigned*)(ws + WS_CTL);
    const int lo = ka->ph_lo, hi = ka->ph_hi;
    XcdBarrier bar; bar.bar = ctl + CW_BAR + ka->li * XCD_BAR_WORDS; bar.x = 0; bar.st = nullptr;
    if (hi - lo > 1) bar = xcd_barrier_post(ctl + CW_BAR + ka->li * XCD_BAR_WORDS, MISC + 8);
#ifndef PROBE_REPEAT
#define PROBE_REPEAT (-1)
#endif
#ifndef PROBE_SUB
#define PROBE_SUB 0
#endif
#ifndef PH_ENABLE
#define PH_ENABLE 0x3ff
#endif
#define IN(k) (((PH_ENABLE >> (k)) & 1) && lo <= (k) && (k) < hi)
#define SEAM(k) do { if (IN(k) && IN((k) + 1)) xcd_barrier(bar); } while (0)
#define hcat ((bf16*)(ws + WS_HCAT))
#define winm ((bf16*)(ws + WS_WINM))
#define wspl ((bf16*)(ws + WS_WSPL))
#define wo ((bf16*)(ws + WS_WO))
#define w1t ((bf16*)(ws + WS_W1))
#define w2t ((bf16*)(ws + WS_W2))
#define tab128 ((f32x2*)(ws + WS_TAB128))
#define tab64 ((f32x2*)(ws + WS_TAB64))
#define pmain ((bf16*)(ws + WS_PMAIN))
#define pspl ((float*)(ws + WS_PSPL))
#define mix ((bf16*)(ws + WS_MIX))
#define oraw ((bf16*)(ws + WS_ORAW))
#define hn ((bf16*)(ws + WS_HN))
#define hid ((bf16*)(ws + WS_HID))
#define ffraw ((bf16*)(ws + WS_FFRAW))
#define ss1 ((float*)(ctl + CW_SS1))
#define ss2 ((float*)(ctl + CW_SS2))
#define GLA_ARGS GlaArgs ga{pmain, pspl, ka->in[3], ka->in[4], ka->in[5], (bf16*)(ws + WS_UT), (float*)(ws + WS_DECAY), (bf16*)(ws + WS_SIN), mix, (bf16*)(ws + WS_GQD), (bf16*)(ws + WS_GKI)}
    const int gw = bid * NWAVES + wave, NGW = G * NWAVES;
    const int sub = (PROBE_SUB != 0 && ka->li == 1) ? PROBE_SUB : 0;

    if (IN(0)) {
        P0Args a{ka->in[0], ka->in[1], ka->in[2], ka->in[8], ka->in[11], ka->in[12], hcat, winm, wspl, wo, w1t, w2t, tab128, tab64};
        p0_prologue(a, ldsg, bid, G, tid);
        SEAM(0);
    }
    if (IN(1)) {
        { pg8::Gemm g{hcat, winm, M, NMAIN, 1024, 2048, 1024, 1 << 30}; pg8::StaticOrder S; S.init(M, NMAIN, G, bid);
          pg8::EpiBf16X<0, false> E{pmain, NMAIN, nullptr};
          pg8::gemm_phase<pg8::EpiBf16X<0, false>, pg8::StaticOrder, true, true, true>(ldsl, g, S, E); }
        __syncthreads();
        { pg8::Gemm g{hcat, wspl, M, NSPLIT, KSPLIT, 2048, KSPLIT, 1 << 30}; pg8::StaticOrder S; S.init(M, NSPLIT, G, bid);
          pg8::EpiF32 E{pspl, NSPLIT};
          pg8::gemm_phase<pg8::EpiF32, pg8::StaticOrder, true, true, true>(ldsl, g, S, E); }
        SEAM(1);
    }
    if (IN(2)) {
        GLA_ARGS;
        P2Args a{pmain, pspl, tab128, tab64, ka->in[6], ka->in[7], (bf16*)(ws + WS_QR), (bf16*)(ws + WS_KR), (bf16*)(ws + WS_IKH), (bf16*)(ws + WS_IKL), (bf16*)(ws + WS_IQH), (bf16*)(ws + WS_IQL), (float*)(ws + WS_IW), (float*)(ws + WS_QB)};
        if (sub != 2) p2_post_rows(a, gw, NGW, lane);
        if (sub != 1) gla_local_phase(ga, ldsg, bid, G, tid);
        SEAM(2);
    }
    if (IN(3)) {
        GLA_ARGS;
#ifndef PROBE_IDX
#define PROBE_IDX 0
#endif
        const int probe = (PROBE_IDX != 0 && ka->li == 1) ? PROBE_IDX : 0;
        if (probe == 0) gla_scan(ga, bid, G, tid);
        float kbound; { const float lw = fabsf(ka->in[6][lane]), lb = ka->in[7][lane]; float mw = lw;
#pragma unroll
          for (int o = 1; o < 64; o <<= 1) mw = fmaxf(mw, __shfl_xor(mw, o));
          kbound = 8.0f * mw + sqrtf(wave_sum(lb * lb)); }
        IdxArgs a{(const bf16*)(ws + WS_IQH), (const bf16*)(ws + WS_IQL), (const bf16*)(ws + WS_IKH), (const bf16*)(ws + WS_IKL), (const float*)(ws + WS_IW), (unsigned short*)(ws + WS_MASK), (const float*)(ws + WS_QB), kbound};
        if (G == 256) {
            const int b = bid >> 5, g = (bid & 31) >> 2, j = bid & 3;
            for (int k = 14; k >= 0; --k) { const int r = (k < 14) ? ((k >> 1) * 8 + ((k & 1) ? 7 - j : j)) : 56 + j;
                indexer_unit<0>(a, b, 4 + r, g, ldsg, tid, probe); }
        } else {
            for (int it = bid; it < BATCH * 30 * 8; it += G) {
                const int b = it / 240, rem = it % 240, p = rem >> 3, g = rem & 7;
                indexer_unit<0>(a, b, 4 + p, g, ldsg, tid, probe); indexer_unit<0>(a, b, 63 - p, g, ldsg, tid, probe); }
        }
        SEAM(3);
    }
    if (IN(4)) {
        GLA_ARGS;
        if (sub != 2) gla_out_phase(ga, ldsg, bid, G, tid);
        if (sub != 1) for (int it = bid; it < BATCH * 32; it += G) {
            const int b = it & 7, p = it >> 3;
            for (int half = 0; half < 2; ++half)
                att::attn_unit((const bf16*)(ws + WS_QR), (const bf16*)(ws + WS_KR), pmain, (const unsigned long long*)(ws + WS_MASK), mix, b, half ? p : 63 - p, ldsg);
        }
        SEAM(4);
    }
    if (IN(5)) {
        __syncthreads();
        pg8::Gemm g{mix, wo, M, DM, 1024, 1024, 1024, 1 << 30}; pg8::StaticOrder S; S.init(M, DM, G, bid);
        pg8::EpiBf16X<0, false> E{oraw, DM, nullptr};
        pg8::gemm_phase<pg8::EpiBf16X<0, false>, pg8::StaticOrder, true, true>(ldsl, g, S, E);
        SEAM(5);
    }
    if (IN(6)) {
        p6_rows(ka->in[0], oraw, ka->in[9], ka->in[10], hn, gw, NGW, lane);
        SEAM(6);
    }
    if (IN(7)) {
        pg8::Gemm g{hn, w1t, M, DFF, 1024, 1024, 1024, 1 << 30}; pg8::StaticOrder S; S.init(M, DFF, G, bid);
        pg8::EpiBf16X<2, false> E{hid, DFF, nullptr};
        pg8::gemm_phase<pg8::EpiBf16X<2, false>, pg8::StaticOrder, true, true>(ldsl, g, S, E);
        SEAM(7);
    }
    if (IN(8)) {
        pg8::Gemm g{hid, w2t, M, DM, DFF, DFF, DFF, 1 << 30}; pg8::StaticOrder S; S.init(M, DM, G, bid);
        pg8::EpiBf16X<0, false> E{ffraw, DM, nullptr};
        pg8::gemm_phase<pg8::EpiBf16X<0, false>, pg8::StaticOrder, true, true>(ldsl, g, S, E);
        SEAM(8);
    }
    if (IN(9)) {
        p9_rows(oraw, ffraw, ka->in[13], ka->out, gw, NGW, lane);
    }
#undef IN
#undef SEAM
#undef hcat
#undef winm
#undef wspl
#undef wo
#undef w1t
#undef w2t
#undef tab128
#undef tab64
#undef pmain
#undef pspl
#undef mix
#undef oraw
#undef hn
#undef hid
#undef ffraw
#undef ss1
#undef ss2
#undef GLA_ARGS
}

extern "C" void kernel_launch(void* const* d_in, const int* in_sizes, int n_in, void* d_out, int out_size, void* d_ws, size_t ws_size, hipStream_t stream) {
    static int grid = 0;
    if (grid == 0) {
        if (n_in != 14 || in_sizes[0] != M * DM || out_size != M * DM || ws_size < WS_END) { fprintf(stderr, "kernel_launch: shape/workspace mismatch (n_in %d, in0 %d, out %d, ws %zu < %zu); nothing launched\n", n_in, n_in > 0 ? in_sizes[0] : -1, out_size, ws_size, (size_t)WS_END); grid = -1; return; }
        int dev = 0, cus = 0, per_cu = 0;
        if (hipGetDevice(&dev) != hipSuccess || hipDeviceGetAttribute(&cus, hipDeviceAttributeMultiprocessorCount, dev) != hipSuccess) { fprintf(stderr, "kernel_launch: device query failed\n"); grid = -1; return; }
        if (hipFuncSetAttribute((const void*)fwd_kernel, hipFuncAttributeMaxDynamicSharedMemorySize, LDS_BYTES) != hipSuccess) { fprintf(stderr, "kernel_launch: hipFuncSetAttribute(%d B LDS) failed\n", LDS_BYTES); grid = -1; return; }
        if (hipOccupancyMaxActiveBlocksPerMultiprocessor(&per_cu, (const void*)fwd_kernel, NTHR, LDS_BYTES) != hipSuccess || per_cu < 1) fprintf(stderr, "kernel_launch: note: occupancy query reports %d workgroups per CU\n", per_cu);
        (void)hipGetLastError();
        grid = cus;
    }
    if (grid < 0) return;
    if (hipMemsetAsync((char*)d_ws + WS_CTL, 0, CTL_ZERO_BYTES, stream) != hipSuccess) { fprintf(stderr, "kernel_launch: memset failed\n"); return; }
    Args a{};
    for (int i = 0; i < 14; ++i) a.in[i] = (const float*)d_in[i];
    a.out = (float*)d_out; a.ws = (unsigned char*)d_ws;
#if MK_ONE_LAUNCH && PROBE_REPEAT >= 0
    { const int k = PROBE_REPEAT; const int lo3[3] = {0, k, k + 1}, hi3[3] = {k + 1, k + 1, NPHASE};
      for (int li = 0; li < 3; ++li) { if (lo3[li] >= hi3[li]) continue; a.ph_lo = lo3[li]; a.ph_hi = hi3[li]; a.li = li;
          hipLaunchKernelGGL(fwd_kernel, dim3(grid), dim3(NTHR), LDS_BYTES, stream, a); } }
#elif MK_ONE_LAUNCH
    a.ph_lo = 0; a.ph_hi = NPHASE; a.li = 0;
    hipLaunchKernelGGL(fwd_kernel, dim3(grid), dim3(NTHR), LDS_BYTES, stream, a);
#else
    for (int ph = 0; ph < NPHASE; ++ph) { a.ph_lo = ph; a.ph_hi = ph + 1; a.li = ph;
        hipLaunchKernelGGL(fwd_kernel, dim3(grid), dim3(NTHR), LDS_BYTES, stream, a); }
#endif
    const hipError_t le = hipPeekAtLastError();
    if (le != hipSuccess) fprintf(stderr, "kernel_launch: launch failed: %s\n", hipGetErrorName(le));
}
```

```cpp
#include <hip/hip_runtime.h>
#include <cstdio>
#include <cstdint>
#include <cmath>
namespace pg8 {
#define PG8_LAS __attribute__((address_space(3)))
typedef unsigned short bf16_t;
typedef short bf16x8 __attribute__((ext_vector_type(8)));
typedef _Float16 f16x8_t __attribute__((ext_vector_type(8)));
typedef float f32x4 __attribute__((ext_vector_type(4)));
typedef unsigned u32x4 __attribute__((ext_vector_type(4)));
constexpr int BM = 256, BK = 64, HALF = 128, HTB = HALF * BK * 2  , STAGE_BYTES = 8 * HTB, NXCD = 8, WGM = 8;

__host__ __device__ __forceinline__ int lds_byte(int r, int c) { const int st = (r >> 4) * 2 + (c >> 5), rr = r & 15, cc = c & 31, ob = rr * 64 + cc * 2; return st * 1024 + (ob ^ (((ob >> 9) & 1) << 5)); }
__host__ __device__ __forceinline__ void stage_rc(int b, int& R, int& C) { const int st = b / 1024, sb = b % 1024, swz = sb ^ (((sb >> 9) & 1) << 5); R = (st >> 1) * 16 + swz / 64; C = (st & 1) * 32 + (swz % 64) / 2; }
__host__ __device__ __forceinline__ int perm32(int rho) { const int n = rho >> 4, i = rho & 15; return 8 * (i >> 2) + 4 * n + (i & 3); }

struct Unit { int pm, pn; };
struct Gemm { const bf16_t* A; const bf16_t* Bt; int M, N, K, lda, ldb, awrap; };

struct StaticOrder {
    int nM, nN, nwg, G, c;
    __host__ __device__ void init(int M, int N, int G_, int c_) { nM = M / BM; nN = N / BM; nwg = nM * nN; G = G_; c = c_; }
    __host__ __device__ bool next(int i, Unit& u) const {
        const long L = (long)i * G + c; if (L >= nwg) return false;
        int wgid = (int)L; { const int q = nwg / NXCD, r = nwg % NXCD, xcd = wgid % NXCD, off = wgid / NXCD; wgid = (xcd < r ? xcd * (q + 1) : r * (q + 1) + (xcd - r) * q) + off; }
        const int nig = WGM * nN, gid = wgid / nig, fm = gid * WGM, gsz = (nM - fm) < WGM ? (nM - fm) : WGM;
        u.pm = fm + ((wgid % nig) % gsz); u.pn = (wgid % nig) / gsz; return true;
    }
    __device__ __forceinline__ void a_ready(const Unit&) const {}
    __device__ __forceinline__ void done(const Unit&) const {}
};

__device__ __forceinline__ unsigned cvt_pk_bf16(float lo, float hi) { unsigned r; asm volatile("v_cvt_pk_bf16_f32 %0, %1, %2" : "=v"(r) : "v"(lo), "v"(hi)); return r; }
template <int ACT  , bool SS> struct EpiBf16X {
    static constexpr bool PERM = true, AFTER_DRAIN = false;
    bf16_t* O; int ldc; float* ss;
    __device__ __forceinline__ void operator()(const f32x4 (&acc)[2][2][4][2], const Unit& u, int wr, int wc, int fr, int fq) const {
        const int row0 = u.pm * BM + wr * 64 + fr; const int col0 = u.pn * BM + wc * 32 + 8 * fq;
#pragma unroll
        for (int ai = 0; ai < 2; ++ai)
#pragma unroll
            for (int m = 0; m < 4; ++m) { const int row = row0 + ai * HALF + m * 16; bf16_t* rowp = O + (size_t)row * ldc + col0; float s = 0.f;
#pragma unroll
                for (int bj = 0; bj < 2; ++bj) { f32x4 v0 = acc[ai][bj][m][0], v1 = acc[ai][bj][m][1];
                    if (ACT == 2) {
#pragma unroll
                        for (int e = 0; e < 4; ++e) { const float a = fmaxf(v0[e], 0.f), b = fmaxf(v1[e], 0.f); v0[e] = a * a; v1[e] = b * b; } }
                    if (SS) s += (v0[0] * v0[0] + v0[1] * v0[1]) + (v0[2] * v0[2] + v0[3] * v0[3]) + (v1[0] * v1[0] + v1[1] * v1[1]) + (v1[2] * v1[2] + v1[3] * v1[3]);
                    u32x4 w; w.x = cvt_pk_bf16(v0[0], v0[1]); w.y = cvt_pk_bf16(v0[2], v0[3]); w.z = cvt_pk_bf16(v1[0], v1[1]); w.w = cvt_pk_bf16(v1[2], v1[3]);
                    *(u32x4*)(rowp + bj * HALF) = w; }
                if (SS) { s += __shfl_xor(s, 16); s += __shfl_xor(s, 32); if (fq == 0) atomicAdd(ss + row, s); } }
    }
};
struct EpiF32 {
    static constexpr bool PERM = false, AFTER_DRAIN = false;
    float* O; int ldc;
    __device__ __forceinline__ void operator()(const f32x4 (&acc)[2][2][4][2], const Unit& u, int wr, int wc, int fr, int fq) const {
        const int row0 = u.pm * BM + wr * 64 + fr; const int col0 = u.pn * BM + wc * 32 + 4 * fq;
#pragma unroll
        for (int ai = 0; ai < 2; ++ai)
#pragma unroll
            for (int m = 0; m < 4; ++m) { float* rowp = O + (size_t)(row0 + ai * HALF + m * 16) * ldc + col0;
#pragma unroll
                for (int bj = 0; bj < 2; ++bj)
#pragma unroll
                    for (int n = 0; n < 2; ++n) *(f32x4*)(rowp + bj * HALF + n * 16) = acc[ai][bj][m][n]; }
    }
};
template <class Epi, class Sched, bool ALIGN_EPI = false, bool SP2 = false, bool F16 = false>
__device__ __forceinline__ void gemm_phase(PG8_LAS unsigned char* lds, const Gemm g, const Sched& S, const Epi& E) {
    const int tid = threadIdx.x, wid = __builtin_amdgcn_readfirstlane(tid >> 6), lane = tid & 63, wr = wid >> 2, wc = wid & 3, fr = lane & 15, fq = lane >> 4;
    const int K = g.K, nt = K / BK;
    unsigned voffA[2], voffB[2];
#pragma unroll
    for (int i = 0; i < 2; ++i) { int R, C; stage_rc(tid * 16 + i * 8192, R, C); const int Rb = Epi::PERM ? ((R & ~31) + perm32(R & 31)) : R;
        voffA[i] = (unsigned)(R * g.lda + C) * 2u; voffB[i] = (unsigned)(Rb * g.ldb + C) * 2u; }
    const size_t kstep = (size_t)(BK * 2);
    const size_t hstepA = (size_t)HALF * g.lda * 2, hstepB = (size_t)HALF * g.ldb * 2;
    const size_t tstepA = 2 * hstepA, tstepB = 2 * hstepB; const int awrap = g.awrap;
    const unsigned ldsw = (unsigned)wid * 1024u;
    const int aoff = lds_byte(wr * 64 + fr, fq * 8), boff = lds_byte(wc * 32 + fr, fq * 8);
#define PG8_SA(b, h) (((b) * 2 + (h)) * HTB)
#define PG8_SB(b, h) ((4 + (b) * 2 + (h)) * HTB)
#define PG8_STAGE(bufoff, gbase, voff) do { _Pragma("unroll") for (int _i = 0; _i < 2; ++_i) \
        __builtin_amdgcn_global_load_lds((const unsigned*)((const char*)(gbase) + (voff)[_i]), (PG8_LAS unsigned*)(lds + (bufoff) + ldsw + _i * 8192), 16, 0, 0); } while (0)
#define PG8_LDA(dst, b, h) do { _Pragma("unroll") for (int m = 0; m < 4; ++m) _Pragma("unroll") for (int k = 0; k < 2; ++k) dst[m][k] = *(const PG8_LAS bf16x8*)(lds + PG8_SA(b, h) + aoff + m * 2048 + k * 1024); } while (0)
#define PG8_LDB(dst, b, h) do { _Pragma("unroll") for (int n = 0; n < 2; ++n) _Pragma("unroll") for (int k = 0; k < 2; ++k) dst[n][k] = *(const PG8_LAS bf16x8*)(lds + PG8_SB(b, h) + boff + n * 2048 + k * 1024); } while (0)
#define PG8_MMA(ai, bj, At, Bt) do { __builtin_amdgcn_s_setprio(1); _Pragma("unroll") for (int m = 0; m < 4; ++m) _Pragma("unroll") for (int n = 0; n < 2; ++n) _Pragma("unroll") for (int k = 0; k < 2; ++k) \
        acc[ai][bj][m][n] = F16 ? __builtin_amdgcn_mfma_f32_16x16x32_f16(__builtin_bit_cast(f16x8_t, Bt[n][k]), __builtin_bit_cast(f16x8_t, At[m][k]), acc[ai][bj][m][n], 0, 0, 0) \
                                : __builtin_amdgcn_mfma_f32_16x16x32_bf16(Bt[n][k], At[m][k], acc[ai][bj][m][n], 0, 0, 0); __builtin_amdgcn_s_setprio(0); } while (0)
#define PG8_WAIT_V(n) asm volatile("s_waitcnt vmcnt(" #n ")" ::: "memory")
#define PG8_WAIT_L(n) asm volatile("s_waitcnt lgkmcnt(" #n ")" ::: "memory")
#define PG8_BAR __builtin_amdgcn_s_barrier()
#define PG8_SCHED __builtin_amdgcn_sched_barrier(0)
    Unit cur, nxt; int ui = 0;
    if (!S.next(0, cur)) return;
    f32x4 acc[2][2][4][2];
#pragma unroll
    for (int a = 0; a < 2; ++a)
#pragma unroll
        for (int b = 0; b < 2; ++b)
#pragma unroll
            for (int m = 0; m < 4; ++m)
#pragma unroll
                for (int n = 0; n < 2; ++n) acc[a][b][m][n] = (f32x4){0.f, 0.f, 0.f, 0.f};
    bf16x8 At[4][2], B0[2][2], B1[2][2];
    const char* cA = (const char*)g.A + (size_t)cur.pm * tstepA; const char* cB = (const char*)g.Bt + (size_t)cur.pn * tstepB;
    S.a_ready(cur);
    if constexpr (SP2) {
        PG8_STAGE(PG8_SB(0, 0), cB, voffB); PG8_STAGE(PG8_SB(0, 1), cB + hstepB, voffB); PG8_STAGE(PG8_SA(0, 0), cA, voffA); PG8_STAGE(PG8_SA(0, 1), cA + hstepA, voffA);
        if (wr == 1) PG8_BAR;
        PG8_WAIT_V(2); PG8_BAR;
        PG8_STAGE(PG8_SB(1, 0), cB + kstep, voffB); PG8_STAGE(PG8_SA(1, 0), cA + kstep, voffA); PG8_STAGE(PG8_SB(1, 1), cB + hstepB + kstep, voffB);
        PG8_WAIT_V(6); PG8_BAR;
    } else {
        PG8_STAGE(PG8_SB(0, 0), cB, voffB); PG8_STAGE(PG8_SA(0, 0), cA, voffA); PG8_STAGE(PG8_SB(0, 1), cB + hstepB, voffB); PG8_STAGE(PG8_SA(0, 1), cA + hstepA, voffA);
        if (wr == 1) PG8_BAR;
        PG8_WAIT_V(4); PG8_BAR;
        PG8_STAGE(PG8_SB(1, 0), cB + kstep, voffB); PG8_STAGE(PG8_SA(1, 0), cA + kstep, voffA); PG8_STAGE(PG8_SB(1, 1), cB + hstepB + kstep, voffB);
        PG8_WAIT_V(6); PG8_BAR;
    }
    for (;;) {
        const bool has_next = S.next(ui + 1, nxt);
        const char* nA = has_next ? (const char*)g.A + (size_t)nxt.pm * tstepA : cA; const char* nB = has_next ? (const char*)g.Bt + (size_t)nxt.pn * tstepB : cB;
        for (int t = 0; t < nt; t += 2) {
            const bool last = (t == nt - 2);
            const int t1 = t + 1, t2 = t + 2; const char* a1 = cA + (size_t)(t1 >= awrap ? t1 - awrap : t1) * kstep;
            const char* a2 = last ? nA : cA + (size_t)(t2 >= awrap ? t2 - awrap : t2) * kstep; const char* b2 = last ? nB : cB + (size_t)(t + 2) * kstep;
            const char* a3 = a2 + kstep; const char* b3 = b2 + kstep;
            if (last && has_next) S.a_ready(nxt);
            if constexpr (SP2) {
            PG8_LDB(B0, 0, 0); PG8_LDB(B1, 0, 1); PG8_SCHED; PG8_LDA(At, 0, 0); PG8_STAGE(PG8_SA(1, 1), a1 + hstepA, voffA);
            PG8_WAIT_V(8); PG8_WAIT_L(0); PG8_BAR; PG8_MMA(0, 0, At, B0); PG8_MMA(0, 1, At, B1); PG8_BAR; PG8_SCHED;
            PG8_LDA(At, 0, 1); PG8_STAGE(PG8_SB(0, 0), b2, voffB); PG8_STAGE(PG8_SB(0, 1), b2 + hstepB, voffB); PG8_STAGE(PG8_SA(0, 0), a2, voffA);
            PG8_WAIT_V(8); PG8_WAIT_L(0); PG8_BAR; PG8_MMA(1, 0, At, B0); PG8_MMA(1, 1, At, B1); PG8_BAR; PG8_SCHED;
            PG8_LDB(B0, 1, 0); PG8_LDB(B1, 1, 1); PG8_SCHED; PG8_LDA(At, 1, 0); PG8_STAGE(PG8_SA(0, 1), a2 + hstepA, voffA);
            PG8_WAIT_V(8); PG8_WAIT_L(0); PG8_BAR; PG8_MMA(0, 0, At, B0); PG8_MMA(0, 1, At, B1); PG8_BAR; PG8_SCHED;
            PG8_LDA(At, 1, 1); PG8_STAGE(PG8_SB(1, 0), b3, voffB); PG8_STAGE(PG8_SB(1, 1), b3 + hstepB, voffB); PG8_STAGE(PG8_SA(1, 0), a3, voffA);
            PG8_WAIT_V(8); PG8_WAIT_L(0); PG8_BAR; PG8_MMA(1, 0, At, B0); PG8_MMA(1, 1, At, B1); PG8_BAR; PG8_SCHED;
            } else {
            PG8_LDB(B0, 0, 0); PG8_SCHED; PG8_LDA(At, 0, 0); PG8_STAGE(PG8_SA(1, 1), a1 + hstepA, voffA);
            PG8_WAIT_L(8); PG8_BAR; PG8_WAIT_L(0); PG8_MMA(0, 0, At, B0); PG8_BAR; PG8_SCHED;
            PG8_LDB(B1, 0, 1); PG8_STAGE(PG8_SB(0, 0), b2, voffB);
            PG8_BAR; PG8_WAIT_L(0); PG8_MMA(0, 1, At, B1); PG8_BAR;
            PG8_LDA(At, 0, 1); PG8_STAGE(PG8_SA(0, 0), a2, voffA);
            PG8_BAR; PG8_WAIT_L(0); PG8_MMA(1, 0, At, B0); PG8_BAR; PG8_SCHED;
            PG8_STAGE(PG8_SB(0, 1), b2 + hstepB, voffB);
            PG8_WAIT_V(6); PG8_BAR; PG8_MMA(1, 1, At, B1); PG8_BAR;
            PG8_LDB(B0, 1, 0); PG8_SCHED; PG8_LDA(At, 1, 0); PG8_STAGE(PG8_SA(0, 1), a2 + hstepA, voffA);
            PG8_WAIT_L(8); PG8_BAR; PG8_WAIT_L(0); PG8_MMA(0, 0, At, B0); PG8_BAR; PG8_SCHED;
            PG8_LDB(B1, 1, 1); PG8_STAGE(PG8_SB(1, 0), b3, voffB);
            PG8_BAR; PG8_WAIT_L(0); PG8_MMA(0, 1, At, B1); PG8_BAR;
            PG8_LDA(At, 1, 1); PG8_STAGE(PG8_SA(1, 0), a3, voffA);
            PG8_BAR; PG8_WAIT_L(0); PG8_MMA(1, 0, At, B0); PG8_BAR; PG8_SCHED;
            PG8_STAGE(PG8_SB(1, 1), b3 + hstepB, voffB);
            PG8_WAIT_V(6); PG8_BAR; PG8_MMA(1, 1, At, B1); PG8_BAR;
            }
        }
        if constexpr (ALIGN_EPI) { if (wr == 0) PG8_BAR; }
        if constexpr (!Epi::AFTER_DRAIN) { E(acc, cur, wr, wc, fr, fq); S.done(cur); }
        if (!has_next) break;
#pragma unroll
        for (int a = 0; a < 2; ++a)
#pragma unroll
            for (int b = 0; b < 2; ++b)
#pragma unroll
                for (int m = 0; m < 4; ++m)
#pragma unroll
                    for (int n = 0; n < 2; ++n) acc[a][b][m][n] = (f32x4){0.f, 0.f, 0.f, 0.f};
        cur = nxt; cA = nA; cB = nB; ++ui;
        if constexpr (ALIGN_EPI) { if (wr == 1) PG8_BAR; }
    }
    PG8_WAIT_V(0);
    if constexpr (!ALIGN_EPI) { if (wr == 0) PG8_BAR; }
    PG8_BAR;
    if constexpr (Epi::AFTER_DRAIN) { E.fused(acc, cur, wr, wc, fr, fq, lds, wid, lane); S.done(cur); }
#undef PG8_SA
#undef PG8_SB
#undef PG8_STAGE
#undef PG8_LDA
#undef PG8_LDB
#undef PG8_MMA
#undef PG8_WAIT_V
#undef PG8_WAIT_L
#undef PG8_BAR
#undef PG8_SCHED
}
}
constexpr int BATCH = 8, SEQ = 4096, DM = 1024, M = BATCH * SEQ;
constexpr int D_IN = 2644, NMAIN = 2304, NSPLIT = 512, KSPLIT = 2048, DFF = 4096;
constexpr int PM_GQ = 0, PM_GK = 256, PM_GV = 512, PM_GR = 1024, PM_DQ = 1536, PM_DK = 2048, PM_DV = 2176;
constexpr int PS_IQ = 0, PS_IK = 256, PS_IW = 320, PS_GLR = 324;
constexpr float EPS = 1e-6f;
constexpr int NWAVES = 8, NTHR = 512;
constexpr int NUNIT_GLA = BATCH * 4 * 64;
constexpr int TOPK = 256;

constexpr size_t MiB = 1u << 20;
constexpr size_t WS_CTL = 0, CTL_ZERO_BYTES = 1 * MiB;
constexpr int CW_BAR = 4096, CW_SS1 = 65536, CW_SS2 = 98304;
constexpr size_t WS_IW = 1 * MiB, WS_DECAY = 1 * MiB + 512 * 1024;
constexpr size_t WS_WINM = 2 * MiB, WS_WSPL = 7 * MiB, WS_WO = 10 * MiB, WS_W1 = 12 * MiB, WS_W2 = 20 * MiB;
constexpr size_t WS_TAB128 = 28 * MiB, WS_TAB64 = 30 * MiB, WS_QB = 31 * MiB;
constexpr size_t WS_HCAT = 32 * MiB;
constexpr size_t WS_QR = 32 * MiB, WS_KR = 64 * MiB, WS_IKH = 72 * MiB, WS_IKL = 76 * MiB, WS_IQH = 80 * MiB, WS_IQL = 96 * MiB, WS_MASK = 112 * MiB, WS_SIN = 128 * MiB;
constexpr size_t WS_PMAIN = 160 * MiB, WS_PSPL = 304 * MiB, WS_UT = 368 * MiB, WS_GQD = 400 * MiB, WS_GKI = 416 * MiB, WS_MIX = 432 * MiB;
constexpr size_t WS_ORAW = 160 * MiB, WS_HN = 32 * MiB, WS_HID = 256 * MiB, WS_FFRAW = 96 * MiB;
constexpr size_t WS_END = 512 * MiB;
constexpr int RING_BYTES = 131072, LDS_BYTES = 147456, MISC_OFF = LDS_BYTES - 256;

#define LAS __attribute__((address_space(3)))
typedef unsigned short bf16;
typedef unsigned v4u __attribute__((ext_vector_type(4)));
typedef unsigned v2u __attribute__((ext_vector_type(2)));
typedef float f32x4 __attribute__((ext_vector_type(4)));
typedef float f32x2 __attribute__((ext_vector_type(2)));
typedef short bf16x8 __attribute__((ext_vector_type(8)));
#define LDS_WAIT() asm volatile("s_waitcnt lgkmcnt(0)" ::: "memory")
__device__ __forceinline__ unsigned f2bf(float f) { unsigned u = __float_as_uint(f); return (u + 0x7fffu + ((u >> 16) & 1u)) >> 16; }
__device__ __forceinline__ float bf2f(unsigned h) { return __uint_as_float(h << 16); }
__device__ __forceinline__ unsigned pk2(float lo, float hi) { return f2bf(lo) | (f2bf(hi) << 16); }
__device__ __forceinline__ float wave_sum(float v) {
#pragma unroll
    for (int o = 1; o < 64; o <<= 1) v += __shfl_xor(v, o);
    return v;
}
__device__ __forceinline__ f32x4 mfma16(bf16x8 a, bf16x8 b, f32x4 c) { return __builtin_amdgcn_mfma_f32_16x16x32_bf16(a, b, c, 0, 0, 0); }
#define XB_TMO      128
#define XB_XCNT(j)  (256  + 64 * (j))
#define XB_XSUB(j)  (1280 + 64 * (j))
#define XB_XGEN(j)  (2304 + 64 * (j))
#define XB_TOP      3328
#define XB_TOPGEN   3392
#define XCD_BAR_WORDS 3456
#define XB_SPIN_CAP (1u << 18)

__device__ __forceinline__ unsigned xb_ld(unsigned* p)              { return __hip_atomic_load(p, __ATOMIC_RELAXED, __HIP_MEMORY_SCOPE_AGENT); }
__device__ __forceinline__ unsigned xb_add(unsigned* p, unsigned v) { return __hip_atomic_fetch_add(p, v, __ATOMIC_RELAXED, __HIP_MEMORY_SCOPE_AGENT); }
__device__ __forceinline__ unsigned xb_xcc_id() { return (unsigned)__builtin_amdgcn_s_getreg((3 << 11) | 20) & 0xFu; }
#define XB_SPIN(cond, bar) do { unsigned _sp = 0; while (cond) { __builtin_amdgcn_s_sleep(1); \
    if ((++_sp & 255u) == 0u) { if (xb_ld(&(bar)[XB_TMO])) break; if (_sp > XB_SPIN_CAP) { atomicAdd(&(bar)[XB_TMO], 1u); break; } } } } while (0)

struct XcdBarrier {
    unsigned* bar; unsigned x;
    volatile LAS unsigned* st;
};

__device__ __forceinline__ XcdBarrier xcd_barrier_post(unsigned* bar, volatile LAS unsigned* st) {
    XcdBarrier b; b.bar = bar; b.x = xb_xcc_id(); b.st = st;
    if (threadIdx.x == 0) (void)xb_add(&bar[XB_XCNT(b.x)], 1u);
    return b;
}
__device__ __forceinline__ void xcd_barrier_complete(unsigned* bar, unsigned x, unsigned& nloc, unsigned& nx) {
    const unsigned G = gridDim.x * gridDim.y * gridDim.z;
    unsigned sum, cnt, mine, sp = 0u;
    for (;;) {
        sum = 0u; cnt = 0u; mine = 0u;
#pragma unroll
        for (unsigned j = 0; j < 16; ++j) { const unsigned c = xb_ld(&bar[XB_XCNT(j)]); sum += c; cnt += (c > 0u) ? 1u : 0u; mine = (j == x) ? c : mine; }
        if (sum == G) break;
        __builtin_amdgcn_s_sleep(1);
        if ((++sp & 255u) == 0u) { if (xb_ld(&bar[XB_TMO])) break; if (sp > XB_SPIN_CAP) { atomicAdd(&bar[XB_TMO], 1u); break; } }
    }
    nloc = mine > 0u ? mine : 1u; nx = cnt > 0u ? cnt : 1u;
}

__device__ __forceinline__ void xcd_barrier(const XcdBarrier& b) {
    asm volatile("s_waitcnt vmcnt(0)" ::: "memory");
    __syncthreads();
    if (threadIdx.x == 0) {
        unsigned* bar = b.bar;
        __builtin_amdgcn_s_waitcnt(0);
        unsigned nloc = b.st[0], nx = b.st[1];
        if (nloc == 0u) { xcd_barrier_complete(bar, b.x, nloc, nx); b.st[0] = nloc; b.st[1] = nx; }
        const unsigned old = xb_add(&bar[XB_XSUB(b.x)], 1u);
        const unsigned gen = old / nloc;
        if (old + 1u == (gen + 1u) * nloc) {
            __builtin_amdgcn_fence(__ATOMIC_RELEASE, "agent");
            asm volatile("s_waitcnt vmcnt(0)" ::: "memory");
            const unsigned og = xb_add(&bar[XB_TOP], 1u);
            const unsigned tg = og / nx;
            if (og + 1u == (tg + 1u) * nx) xb_add(&bar[XB_TOPGEN], 1u);
            else XB_SPIN(xb_ld(&bar[XB_TOPGEN]) == tg, bar);
            __builtin_amdgcn_fence(__ATOMIC_ACQUIRE, "agent");
            xb_add(&bar[XB_XGEN(b.x)], 1u);
            asm volatile("s_waitcnt vmcnt(0)" ::: "memory");
        } else {
            XB_SPIN(xb_ld(&bar[XB_XGEN(b.x)]) == gen, bar);
            __builtin_amdgcn_fence(__ATOMIC_ACQUIRE, "agent");
            asm volatile("s_waitcnt vmcnt(0)" ::: "memory");
        }
    }
    __syncthreads();
}

__device__ __forceinline__ unsigned short f16bits(_Float16 h) { return __builtin_bit_cast(unsigned short, h); }
__device__ __forceinline__ unsigned pkh2(float lo, float hi) { return (unsigned)f16bits((_Float16)lo) | ((unsigned)f16bits((_Float16)hi) << 16); }
__device__ __forceinline__ float h2f(unsigned bits16) { return (float)__builtin_bit_cast(_Float16, (unsigned short)bits16); }
__device__ __forceinline__ int win_src_main(int j) { return j < 1024 ? j : j + 16; }
__device__ __forceinline__ int win_src_split(int j) { return j < 256 ? 2320 + j : (j < 320 ? 2576 + (j - 256) : (j < 324 ? 2640 + (j - 320) : (j < 340 ? 1024 + (j - 324) : -1))); }
template <int MODE>
__device__ __forceinline__ void p0_transpose_item(const float* W, int ldw, bf16* WT, int ldo, float* scr, int item, int nblk, int lane) {
    const int kb = item / nblk, nb = item % nblk, k0 = 64 * kb, n0 = 32 * nb;
    const int n = n0 + (lane & 31);
    const int sc = MODE == 0 ? n : (MODE == 1 ? win_src_main(n) : win_src_split(n));
    float wv[32];
#pragma unroll
    for (int i = 0; i < 32; ++i) { const int kk = 2 * i + (lane >> 5); wv[i] = sc >= 0 ? W[(size_t)(k0 + kk) * ldw + sc] : 0.f; }
#pragma unroll
    for (int i = 0; i < 32; ++i) { const int kk = 2 * i + (lane >> 5); scr[kk * 33 + (lane & 31)] = wv[i]; }
    LDS_WAIT();
    const int c = lane & 7;
#pragma unroll
    for (int j = 0; j < 4; ++j) { const int nn = (lane >> 3) + 8 * j; const float* s = scr + (8 * c) * 33 + nn;
        const float v0 = s[0 * 33], v1 = s[1 * 33], v2 = s[2 * 33], v3 = s[3 * 33], v4 = s[4 * 33], v5 = s[5 * 33], v6 = s[6 * 33], v7 = s[7 * 33];
        v4u o; if (MODE == 0) { o.x = pk2(v0, v1); o.y = pk2(v2, v3); o.z = pk2(v4, v5); o.w = pk2(v6, v7); } else { o.x = pkh2(v0, v1); o.y = pkh2(v2, v3); o.z = pkh2(v4, v5); o.w = pkh2(v6, v7); }
        bf16* dst = WT + (size_t)(n0 + nn) * ldo + k0 + 8 * c;
        *(v4u*)dst = o;
        if (MODE == 2) *(v4u*)(dst + 1024) = o; }
    LDS_WAIT();
}
__device__ __forceinline__ void p0_rms_finish(const f32x4 (&v)[4], const float* w, bf16* orow, int lane) {
    const f32x4* wr = (const f32x4*)w + lane; float s = 0.f;
#pragma unroll
    for (int j = 0; j < 4; ++j) s += (v[j].x * v[j].x + v[j].y * v[j].y) + (v[j].z * v[j].z + v[j].w * v[j].w);
    const float r = 1.0f / sqrtf(wave_sum(s) * (1.f / DM) + EPS);
    unsigned long long* oh = (unsigned long long*)orow + lane; unsigned long long* ol = (unsigned long long*)(orow + 1024) + lane;
#pragma unroll
    for (int j = 0; j < 4; ++j) { const f32x4 y = (v[j] * r) * wr[64 * j];
        const unsigned h0 = pkh2(y.x, y.y), h1 = pkh2(y.z, y.w);
        const unsigned l0 = pkh2(y.x - h2f(h0 & 0xffffu), y.y - h2f(h0 >> 16)), l1 = pkh2(y.z - h2f(h1 & 0xffffu), y.w - h2f(h1 >> 16));
        oh[64 * j] = (unsigned long long)h0 | ((unsigned long long)h1 << 32); ol[64 * j] = (unsigned long long)l0 | ((unsigned long long)l1 << 32); }
}
__device__ __forceinline__ void p0_rms_rows(const float* x, const float* w, bf16* hcat, int gw, int NGW, int lane) {
    if (gw >= M) return;
    f32x4 cur[4], nxt[4];
#pragma unroll
    for (int j = 0; j < 4; ++j) cur[j] = __builtin_nontemporal_load((const f32x4*)(x + (size_t)gw * DM) + lane + 64 * j);
    for (int m = gw; m < M; m += NGW) { const int mn = (m + NGW < M) ? m + NGW : m;
#pragma unroll
        for (int j = 0; j < 4; ++j) nxt[j] = __builtin_nontemporal_load((const f32x4*)(x + (size_t)mn * DM) + lane + 64 * j);
        p0_rms_finish(cur, w, hcat + (size_t)m * 2048, lane);
#pragma unroll
        for (int j = 0; j < 4; ++j) cur[j] = nxt[j]; }
}
__device__ __forceinline__ void sincos_f64(double a, double& sn, double& cs) {
    const double kd = rint(a * 0.63661977236758134308);
    const double r = (a - kd * 1.57079632673412561417e+00) - kd * 6.07710050650619224932e-11;
    const double z = r * r;
    const double ps = 8.33333333332248946124e-03 + z * (-1.98412698298579493134e-04 + z * (2.75573137070700676789e-06 + z * (-2.50507602534068634195e-08 + z * 1.58969099521155010221e-10)));
    const double s = r + (z * r) * (-1.66666666666666324348e-01 + z * ps);
    const double pc = z * (4.16666666666666019037e-02 + z * (-1.38888888888741095749e-03 + z * (2.48015872894767294178e-05 + z * (-2.75573143513906633035e-07 + z * (2.08757232129817482790e-09 + z * -1.13596475577881948265e-11)))));
    const double c = 1.0 - (0.5 * z - z * pc);
    const int q = ((int)kd) & 3;
    sn = (q == 0) ? s : (q == 1) ? c : (q == 2) ? -s : -c;
    cs = (q == 0) ? c : (q == 1) ? -s : (q == 2) ? -c : s;
}
struct P0Args { const float *x, *nw, *w_in, *w_out, *w1, *w2; bf16 *hcat, *winm, *wspl, *wo, *w1t, *w2t; f32x2 *tab128, *tab64; };
__device__ __forceinline__ void p0_prologue(const P0Args& a, char* ldsg, int bid, int G, int tid) {
    const int lane = tid & 63, wave = tid >> 6;
    float* scr = (float*)(ldsg + wave * 16384);
    const int gw = bid * NWAVES + wave, NGW = G * NWAVES;
    constexpr int I_M = 16 * (NMAIN / 32), I_S = 16 * (NSPLIT / 32), I_O = 16 * (DM / 32), I_1 = 16 * (DFF / 32), I_2 = 64 * (DM / 32);
    for (int it = gw; it < I_M + I_S + I_O + I_1 + I_2; it += NGW) {
        int r = it;
        if (r < I_M) { p0_transpose_item<1>(a.w_in, D_IN, a.winm, 1024, scr, r, NMAIN / 32, lane); continue; } r -= I_M;
        if (r < I_S) { p0_transpose_item<2>(a.w_in, D_IN, a.wspl, KSPLIT, scr, r, NSPLIT / 32, lane); continue; } r -= I_S;
        if (r < I_O) { p0_transpose_item<0>(a.w_out, DM, a.wo, 1024, scr, r, DM / 32, lane); continue; } r -= I_O;
        if (r < I_1) { p0_transpose_item<0>(a.w1, DFF, a.w1t, 1024, scr, r, DFF / 32, lane); continue; } r -= I_1;
        p0_transpose_item<0>(a.w2, DM, a.w2t, DFF, scr, r, DM / 32, lane);
    }
    p0_rms_rows(a.x, a.nw, a.hcat, gw, NGW, lane);
    for (int e = bid * NTHR + tid; e < SEQ * 96; e += G * NTHR) {
        const int s = e / 96, j = e % 96; const bool big = j < 64; const int i = big ? j : j - 64;
        const double base = big ? 0.8659643233600653 : 0.7498942093324558;
        double p = 1.0; for (int k = 0; k < i; ++k) p *= base;
        const double ang = (double)s * (double)(float)p; double sn, cs; sincos_f64(ang, sn, cs);
        const f32x2 o = {(float)cs, (float)sn};
        if (big) a.tab128[s * 64 + i] = o; else a.tab64[s * 32 + i] = o;
    }
}

struct P2Args { const bf16* pmain; const float* pspl; const f32x2 *tab128, *tab64; const float *lnw, *lnb; bf16 *qr, *kr, *ikh, *ikl, *iqh, *iql; float* iw; float* qb; };
struct P2In { unsigned short k1, k2, q1[4], q2[4]; float iq1[2], iq2[2], iwr[2], ik, iw4; f32x2 cs, c2; };
__device__ __forceinline__ void p2_load(P2In& r, const P2Args& a, int m, int lane) {
    const int s = m & (SEQ - 1);
    const bf16* pm = a.pmain + (size_t)m * NMAIN; const float* ps = a.pspl + (size_t)m * NSPLIT;
    r.cs = a.tab128[s * 64 + lane]; r.c2 = a.tab64[s * 32 + (lane & 31)];
    r.k1 = pm[PM_DK + lane]; r.k2 = pm[PM_DK + 64 + lane];
#pragma unroll
    for (int h = 0; h < 4; ++h) { r.q1[h] = pm[PM_DQ + h * 128 + lane]; r.q2[h] = pm[PM_DQ + h * 128 + 64 + lane]; }
#pragma unroll
    for (int e = 0; e < 2; ++e) { const int h = 2 * e + (lane >> 5), i = lane & 31; r.iq1[e] = ps[PS_IQ + h * 64 + i]; r.iq2[e] = ps[PS_IQ + h * 64 + 32 + i]; r.iwr[e] = ps[PS_IW + h]; }
    r.ik = ps[PS_IK + lane]; r.iw4 = ps[PS_IW + (lane & 3)];
}
__device__ __forceinline__ void p2_post_row(const P2In& r, const P2Args& a, int m, int lane) {
    const int s = m & (SEQ - 1);
    const f32x2 cs = r.cs;
    { const float x1 = bf2f(r.k1), x2 = bf2f(r.k2);
      a.kr[(size_t)m * 128 + lane] = (bf16)f2bf(x1 * cs.x - x2 * cs.y); a.kr[(size_t)m * 128 + 64 + lane] = (bf16)f2bf(x2 * cs.x + x1 * cs.y); }
#pragma unroll
    for (int h = 0; h < 4; ++h) { const float x1 = bf2f(r.q1[h]), x2 = bf2f(r.q2[h]);
      a.qr[(size_t)m * 512 + h * 128 + lane] = (bf16)f2bf(x1 * cs.x - x2 * cs.y); a.qr[(size_t)m * 512 + h * 128 + 64 + lane] = (bf16)f2bf(x2 * cs.x + x1 * cs.y); }
    const f32x2 c2 = r.c2;
    float qn = 0.f;
#pragma unroll
    for (int e = 0; e < 2; ++e) { const int h = 2 * e + (lane >> 5), i = lane & 31;
      const float x1 = r.iq1[e], x2 = r.iq2[e];
      const float wr = r.iwr[e];
      const float o1 = (x1 * c2.x - x2 * c2.y) * wr, o2 = (x2 * c2.x + x1 * c2.y) * wr;
      float sq = o1 * o1 + o2 * o2;
#pragma unroll
      for (int o = 1; o < 32; o <<= 1) sq += __shfl_xor(sq, o);
      qn += sqrtf(sq);
      const _Float16 h1 = (_Float16)o1, h2 = (_Float16)o2; const size_t p = ((size_t)m * 4 + h) * 64 + i;
      a.iqh[p] = f16bits(h1); a.iqh[p + 32] = f16bits(h2); a.iql[p] = f16bits((_Float16)(o1 - (float)h1)); a.iql[p + 32] = f16bits((_Float16)(o2 - (float)h2)); }
    qn += __shfl_xor(qn, 32);
    if (lane == 0) a.qb[m] = qn;
    { const float v = r.ik; const float mu = wave_sum(v) * (1.f / 64.f); const float d = v - mu; const float var = wave_sum(d * d) * (1.f / 64.f);
      const float y = d * (1.0f / sqrtf(var + EPS)) * a.lnw[lane] + a.lnb[lane];
      const float other = __shfl_xor(y, 32);
      const float o = lane < 32 ? (y * c2.x - other * c2.y) : (y * c2.x + other * c2.y);
      const size_t p = (size_t)(m >> 12) * (SEQ * 64) + (size_t)(s >> 4) * 1024 + (lane >> 5) * 512 + ((((lane & 31) >> 3) * 16 + (s & 15)) * 8) + (lane & 7);
      a.ikh[p] = f16bits((_Float16)o); }
    if (lane < 4) a.iw[(size_t)m * 4 + lane] = (r.iw4 < 0.f) ? -__builtin_inff() : __builtin_inff();
}
__device__ __forceinline__ void p2_post_rows(const P2Args& a, int gw, int NGW, int lane) {
    if (gw >= M) return;
    P2In cur, nxt; p2_load(cur, a, gw, lane);
    for (int m = gw; m < M; m += NGW) { const int mn = (m + NGW < M) ? m + NGW : m;
        p2_load(nxt, a, mn, lane); p2_post_row(cur, a, m, lane); cur = nxt; }
}

constexpr int GLA_LD = 72;
struct GlaArgs { const bf16* pmain; const float* pspl; const float *gw2, *gb, *gnw; bf16* ut; float* decay; bf16* sin_; bf16* mix; bf16* gqd; bf16* gki; };
struct GlaPre { f32x2 glr, w2; float gbv; v4u k, q, v0, v1; };
template <bool WITH_Q>
__device__ __forceinline__ void gla_prefetch(GlaPre& p, const GlaArgs& a, int u, int tid) {
    const int b = u >> 8, h = (u >> 6) & 3, n = u & 63, m0 = b * SEQ + n * 64;
    { const int i = 2 * tid, t = i >> 4, j = i & 15; p.glr = *(const f32x2*)(a.pspl + (size_t)(m0 + t) * NSPLIT + PS_GLR + j); }
    { const int i = 2 * tid, j = i >> 6, d = i & 63; p.w2 = *(const f32x2*)(a.gw2 + j * 256 + h * 64 + d); }
    p.gbv = a.gb[h * 64 + (tid & 63)];
    const bf16* row = a.pmain + (size_t)(m0 + (tid & 63)) * NMAIN;
    p.k = *(const v4u*)(row + PM_GK + h * 64 + 8 * (tid >> 6));
    if (WITH_Q) p.q = *(const v4u*)(row + PM_GQ + h * 64 + 8 * (tid >> 6));
    p.v0 = *(const v4u*)(row + PM_GV + h * 128 + 8 * (tid >> 6)); p.v1 = *(const v4u*)(row + PM_GV + h * 128 + 64 + 8 * (tid >> 6));
}
constexpr int GS_LD = 65;
__device__ __forceinline__ void gla_bcum(const GlaPre& p, float* Gs, float* glr, float* w2s, float* gbs, int tid) {
    *(f32x2*)(glr + 2 * tid) = p.glr; *(f32x2*)(w2s + 2 * tid) = p.w2; if (tid < 64) gbs[tid] = p.gbv;
    __syncthreads();
    { const int d = tid & 63; float wc[16];
#pragma unroll
      for (int j = 0; j < 16; ++j) wc[j] = w2s[j * 64 + d];
      const float bias = gbs[d];
#pragma unroll
      for (int e = 0; e < 8; ++e) { const int t = (tid >> 6) + 8 * e; const f32x4* g4 = (const f32x4*)(glr + t * 16); float z = 0.f;
#pragma unroll
          for (int j4 = 0; j4 < 4; ++j4) { const f32x4 gv = g4[j4]; z += gv.x * wc[4 * j4]; z += gv.y * wc[4 * j4 + 1]; z += gv.z * wc[4 * j4 + 2]; z += gv.w * wc[4 * j4 + 3]; }
          z += bias;
          Gs[t * GS_LD + d] = (fminf(z, 0.f) - __logf(1.f + __expf(-fabsf(z)))) * (1.f / 16.f); } }
    __syncthreads();
    if (tid < 64) { float c[64];
#pragma unroll
        for (int t = 0; t < 64; ++t) c[t] = Gs[t * GS_LD + tid];
#pragma unroll
        for (int t = 1; t < 64; ++t) c[t] += c[t - 1];
#pragma unroll
        for (int t = 0; t < 64; ++t) Gs[t * GS_LD + tid] = c[t]; }
    __syncthreads();
}
__device__ __forceinline__ float bfl(unsigned w) { return __uint_as_float(w << 16); }
__device__ __forceinline__ float bfh(unsigned w) { return __uint_as_float(w & 0xffff0000u); }
__device__ __forceinline__ void gla_local_phase(const GlaArgs& a, char* ldsg, int bid, int G, int tid) {
    const int lane = tid & 63, w = tid >> 6, quad = lane >> 4, l15 = lane & 15;
    float* Gs = (float*)ldsg; float* glr = Gs + 64 * GS_LD + 32; float* w2s = glr + 1024; float* gbs = w2s + 1024; bf16* kT = (bf16*)(gbs + 64); bf16* vT = kT + 64 * GLA_LD;
    if (bid >= NUNIT_GLA) return;
    GlaPre cur, nxt; gla_prefetch<true>(cur, a, bid, tid);
    for (int u = bid; u < NUNIT_GLA; u += G) {
        const int un = (u + G < NUNIT_GLA) ? u + G : u; gla_prefetch<true>(nxt, a, un, tid);
        __syncthreads();
        gla_bcum(cur, Gs, glr, w2s, gbs, tid);
        { const int t = tid & 63, d0 = 8 * (tid >> 6); const unsigned kw[4] = {cur.k.x, cur.k.y, cur.k.z, cur.k.w}, qw[4] = {cur.q.x, cur.q.y, cur.q.z, cur.q.w}; unsigned qo[4], ko[4]; const unsigned v0w[4] = {cur.v0.x, cur.v0.y, cur.v0.z, cur.v0.w}, v1w[4] = {cur.v1.x, cur.v1.y, cur.v1.z, cur.v1.w};
#pragma unroll
          for (int e = 0; e < 4; ++e) { const int d = d0 + 2 * e; const float g0 = Gs[t * GS_LD + d], g1 = Gs[t * GS_LD + d + 1];
              qo[e] = pk2(bfl(qw[e]) * 0.125f * __expf(g0), bfh(qw[e]) * 0.125f * __expf(g1)); ko[e] = pk2(bfl(kw[e]) * __expf(-g0), bfh(kw[e]) * __expf(-g1));
              kT[d * GLA_LD + t] = (bf16)f2bf(bfl(kw[e]) * __expf(Gs[63 * GS_LD + d] - Gs[t * GS_LD + d])); kT[(d + 1) * GLA_LD + t] = (bf16)f2bf(bfh(kw[e]) * __expf(Gs[63 * GS_LD + d + 1] - Gs[t * GS_LD + d + 1]));
              vT[d * GLA_LD + t] = (bf16)(v0w[e] & 0xffffu); vT[(d + 1) * GLA_LD + t] = (bf16)(v0w[e] >> 16);
              vT[(64 + d) * GLA_LD + t] = (bf16)(v1w[e] & 0xffffu); vT[(64 + d + 1) * GLA_LD + t] = (bf16)(v1w[e] >> 16); }
          *(v4u*)(a.gqd + (size_t)u * 4096 + t * 64 + d0) = (v4u){qo[0], qo[1], qo[2], qo[3]}; *(v4u*)(a.gki + (size_t)u * 4096 + t * 64 + d0) = (v4u){ko[0], ko[1], ko[2], ko[3]}; }
        if (tid < 64) a.decay[(size_t)u * 64 + tid] = __expf(Gs[63 * GS_LD + tid]);
        __syncthreads();
        f32x4 acc[4];
#pragma unroll
        for (int dt = 0; dt < 4; ++dt) acc[dt] = (f32x4){0.f, 0.f, 0.f, 0.f};
#pragma unroll
        for (int ks = 0; ks < 2; ++ks) { const bf16x8 af = *(const bf16x8*)(vT + (16 * w + l15) * GLA_LD + ks * 32 + 8 * quad);
#pragma unroll
            for (int dt = 0; dt < 4; ++dt) { const bf16x8 bfr = *(const bf16x8*)(kT + (16 * dt + l15) * GLA_LD + ks * 32 + 8 * quad); acc[dt] = mfma16(af, bfr, acc[dt]); } }
        bf16* uo = a.ut + (size_t)u * 8192;
#pragma unroll
        for (int dt = 0; dt < 4; ++dt)
#pragma unroll
            for (int r = 0; r < 4; ++r) uo[(16 * w + 4 * quad + r) * 64 + 16 * dt + l15] = (bf16)f2bf(acc[dt][r]);
        cur = nxt;
    }
}
__device__ __forceinline__ void gla_scan(const GlaArgs& a, int bid, int G, int tid) {
    for (int idx = bid * NTHR + tid; idx < 32 * 4096; idx += G * NTHR) {
        const int bh = idx >> 12, e = idx & 4095, d = e & 63; float s0 = 0.f, s1 = 0.f;
        const bf16* up = a.ut + (size_t)bh * 64 * 8192 + e; const float* dp = a.decay + (size_t)bh * 64 * 64 + d; bf16* sp = a.sin_ + (size_t)bh * 64 * 8192 + e;
#pragma nounroll
        for (int n0 = 0; n0 < 64; n0 += 8) {
            float u0[8], u1[8], dc[8];
#pragma unroll
            for (int k = 0; k < 8; ++k) { u0[k] = bf2f(up[(size_t)(n0 + k) * 8192]); u1[k] = bf2f(up[(size_t)(n0 + k) * 8192 + 4096]); dc[k] = dp[(n0 + k) * 64]; }
#pragma unroll
            for (int k = 0; k < 8; ++k) { sp[(size_t)(n0 + k) * 8192] = (bf16)f2bf(s0); sp[(size_t)(n0 + k) * 8192 + 4096] = (bf16)f2bf(s1); s0 = dc[k] * s0 + u0[k]; s1 = dc[k] * s1 + u1[k]; }
        }
    }
}
struct GlaPreO { v4u qd, ki, v0, v1; };
__device__ __forceinline__ void gla_prefetch_o(GlaPreO& p, const GlaArgs& a, int u, int tid) {
    const int b = u >> 8, h = (u >> 6) & 3, n = u & 63, m0 = b * SEQ + n * 64, t = tid & 63, d0 = 8 * (tid >> 6);
    p.qd = *(const v4u*)(a.gqd + (size_t)u * 4096 + t * 64 + d0); p.ki = *(const v4u*)(a.gki + (size_t)u * 4096 + t * 64 + d0);
    const bf16* row = a.pmain + (size_t)(m0 + t) * NMAIN + PM_GV + h * 128;
    p.v0 = *(const v4u*)(row + d0); p.v1 = *(const v4u*)(row + 64 + d0);
}
__device__ __forceinline__ void gla_out_phase(const GlaArgs& a, char* ldsg, int bid, int G, int tid) {
    const int lane = tid & 63, w = tid >> 6, quad = lane >> 4, l15 = lane & 15;
    bf16* Qd = (bf16*)ldsg; bf16* Ki = Qd + 64 * GLA_LD; bf16* vT = Ki + 64 * GLA_LD; bf16* At = vT + 128 * GLA_LD;
    float* part = (float*)(At + 64 * GLA_LD);
    if (bid >= NUNIT_GLA) return;
    const int rt = w & 3, ch = w >> 2;
    GlaPreO cur, nxt; gla_prefetch_o(cur, a, bid, tid);
    for (int u = bid; u < NUNIT_GLA; u += G) {
        const int b = u >> 8, h = (u >> 6) & 3, n = u & 63, m0 = b * SEQ + n * 64;
        const int un = (u + G < NUNIT_GLA) ? u + G : u; gla_prefetch_o(nxt, a, un, tid);
        bf16x8 sfr[2][4]; unsigned short rg[4][4];
        { const bf16* Sg = a.sin_ + (size_t)u * 8192;
#pragma unroll
          for (int ks = 0; ks < 2; ++ks)
#pragma unroll
            for (int vt = 0; vt < 4; ++vt) sfr[ks][vt] = *(const bf16x8*)(Sg + (16 * (4 * ch + vt) + l15) * 64 + ks * 32 + 8 * quad);
#pragma unroll
          for (int r = 0; r < 4; ++r)
#pragma unroll
            for (int vt = 0; vt < 4; ++vt) rg[r][vt] = a.pmain[(size_t)(m0 + 16 * rt + 4 * quad + r) * NMAIN + PM_GR + h * 128 + 16 * (4 * ch + vt) + l15]; }
        __syncthreads();
        { const int t = tid & 63, d0 = 8 * (tid >> 6);
          const unsigned v0w[4] = {cur.v0.x, cur.v0.y, cur.v0.z, cur.v0.w}, v1w[4] = {cur.v1.x, cur.v1.y, cur.v1.z, cur.v1.w};
#pragma unroll
          for (int e = 0; e < 4; ++e) { const int d = d0 + 2 * e;
              vT[d * GLA_LD + t] = (bf16)(v0w[e] & 0xffffu); vT[(d + 1) * GLA_LD + t] = (bf16)(v0w[e] >> 16);
              vT[(64 + d) * GLA_LD + t] = (bf16)(v1w[e] & 0xffffu); vT[(64 + d + 1) * GLA_LD + t] = (bf16)(v1w[e] >> 16); }
          *(v4u*)(Qd + t * GLA_LD + d0) = cur.qd; *(v4u*)(Ki + t * GLA_LD + d0) = cur.ki; }
        __syncthreads();
        {
            f32x4 s2[2] = {(f32x4){0.f, 0.f, 0.f, 0.f}, (f32x4){0.f, 0.f, 0.f, 0.f}};
#pragma unroll
            for (int ks = 0; ks < 2; ++ks) { const bf16x8 af = *(const bf16x8*)(Qd + (16 * rt + l15) * GLA_LD + ks * 32 + 8 * quad);
#pragma unroll
                for (int j2 = 0; j2 < 2; ++j2) { const bf16x8 bfr = *(const bf16x8*)(Ki + (16 * (2 * ch + j2) + l15) * GLA_LD + ks * 32 + 8 * quad); s2[j2] = mfma16(af, bfr, s2[j2]); } }
#pragma unroll
            for (int j2 = 0; j2 < 2; ++j2)
#pragma unroll
                for (int r = 0; r < 4; ++r) { const int i = 16 * rt + 4 * quad + r, j = 16 * (2 * ch + j2) + l15; At[i * GLA_LD + j] = (bf16)f2bf(j <= i ? s2[j2][r] : 0.f); }
        }
        __syncthreads();
        f32x4 o[4];
#pragma unroll
        for (int vt = 0; vt < 4; ++vt) o[vt] = (f32x4){0.f, 0.f, 0.f, 0.f};
#pragma unroll
        for (int ks = 0; ks < 2; ++ks) {
            const bf16x8 a1 = *(const bf16x8*)(At + (16 * rt + l15) * GLA_LD + ks * 32 + 8 * quad);
            const bf16x8 a2 = *(const bf16x8*)(Qd + (16 * rt + l15) * GLA_LD + ks * 32 + 8 * quad);
#pragma unroll
            for (int vt = 0; vt < 4; ++vt) { const bf16x8 b1 = *(const bf16x8*)(vT + (16 * (4 * ch + vt) + l15) * GLA_LD + ks * 32 + 8 * quad);
                o[vt] = mfma16(a1, b1, o[vt]); o[vt] = mfma16(a2, sfr[ks][vt], o[vt]); } }
#pragma unroll
        for (int r = 0; r < 4; ++r) { float sq = 0.f;
#pragma unroll
            for (int vt = 0; vt < 4; ++vt) sq += o[vt][r] * o[vt][r];
            sq += __shfl_xor(sq, 1); sq += __shfl_xor(sq, 2); sq += __shfl_xor(sq, 4); sq += __shfl_xor(sq, 8);
            if (l15 == 0) part[ch * 64 + 16 * rt + 4 * quad + r] = sq; }
        __syncthreads();
#pragma unroll
        for (int r = 0; r < 4; ++r) { const int i = 16 * rt + 4 * quad + r; const float rstd = 1.0f / sqrtf((part[i] + part[64 + i]) * (1.f / 128.f) + EPS);
#pragma unroll
            for (int vt = 0; vt < 4; ++vt) { const int v = 16 * (4 * ch + vt) + l15; const float rgf = bf2f(rg[r][vt]);
                a.mix[(size_t)(m0 + i) * 1024 + h * 128 + v] = (bf16)f2bf(o[vt][r] * rstd * a.gnw[v] * (rgf / (1.f + __expf(-rgf)))); } }
        cur = nxt;
    }
}

template <class T> __device__ __forceinline__ T ntl(const T* p) { return __builtin_nontemporal_load(p); }
template <class T> __device__ __forceinline__ void nts(T* p, T v) { __builtin_nontemporal_store(v, p); }
struct RowBuf { f32x4 x[4]; v2u r[4]; };
__device__ __forceinline__ void row_load(RowBuf& b, const float* xrow, const bf16* raw, int lane) {
#pragma unroll
    for (int j = 0; j < 4; ++j) { b.x[j] = ntl((const f32x4*)xrow + lane + 64 * j); b.r[j] = ntl((const v2u*)raw + lane + 64 * j); }
}
__device__ __forceinline__ f32x4 bf4(v2u rw);
__device__ __forceinline__ float row_ss(const v2u (&r)[4]);
__device__ __forceinline__ f32x4 bf4(v2u rw) { return (f32x4){bf2f(rw.x & 0xffffu), bf2f(rw.x >> 16), bf2f(rw.y & 0xffffu), bf2f(rw.y >> 16)}; }
__device__ __forceinline__ void p6_finish(const RowBuf& b, const float* wpost, const float* wpre, bf16* x1b, bf16* hn, int lane) {
    const float r1 = 1.0f / sqrtf(row_ss(b.r) * (1.f / DM) + EPS);
    f32x4 v[4]; float s = 0.f;
#pragma unroll
    for (int j = 0; j < 4; ++j) { v[j] = b.x[j] + (bf4(b.r[j]) * r1) * ((const f32x4*)wpost)[lane + 64 * j];
        s += (v[j].x * v[j].x + v[j].y * v[j].y) + (v[j].z * v[j].z + v[j].w * v[j].w);
        v2u o; o.x = pk2(v[j].x, v[j].y); o.y = pk2(v[j].z, v[j].w); ((v2u*)x1b)[lane + 64 * j] = o; }
    const float r2 = 1.0f / sqrtf(wave_sum(s) * (1.f / DM) + EPS);
#pragma unroll
    for (int j = 0; j < 4; ++j) { const f32x4 wv = ((const f32x4*)wpre)[lane + 64 * j]; const f32x4 y = (v[j] * r2) * wv;
        v2u o; o.x = pk2(y.x, y.y); o.y = pk2(y.z, y.w); ((v2u*)hn)[lane + 64 * j] = o; }
}
__device__ __forceinline__ float row_ss(const v2u (&r)[4]) { float s = 0.f;
#pragma unroll
    for (int j = 0; j < 4; ++j) { const f32x4 o = bf4(r[j]); s += (o.x * o.x + o.y * o.y) + (o.z * o.z + o.w * o.w); }
    return wave_sum(s); }
__device__ __forceinline__ void p6_rows(const float* x, bf16* raw, const float* wpost, const float* wpre, bf16* hn, int gw, int NGW, int lane) {
    if (gw >= M) return;
    RowBuf cur, nxt; row_load(cur, x + (size_t)gw * DM, raw + (size_t)gw * DM, lane);
    for (int m = gw; m < M; m += NGW) { const int mn = (m + NGW < M) ? m + NGW : m;
        if (mn != m) row_load(nxt, x + (size_t)mn * DM, raw + (size_t)mn * DM, lane);
        p6_finish(cur, wpost, wpre, raw + (size_t)m * DM, hn + (size_t)m * DM, lane); cur = nxt; }
}
__device__ __forceinline__ void p9_rows(const bf16* x1b, const bf16* raw2, const float* wpost2, float* out, int gw, int NGW, int lane) {
    if (gw >= M) return;
    v2u cx[4], c2[4], nx[4], n2[4];
#pragma unroll
    for (int j = 0; j < 4; ++j) { cx[j] = ntl((const v2u*)(x1b + (size_t)gw * DM) + lane + 64 * j); c2[j] = ntl((const v2u*)(raw2 + (size_t)gw * DM) + lane + 64 * j); }
    for (int m = gw; m < M; m += NGW) { const int mn = (m + NGW < M) ? m + NGW : m;
#pragma unroll
        for (int j = 0; j < 4; ++j) { nx[j] = ntl((const v2u*)(x1b + (size_t)mn * DM) + lane + 64 * j); n2[j] = ntl((const v2u*)(raw2 + (size_t)mn * DM) + lane + 64 * j); }
        const float r2 = 1.0f / sqrtf(row_ss(c2) * (1.f / DM) + EPS);
#pragma unroll
        for (int j = 0; j < 4; ++j) nts((f32x4*)(out + (size_t)m * DM) + lane + 64 * j, bf4(cx[j]) + (bf4(c2[j]) * r2) * ((const f32x4*)wpost2)[lane + 64 * j]);
#pragma unroll
        for (int j = 0; j < 4; ++j) { cx[j] = nx[j]; c2[j] = n2[j]; } }
}
__device__ __forceinline__ unsigned okey_of(float s) { const unsigned u = __float_as_uint(s); return (u & 0x80000000u) ? ~u : (u | 0x80000000u); }
__device__ __forceinline__ void cnt_ge(unsigned& n, unsigned k, unsigned c) { asm volatile("v_cmp_ge_u32 vcc, %1, %2\n\tv_addc_co_u32 %0, vcc, 0, %0, vcc" : "+v"(n) : "v"(k), "v"(c) : "vcc"); }
__device__ __forceinline__ void cnt_gt(unsigned& n, unsigned k, unsigned c) { asm volatile("v_cmp_gt_u32 vcc, %1, %2\n\tv_addc_co_u32 %0, vcc, 0, %0, vcc" : "+v"(n) : "v"(k), "v"(c) : "vcc"); }
__device__ __forceinline__ void cnt_tie(unsigned& n, unsigned k, unsigned T, unsigned lo, unsigned c) { unsigned tmp;
    asm volatile("v_cmp_eq_u32 vcc, %2, %3\n\tv_cndmask_b32 %1, 0, %4, vcc\n\tv_cmp_ge_u32 vcc, %1, %5\n\tv_addc_co_u32 %0, vcc, 0, %0, vcc" : "+v"(n), "=&v"(tmp) : "v"(k), "v"(T), "v"(lo), "v"(c) : "vcc"); }
#ifndef PROBE_IDX
#define PROBE_IDX 0
#endif
typedef _Float16 f16x8 __attribute__((ext_vector_type(8)));
__device__ __forceinline__ f32x4 mfma16h(f16x8 a, f16x8 b, f32x4 c) { return __builtin_amdgcn_mfma_f32_16x16x32_f16(a, b, c, 0, 0, 0); }
struct IdxArgs { const bf16 *iqh, *iql, *ikh, *ikl; const float* iw; unsigned short* mask16; const float* qb; float kbound; };
constexpr int IDX_ROUNDS = 45;
constexpr int IDX_NB = 2048, IDX_CAP = 512;
constexpr int IDX_HIST = 0, IDX_CAND = 8 * IDX_NB * 4, IDX_SMALL = IDX_CAND + 8 * IDX_CAP * 8;
__device__ __forceinline__ float okey_to_f(unsigned k) { return __uint_as_float((k & 0x80000000u) ? (k & 0x7fffffffu) : ~k); }
__device__ __forceinline__ unsigned idx_bin(float s, float inv) { return min((unsigned)__builtin_fmaf(s, inv, 0.5f * IDX_NB), (unsigned)(IDX_NB - 1)); }
template <int NI, int PV>
__device__ __forceinline__ void indexer_unit_t(const IdxArgs& a, int b, int c, int g, char* ldsg, int tid, int probe) {
    int lane_ = tid & 63; asm volatile("" : "+v"(lane_));
    const int lane = lane_, w = __builtin_amdgcn_readfirstlane(tid >> 6), quad = lane >> 4, l15 = lane & 15;
    const int q0 = b * SEQ + c * 64 + g * 8, ntile = 4 * (c + 1), nloc = (ntile - w + 7) >> 3;
    unsigned* hist = (unsigned*)(ldsg + IDX_HIST); unsigned long long* cand = (unsigned long long*)(ldsg + IDX_CAND); unsigned* sm = (unsigned*)(ldsg + IDX_SMALL);
    unsigned* qmin = sm; unsigned* qmax = sm + 8; unsigned* bstar = sm + 16; unsigned* above = sm + 24; unsigned* candn = sm + 32; unsigned* Tq = sm + 40; unsigned* Lq = sm + 48; unsigned* ovf = sm + 56; unsigned* dump = sm + 60; unsigned* cnt = sm + 64;
    __syncthreads();
    { v4u z = {0u, 0u, 0u, 0u}; v4u* h4 = (v4u*)hist;
#pragma unroll
      for (int k = 0; k < 8; ++k) h4[tid + k * NTHR] = z;
      if (tid < 8) candn[tid] = 0u;
      if (tid == 8) ovf[0] = 0u; }
    f16x8 aqh[2][2], aql[2][2]; f32x4 wq[2];
#pragma unroll
    for (int rt = 0; rt < 2; ++rt) {
#pragma unroll
        for (int ks = 0; ks < 2; ++ks) { const size_t p = ((size_t)(q0 + rt * 4 + (l15 >> 2)) * 4 + (l15 & 3)) * 64 + ks * 32 + 8 * quad;
            aqh[rt][ks] = *(const f16x8*)(a.iqh + p); aql[rt][ks] = *(const f16x8*)(a.iql + p); }
        wq[rt] = *(const f32x4*)(a.iw + (size_t)(q0 + rt * 4 + quad) * 4); }
    float sc[NI][2];
    const float kmx = a.kbound * 0.1666667f; const float inv0 = (0.5f * IDX_NB) / (a.qb[q0 + quad] * kmx), inv1 = (0.5f * IDX_NB) / (a.qb[q0 + 4 + quad] * kmx);
    __syncthreads();
    const char* khb = (const char*)a.ikh + (size_t)b * SEQ * 128;
    const unsigned koff = (unsigned)lane * 16u;
    constexpr int RING = 8;
    f16x8 kb[RING][2];
#define IDX_LOAD(i) do { const int tc_ = (probe >= 4) ? 0 : min(w + 8 * (i), ntile - 1); const unsigned o_ = koff + (unsigned)tc_ * 2048u; kb[(i) % RING][0] = *(const f16x8*)(khb + o_); kb[(i) % RING][1] = *(const f16x8*)(khb + (o_ + 1024u)); } while (0)
#pragma unroll
    for (int i = 0; i < RING - 1; ++i) IDX_LOAD(i);
#pragma unroll
    for (int i = 0; i < NI; ++i) {
        if (i + RING - 1 < NI) IDX_LOAD(i + RING - 1);
        const f16x8 bh0 = kb[i % RING][0], bh1 = kb[i % RING][1];
#pragma unroll
        for (int rt = 0; rt < 2; ++rt) { f32x4 acc = {0.f, 0.f, 0.f, 0.f};
            acc = mfma16h(aqh[rt][0], bh0, acc); acc = mfma16h(aqh[rt][1], bh1, acc); acc = mfma16h(aql[rt][0], bh0, acc); acc = mfma16h(aql[rt][1], bh1, acc);
            if constexpr (PV == 5) sc[i][rt] = acc[0] + acc[1] + acc[2] + acc[3]; else
            sc[i][rt] = ((__builtin_amdgcn_fmed3f(acc[0], 0.f, wq[rt][0]) + __builtin_amdgcn_fmed3f(acc[1], 0.f, wq[rt][1])) + __builtin_amdgcn_fmed3f(acc[2], 0.f, wq[rt][2])) + __builtin_amdgcn_fmed3f(acc[3], 0.f, wq[rt][3]); }
        { const unsigned one = (i < nloc) ? 1u : 0u;
          atomicAdd(&hist[quad * IDX_NB + idx_bin(sc[i][0], inv0)], one); atomicAdd(&hist[(4 + quad) * IDX_NB + idx_bin(sc[i][1], inv1)], one); }
        __builtin_amdgcn_sched_barrier(0);
    }
#undef IDX_LOAD
    if (probe == 1 || probe >= 4) return;
    __syncthreads();
    { const v4u* hq = (const v4u*)(hist + w * IDX_NB) + lane * 8; unsigned cntv[32]; unsigned tot = 0u;
#pragma unroll
      for (int k = 0; k < 8; ++k) { const v4u v = hq[k]; cntv[4 * k] = v.x; cntv[4 * k + 1] = v.y; cntv[4 * k + 2] = v.z; cntv[4 * k + 3] = v.w; tot += (v.x + v.y) + (v.z + v.w); }
      unsigned suf = tot;
#pragma unroll
      for (int o = 1; o < 64; o <<= 1) { const unsigned t = __shfl_down(suf, o); if (lane + o < 64) suf += t; }
      unsigned run = suf - tot;
      int bj = -1; unsigned ab = 0u;
#pragma unroll
      for (int j = 31; j >= 0; --j) { const unsigned cj = cntv[j]; const bool hit = (run < (unsigned)TOPK) && (run + cj >= (unsigned)TOPK); bj = hit ? j : bj; ab = hit ? run : ab; run += cj; }
      if (bj >= 0) { bstar[w] = (unsigned)(lane * 32 + bj); above[w] = ab; } }
    __syncthreads();
    if (probe == 2) return;
    const unsigned lo_base = 4095u - (unsigned)(16 * w + l15);
    { const unsigned bs0 = bstar[quad], bs1 = bstar[4 + quad];
#pragma unroll
      for (int i = 0; i < NI; ++i) { const unsigned lo = lo_base - 128u * (unsigned)i; const bool act = (i < nloc);
          if (act && idx_bin(sc[i][0], inv0) == bs0) { const unsigned slot = atomicAdd(&candn[quad], 1u); if (slot < (unsigned)IDX_CAP) cand[quad * IDX_CAP + slot] = ((unsigned long long)okey_of(sc[i][0]) << 12) | lo; }
          if (act && idx_bin(sc[i][1], inv1) == bs1) { const unsigned slot = atomicAdd(&candn[4 + quad], 1u); if (slot < (unsigned)IDX_CAP) cand[(4 + quad) * IDX_CAP + slot] = ((unsigned long long)okey_of(sc[i][1]) << 12) | lo; } } }
    __syncthreads();
    if (probe == 7) return;
    { const unsigned L = candn[w], need = (unsigned)TOPK - above[w];
      if (L > (unsigned)IDX_CAP) { if (lane == 0) ovf[0] = 1u; }
      else if (L <= 64u) {
        const unsigned long long mine = ((unsigned)lane < L) ? cand[w * IDX_CAP + lane] : 0ull; const unsigned mlo = (unsigned)mine, mhi = (unsigned)(mine >> 32); unsigned rank = 0u;
        for (unsigned i = 0; i < L; ++i) { const unsigned long long o = ((unsigned long long)(unsigned)__builtin_amdgcn_readlane((int)mhi, (int)i) << 32) | (unsigned)__builtin_amdgcn_readlane((int)mlo, (int)i); rank += (o > mine) ? 1u : 0u; }
        const unsigned long long bal = __ballot((unsigned)lane < L && rank + 1u == need); const int src = (int)__ffsll((long long)bal) - 1;
        const unsigned klo = (unsigned)__builtin_amdgcn_readlane((int)mlo, src), khi = (unsigned)__builtin_amdgcn_readlane((int)mhi, src);
        if (lane == 0) { Tq[w] = (khi << 20) | (klo >> 12); Lq[w] = klo & 0xfffu; } }
      else { unsigned long long ck[8];
#pragma unroll
        for (int j = 0; j < 8; ++j) ck[j] = ((unsigned)(j * 64 + lane) < L) ? cand[w * IDX_CAP + j * 64 + lane] : 0ull;
        unsigned long long Kth = 0ull;
#pragma nounroll
        for (int bit = 43; bit >= 0; --bit) { const unsigned long long cv = Kth | (1ull << bit); unsigned n = 0u;
#pragma unroll
            for (int j = 0; j < 8; ++j) if ((unsigned)(j * 64) < L) n += (unsigned)__popcll(__ballot(ck[j] >= cv));
            if (n >= need) Kth = cv; }
        if (lane == 0) { Tq[w] = (unsigned)(Kth >> 12); Lq[w] = (unsigned)Kth & 0xfffu; } } }
    __syncthreads();
    if (probe == 3) return;
    unsigned T0, T1, L0, L1; float Tf0, Tf1;
    if (ovf[0] == 0u) { Tf0 = okey_to_f(Tq[quad]); Tf1 = okey_to_f(Tq[4 + quad]); L0 = Lq[quad]; L1 = Lq[4 + quad];
    } else {
#pragma unroll
        for (int i = 0; i < NI; ++i) { sc[i][0] = (i < nloc) ? __uint_as_float(okey_of(sc[i][0])) : 0.f; sc[i][1] = (i < nloc) ? __uint_as_float(okey_of(sc[i][1])) : 0.f; }
        for (int i = tid; i < IDX_ROUNDS * 8; i += NTHR) cnt[i] = 0u;
        __syncthreads();
        T0 = 0u; T1 = 0u;
#pragma nounroll
        for (int rd = 0; rd < 32; ++rd) {
            const unsigned c0v = T0 | (0x80000000u >> rd), c1v = T1 | (0x80000000u >> rd); unsigned n0 = 0u, n1 = 0u;
#pragma unroll
            for (int i = 0; i < NI; ++i) { cnt_ge(n0, __float_as_uint(sc[i][0]), c0v); cnt_ge(n1, __float_as_uint(sc[i][1]), c1v); }
#pragma unroll
            for (int o = 1; o < 16; o <<= 1) { n0 += __shfl_xor(n0, o); n1 += __shfl_xor(n1, o); }
            if (l15 == 0) { atomicAdd(&cnt[rd * 8 + quad], n0); atomicAdd(&cnt[rd * 8 + 4 + quad], n1); }
            __syncthreads();
            if (cnt[rd * 8 + quad] >= (unsigned)TOPK) T0 = c0v;
            if (cnt[rd * 8 + 4 + quad] >= (unsigned)TOPK) T1 = c1v;
        }
        { unsigned n0 = 0u, n1 = 0u;
#pragma unroll
          for (int i = 0; i < NI; ++i) { cnt_gt(n0, __float_as_uint(sc[i][0]), T0); cnt_gt(n1, __float_as_uint(sc[i][1]), T1); }
#pragma unroll
          for (int o = 1; o < 16; o <<= 1) { n0 += __shfl_xor(n0, o); n1 += __shfl_xor(n1, o); }
          if (l15 == 0) { atomicAdd(&cnt[32 * 8 + quad], n0); atomicAdd(&cnt[32 * 8 + 4 + quad], n1); }
          __syncthreads(); }
        const unsigned need0 = (unsigned)TOPK - cnt[32 * 8 + quad], need1 = (unsigned)TOPK - cnt[32 * 8 + 4 + quad];
        L0 = 0u; L1 = 0u;
#pragma nounroll
        for (int rd = 0; rd < 12; ++rd) {
            const unsigned c0v = L0 | (0x800u >> rd), c1v = L1 | (0x800u >> rd); unsigned n0 = 0u, n1 = 0u;
#pragma unroll
            for (int i = 0; i < NI; ++i) { const unsigned lo = lo_base - 128u * (unsigned)i; cnt_tie(n0, __float_as_uint(sc[i][0]), T0, lo, c0v); cnt_tie(n1, __float_as_uint(sc[i][1]), T1, lo, c1v); }
#pragma unroll
            for (int o = 1; o < 16; o <<= 1) { n0 += __shfl_xor(n0, o); n1 += __shfl_xor(n1, o); }
            if (l15 == 0) { atomicAdd(&cnt[(33 + rd) * 8 + quad], n0); atomicAdd(&cnt[(33 + rd) * 8 + 4 + quad], n1); }
            __syncthreads();
            if (cnt[(33 + rd) * 8 + quad] >= need0) L0 = c0v;
            if (cnt[(33 + rd) * 8 + 4 + quad] >= need1) L1 = c1v;
        }
        Tf0 = okey_to_f(T0); Tf1 = okey_to_f(T1);
#pragma unroll
        for (int i = 0; i < NI; ++i) { sc[i][0] = okey_to_f(__float_as_uint(sc[i][0])); sc[i][1] = okey_to_f(__float_as_uint(sc[i][1])); }
    }
#pragma unroll
    for (int i = 0; i < NI; ++i) {
        const int t = w + 8 * i; const unsigned lo = lo_base - 128u * (unsigned)i; const bool act = (i < nloc);
#pragma unroll
        for (int rt = 0; rt < 2; ++rt) { const float k = sc[i][rt], T = rt ? Tf1 : Tf0; const unsigned L = rt ? L1 : L0;
            const bool sel = (k > T) || (k == T && lo >= L);
            const unsigned long long bal = __ballot(sel);
            if (lane < 4 && act) a.mask16[(size_t)(q0 + rt * 4 + lane) * 256 + t] = (unsigned short)((bal >> (16 * lane)) & 0xffffull); }
        __builtin_amdgcn_sched_barrier(0);
    }
}
template <int PV>
__device__ __forceinline__ void indexer_unit(const IdxArgs& a, int b, int c, int g, char* ldsg, int tid, int probe) {
    if (c < 16) indexer_unit_t<8, PV>(a, b, c, g, ldsg, tid, probe); else if (c < 32) indexer_unit_t<16, PV>(a, b, c, g, ldsg, tid, probe); else if (c < 48) indexer_unit_t<24, PV>(a, b, c, g, ldsg, tid, probe); else indexer_unit_t<32, PV>(a, b, c, g, ldsg, tid, probe);
}

namespace att {
using s16x4  = __attribute__((ext_vector_type(4))) short;
using f32x16 = __attribute__((ext_vector_type(16))) float;
using u32x4  = __attribute__((ext_vector_type(4))) unsigned;
constexpr int D = 128, NW = 8, QBLK = 32, KVBLK = 64;
constexpr float SCALE = 0.088388347648318440f, THR = 8.f;
constexpr int SHM_V = KVBLK * D * 2, SHM_K = KVBLK * D * 2, SHM_Q0 = 2 * SHM_V + 2 * SHM_K + NW * 64 * 4, SHM_ATTN = SHM_Q0 + 256 * D * 2;
constexpr int LDK = 128, LDV = NMAIN;
#define KSWZ(row, colB) ((row) * 256 + ((colB) ^ (((row) & 7) << 4)))
#define SBAR() __builtin_amdgcn_sched_barrier(0)
__device__ __forceinline__ int crow(int r, int hi) { return (r & 3) + 8 * (r >> 2) + 4 * hi; }
__device__ __forceinline__ unsigned cvtpk(float lo, float hi) { unsigned r; asm volatile("v_cvt_pk_bf16_f32 %0, %1, %2" : "=v"(r) : "v"(lo), "v"(hi)); return r; }
__device__ __forceinline__ float mask_and(float e, unsigned m, int pos) { float r; asm("v_bfe_i32 %0, %1, %2, 1\n\tv_and_b32 %0, %0, %3" : "=&v"(r) : "v"(m), "n"(pos), "v"(e)); return r; }
__device__ __forceinline__ void partialSM(f32x16& p0, f32x16& p1, float& m_reg, float& mn, float& alpha, unsigned ml) {
  constexpr float C = SCALE * 1.4426950408889634f;
  float pmax = p0[0];
#pragma unroll
  for (int r = 1; r < 16; ++r) pmax = fmaxf(pmax, p0[r]);
#pragma unroll
  for (int r = 0; r < 16; ++r) pmax = fmaxf(pmax, p1[r]);
  { auto rr = __builtin_amdgcn_permlane32_swap(__float_as_uint(pmax), __float_as_uint(pmax), false, false);
    pmax = fmaxf(__uint_as_float(rr[0]), __uint_as_float(rr[1])); }
  if (__builtin_expect(__all(pmax - m_reg <= THR / SCALE), 1)) { mn = m_reg; alpha = 1.f; }
  else { mn = fmaxf(m_reg, pmax); alpha = __builtin_amdgcn_exp2f((m_reg - mn) * C); m_reg = mn; }
  const float mnC = -mn * C;
#pragma unroll
  for (int r = 0; r < 16; ++r) p0[r] = fmaf(p0[r], C, mnC);
#pragma unroll
  for (int r = 0; r < 16; ++r) p1[r] = fmaf(p1[r], C, mnC);
#pragma unroll
  for (int r = 0; r < 16; ++r) p0[r] = mask_and(__builtin_amdgcn_exp2f(p0[r]), ml, (r & 3) + 8 * (r >> 2));
}
__device__ __forceinline__ void finishSM(f32x16& p0, f32x16& p1, float alpha, float& l_reg, bf16x8& pa0, bf16x8& pa1, bf16x8& pa2, bf16x8& pa3, unsigned mh) {
#pragma unroll
  for (int r = 0; r < 16; ++r) p1[r] = mask_and(__builtin_amdgcn_exp2f(p1[r]), mh, (r & 3) + 8 * (r >> 2));
  float ps = 0;
#pragma unroll
  for (int r = 0; r < 16; ++r) ps += p0[r];
#pragma unroll
  for (int r = 0; r < 16; ++r) ps += p1[r];
  { auto rr = __builtin_amdgcn_permlane32_swap(__float_as_uint(ps), __float_as_uint(ps), false, false);
    ps = __uint_as_float(rr[0]) + __uint_as_float(rr[1]); }
  l_reg = l_reg * alpha + ps;
#define PK4(P, BASE, OUT) do { unsigned a0 = cvtpk(P[BASE + 0], P[BASE + 1]), a1 = cvtpk(P[BASE + 2], P[BASE + 3]);   \
    unsigned b0 = cvtpk(P[BASE + 4], P[BASE + 5]), b1 = cvtpk(P[BASE + 6], P[BASE + 7]);                              \
    auto r0 = __builtin_amdgcn_permlane32_swap(a0, b0, false, false); auto r1 = __builtin_amdgcn_permlane32_swap(a1, b1, false, false); \
    u32x4 w = {r0[0], r1[0], r0[1], r1[1]}; OUT = *reinterpret_cast<bf16x8*>(&w); } while (0)
  PK4(p0, 0, pa0); PK4(p0, 8, pa1); PK4(p1, 0, pa2); PK4(p1, 8, pa3);
#undef PK4
}
__device__ __forceinline__ void qkt(f32x16& p0, f32x16& p1, const bf16* Ks, const char* Qs, int r32, int hi) {
  p0 = f32x16{}; p1 = f32x16{};
#pragma unroll
  for (int d0 = 0; d0 < 8; ++d0) { int cb = (d0 * 16 + hi * 8) * 2;
    bf16x8 b0 = *reinterpret_cast<const bf16x8*>((const char*)Ks + KSWZ(r32, cb));
    bf16x8 b1 = *reinterpret_cast<const bf16x8*>((const char*)Ks + KSWZ(32 + r32, cb));
    bf16x8 q = *reinterpret_cast<const bf16x8*>(Qs + KSWZ(r32, cb));
    p0 = __builtin_amdgcn_mfma_f32_32x32x16_bf16(b0, q, p0, 0, 0, 0);
    p1 = __builtin_amdgcn_mfma_f32_32x32x16_bf16(b1, q, p1, 0, 0, 0); }
}
__device__ __forceinline__ int v_st(int k, int c) { const int kk = (k & ~0xC) | ((k & 4) << 1) | ((k & 8) >> 1); return ((kk >> 3) * 4 + (c >> 5)) * 512 + ((kk & 7) * 32 + (c & 31)) * 2; }
__device__ __forceinline__ int v_rd_base(int lane) { return ((lane & 3) << 3) | (((lane >> 2) & 3) << 6) | (((lane >> 4) & 1) << 5) | (((lane >> 5) & 1) << 8); }
constexpr int v_rd_off(int d0, int ks, int half) { return d0 * 512 + ks * 4096 + half * 2048; }
template <int OFF> __device__ __forceinline__ s16x4 tr_read(int vb) {
  s16x4 r; asm volatile("ds_read_b64_tr_b16 %0, %1 offset:%2" : "=&v"(r) : "v"(vb), "i"(OFF) : "memory"); return r;
}
template <int D0> __device__ __forceinline__ void pv_one(f32x16& od, int vb, bf16x8 pa0, bf16x8 pa1, bf16x8 pa2, bf16x8 pa3) {
  const s16x4 l0 = tr_read<v_rd_off(D0, 0, 0)>(vb), h0 = tr_read<v_rd_off(D0, 0, 1)>(vb), l1 = tr_read<v_rd_off(D0, 1, 0)>(vb), h1 = tr_read<v_rd_off(D0, 1, 1)>(vb);
  const s16x4 l2 = tr_read<v_rd_off(D0, 2, 0)>(vb), h2 = tr_read<v_rd_off(D0, 2, 1)>(vb), l3 = tr_read<v_rd_off(D0, 3, 0)>(vb), h3 = tr_read<v_rd_off(D0, 3, 1)>(vb);
  asm volatile("s_waitcnt lgkmcnt(0)" ::: "memory"); SBAR();
#define PK(L, H) (bf16x8){L[0], L[1], L[2], L[3], H[0], H[1], H[2], H[3]}
  od = __builtin_amdgcn_mfma_f32_32x32x16_bf16(pa0, PK(l0, h0), od, 0, 0, 0);
  od = __builtin_amdgcn_mfma_f32_32x32x16_bf16(pa1, PK(l1, h1), od, 0, 0, 0);
  od = __builtin_amdgcn_mfma_f32_32x32x16_bf16(pa2, PK(l2, h2), od, 0, 0, 0);
  od = __builtin_amdgcn_mfma_f32_32x32x16_bf16(pa3, PK(l3, h3), od, 0, 0, 0);
#undef PK
}
__device__ __forceinline__ void pv_d0(f32x16* o, int vb, bf16x8 pa0, bf16x8 pa1, bf16x8 pa2, bf16x8 pa3) {
  pv_one<0>(o[0], vb, pa0, pa1, pa2, pa3); pv_one<1>(o[1], vb, pa0, pa1, pa2, pa3); pv_one<2>(o[2], vb, pa0, pa1, pa2, pa3); pv_one<3>(o[3], vb, pa0, pa1, pa2, pa3);
}
__device__ __forceinline__ void attn_unit(const bf16* __restrict__ QR, const bf16* __restrict__ KR, const bf16* __restrict__ PMAIN, const unsigned long long* __restrict__ MASK,
                                          bf16* __restrict__ MIX, int b, int c, char* lds) {
  const int tid = threadIdx.x, wid = tid >> 6, lane = tid & 63, r32 = lane & 31, hi = lane >> 5;
  bf16* V_lds = (bf16*)lds; bf16* K_lds = (bf16*)(lds + 2 * SHM_V);
  float* ws = (float*)(lds + 2 * SHM_V + 2 * SHM_K) + wid * 64; float* li_l = ws; float* al_l = ws + 32;
  float m_reg = -1e30f, l_reg = 0; f32x16 o[4] = {};
  const char* qr = lds + SHM_Q0 + wid * (QBLK * 256);
  const int tok0 = b * SEQ + c * 64, qloc = 8 * wid + (r32 >> 2);
  const bf16* Kh = KR + (size_t)b * SEQ * LDK; const bf16* Vh = PMAIN + (size_t)b * SEQ * LDV + PM_DV;
  const char* mb = (const char*)MASK + (size_t)tok0 * 512; const unsigned moff = (unsigned)qloc * 512u; const bool allsel = (c <= 3);
  const int NTR = c + 1, NT = (NTR + 1) & ~1;
#define GETMASK(kt, ML, MH) do { unsigned long long mm_ = allsel ? ~0ull : *(const unsigned long long*)(mb + (moff + 8u * (unsigned)(kt))); if ((kt) >= NTR) mm_ = 0ull; ML = (unsigned)mm_ >> (4 * hi); MH = (unsigned)(mm_ >> 32) >> (4 * hi); } while (0)
  const int sr = tid >> 4, sc = (tid & 15) * 8, vst0 = v_st(sr, sc), vst1 = v_st(32 + sr, sc);
  const int vb0 = (int)(uintptr_t)V_lds + v_rd_base(lane);
  struct { bf16x8 vs0, vs1, ks0, ks1; } sr_[1];
const unsigned offV0 = (unsigned)(sr * LDV + sc) * 2u, offV1 = offV0 + 32u * LDV * 2u, offK0 = (unsigned)(sr * LDK + sc) * 2u, offK1 = offK0 + 32u * LDK * 2u;
#define SLOAD(i, k0) do { const char* vb_ = (const char*)Vh + (size_t)(k0) * (LDV * 2); const char* kb_ = (const char*)Kh + (size_t)(k0) * (LDK * 2); \
    sr_[i].vs0 = *(const bf16x8*)(vb_ + offV0); sr_[i].vs1 = *(const bf16x8*)(vb_ + offV1); sr_[i].ks0 = *(const bf16x8*)(kb_ + offK0); sr_[i].ks1 = *(const bf16x8*)(kb_ + offK1); } while (0)
#define SWRITE(bb, i) do { *(bf16x8*)((char*)V_lds + (bb) * SHM_V + vst0) = sr_[i].vs0;          \
    *(bf16x8*)((char*)V_lds + (bb) * SHM_V + vst1) = sr_[i].vs1; int kc = sc * 2;               \
    *(bf16x8*)((char*)K_lds + (bb) * SHM_K + KSWZ(sr, kc)) = sr_[i].ks0;                       \
    *(bf16x8*)((char*)K_lds + (bb) * SHM_K + KSWZ(32 + sr, kc)) = sr_[i].ks1; } while (0)
#define SWAIT() asm volatile("s_waitcnt vmcnt(0)" ::: "memory")
#define RESC(a) do { if (__any((a) < 1.f)) { if (hi == 0) al_l[r32] = (a); asm volatile("s_waitcnt lgkmcnt(0)" ::: "memory"); \
    _Pragma("unroll") for (int d = 0; d < 4; ++d) _Pragma("unroll") for (int r = 0; r < 16; ++r) o[d][r] *= al_l[crow(r, hi)]; } } while (0)
  f32x16 pA0, pA1, pB0, pB1; float mnA, mnB, alA, alB; bf16x8 pa0, pa1, pa2, pa3; unsigned mlA, mhA, mlB, mhB;
  constexpr int SE = 0, SO = 0;
  __syncthreads();
  { const char* qb = (const char*)QR + (size_t)tok0 * 1024; const unsigned qoff = (unsigned)(qloc * 512 + (r32 & 3) * 128 + hi * 8) * 2u;
#pragma unroll
    for (int d0 = 0; d0 < 8; ++d0) { const bf16x8 t = *reinterpret_cast<const bf16x8*>(qb + (qoff + 32u * d0)); *(bf16x8*)(const_cast<char*>(qr) + KSWZ(r32, (d0 * 16 + hi * 8) * 2)) = t; }
    asm volatile("s_waitcnt lgkmcnt(0)" ::: "memory"); }
  SLOAD(SE, 0); asm volatile("s_waitcnt vmcnt(0)" ::: "memory"); SWRITE(0, SE); __syncthreads();
  GETMASK(0, mlA, mhA);
  qkt(pA0, pA1, K_lds, qr, r32, hi); partialSM(pA0, pA1, m_reg, mnA, alA, mlA);
  SLOAD(SO, KVBLK);
  SWAIT(); SWRITE(1, SO); __syncthreads();
  for (int j = 1; j + 1 < NT; j += 2) {
    GETMASK(j, mlB, mhB);
    SBAR(); qkt(pB0, pB1, (bf16*)((char*)K_lds + SHM_K), qr, r32, hi);
    finishSM(pA0, pA1, alA, l_reg, pa0, pa1, pa2, pa3, mhA); SBAR();
    SLOAD(SO, (j + 1) * KVBLK); SBAR();
    pv_d0(o, vb0, pa0, pa1, pa2, pa3); partialSM(pB0, pB1, m_reg, mnB, alB, mlB);
    __syncthreads(); SWAIT(); SWRITE(0, SE);
    RESC(alB); __syncthreads();
    GETMASK(j + 1, mlA, mhA);
    SBAR(); qkt(pA0, pA1, K_lds, qr, r32, hi);
    finishSM(pB0, pB1, alB, l_reg, pa0, pa1, pa2, pa3, mhB); SBAR();
    SLOAD(SE, (j + 2) * KVBLK); SBAR();
    pv_d0(o, vb0 + (int)SHM_V, pa0, pa1, pa2, pa3); partialSM(pA0, pA1, m_reg, mnA, alA, mlA);
    __syncthreads(); SWAIT(); SWRITE(1, SO);
    RESC(alA); __syncthreads();
  }
  GETMASK(NT - 1, mlB, mhB);
  SBAR(); qkt(pB0, pB1, (bf16*)((char*)K_lds + SHM_K), qr, r32, hi);
  finishSM(pA0, pA1, alA, l_reg, pa0, pa1, pa2, pa3, mhA); SBAR();
  pv_d0(o, vb0, pa0, pa1, pa2, pa3); partialSM(pB0, pB1, m_reg, mnB, alB, mlB);
  __syncthreads(); RESC(alB);
  finishSM(pB0, pB1, alB, l_reg, pa0, pa1, pa2, pa3, mhB); SBAR();
  pv_d0(o, vb0 + (int)SHM_V, pa0, pa1, pa2, pa3);
  if (hi == 0) li_l[r32] = l_reg; asm volatile("s_waitcnt lgkmcnt(0)" ::: "memory");
  float rli[16];
#pragma unroll
  for (int r = 0; r < 16; ++r) rli[r] = __builtin_amdgcn_rcpf(li_l[crow(r, hi)]);
  { char* ob = (char*)MIX + (size_t)tok0 * 2048; const unsigned ooff = (unsigned)((8 * wid + hi) * 1024 + 512 + r32) * 2u;
#pragma unroll
    for (int r = 0; r < 16; ++r)
#pragma unroll
      for (int d0 = 0; d0 < 4; ++d0) *(bf16*)(ob + (size_t)((2 * (r >> 2) * 1024 + (r & 3) * 128 + d0 * 32) * 2) + ooff) = (bf16)f2bf(o[d0][r] * rli[r]); }
#undef GETMASK
#undef SLOAD
#undef SWRITE
#undef SWAIT
#undef RESC
}
}
#ifndef MK_ONE_LAUNCH
#define MK_ONE_LAUNCH 1
#endif
constexpr int NPHASE = 10;
static_assert(att::SHM_ATTN <= MISC_OFF && pg8::STAGE_BYTES <= MISC_OFF, "LDS map");
struct Args { const float* in[14]; float* out; unsigned char* ws; int ph_lo, ph_hi, li, pad; };
__global__ void __launch_bounds__(NTHR, 2) fwd_kernel(Args args) {
    extern __shared__ __attribute__((aligned(16))) unsigned char lds[];
    const int tid = threadIdx.x, lane = tid & 63, wave = __builtin_amdgcn_readfirstlane(tid >> 6), bid = blockIdx.x, G = gridDim.x;
    typedef const __attribute__((address_space(4))) Args* KArgs;
    const KArgs ka = (KArgs)__builtin_amdgcn_kernarg_segment_ptr(); (void)args;
    unsigned char* ws = ka->ws; char* ldsg = (char*)lds; LAS unsigned char* ldsl = (LAS unsigned char*)lds;
    if (tid < 64) ((LAS unsigned*)(ldsl + MISC_OFF))[tid] = 0u;
    __syncthreads();
    volatile LAS unsigned* MISC = (volatile LAS unsigned*)(ldsl + MISC_OFF);
    unsigned* ctl = (unsigned*)(ws + WS_CTL);
    const int lo = ka->ph_lo, hi = ka->ph_hi;
    XcdBarrier bar; bar.bar = ctl + CW_BAR + ka->li * XCD_BAR_WORDS; bar.x = 0; bar.st = nullptr;
    if (hi - lo > 1) bar = xcd_barrier_post(ctl + CW_BAR + ka->li * XCD_BAR_WORDS, MISC + 8);
#ifndef PROBE_REPEAT
#define PROBE_REPEAT (-1)
#endif
#ifndef PROBE_SUB
#define PROBE_SUB 0
#endif
#ifndef PH_ENABLE
#define PH_ENABLE 0x3ff
#endif
#define IN(k) (((PH_ENABLE >> (k)) & 1) && lo <= (k) && (k) < hi)
#define SEAM(k) do { if (IN(k) && IN((k) + 1)) xcd_barrier(bar); } while (0)
#define hcat ((bf16*)(ws + WS_HCAT))
#define winm ((bf16*)(ws + WS_WINM))
#define wspl ((bf16*)(ws + WS_WSPL))
#define wo ((bf16*)(ws + WS_WO))
#define w1t ((bf16*)(ws + WS_W1))
#define w2t ((bf16*)(ws + WS_W2))
#define tab128 ((f32x2*)(ws + WS_TAB128))
#define tab64 ((f32x2*)(ws + WS_TAB64))
#define pmain ((bf16*)(ws + WS_PMAIN))
#define pspl ((float*)(ws + WS_PSPL))
#define mix ((bf16*)(ws + WS_MIX))
#define oraw ((bf16*)(ws + WS_ORAW))
#define hn ((bf16*)(ws + WS_HN))
#define hid ((bf16*)(ws + WS_HID))
#define ffraw ((bf16*)(ws + WS_FFRAW))
#define ss1 ((float*)(ctl + CW_SS1))
#define ss2 ((float*)(ctl + CW_SS2))
#define GLA_ARGS GlaArgs ga{pmain, pspl, ka->in[3], ka->in[4], ka->in[5], (bf16*)(ws + WS_UT), (float*)(ws + WS_DECAY), (bf16*)(ws + WS_SIN), mix, (bf16*)(ws + WS_GQD), (bf16*)(ws + WS_GKI)}
    const int gw = bid * NWAVES + wave, NGW = G * NWAVES;
    const int sub = (PROBE_SUB != 0 && ka->li == 1) ? PROBE_SUB : 0;

    if (IN(0)) {
        P0Args a{ka->in[0], ka->in[1], ka->in[2], ka->in[8], ka->in[11], ka->in[12], hcat, winm, wspl, wo, w1t, w2t, tab128, tab64};
        p0_prologue(a, ldsg, bid, G, tid);
        SEAM(0);
    }
    if (IN(1)) {
        { pg8::Gemm g{hcat, winm, M, NMAIN, 1024, 2048, 1024, 1 << 30}; pg8::StaticOrder S; S.init(M, NMAIN, G, bid);
          pg8::EpiBf16X<0, false> E{pmain, NMAIN, nullptr};
          pg8::gemm_phase<pg8::EpiBf16X<0, false>, pg8::StaticOrder, true, true, true>(ldsl, g, S, E); }
        __syncthreads();
        { pg8::Gemm g{hcat, wspl, M, NSPLIT, KSPLIT, 2048, KSPLIT, 1 << 30}; pg8::StaticOrder S; S.init(M, NSPLIT, G, bid);
          pg8::EpiF32 E{pspl, NSPLIT};
          pg8::gemm_phase<pg8::EpiF32, pg8::StaticOrder, true, true, true>(ldsl, g, S, E); }
        SEAM(1);
    }
    if (IN(2)) {
        GLA_ARGS;
        P2Args a{pmain, pspl, tab128, tab64, ka->in[6], ka->in[7], (bf16*)(ws + WS_QR), (bf16*)(ws + WS_KR), (bf16*)(ws + WS_IKH), (bf16*)(ws + WS_IKL), (bf16*)(ws + WS_IQH), (bf16*)(ws + WS_IQL), (float*)(ws + WS_IW), (float*)(ws + WS_QB)};
        if (sub != 2) p2_post_rows(a, gw, NGW, lane);
        if (sub != 1) gla_local_phase(ga, ldsg, bid, G, tid);
        SEAM(2);
    }
    if (IN(3)) {
        GLA_ARGS;
#ifndef PROBE_IDX
#define PROBE_IDX 0
#endif
        const int probe = (PROBE_IDX != 0 && ka->li == 1) ? PROBE_IDX : 0;
        if (probe == 0) gla_scan(ga, bid, G, tid);
        float kbound; { const float lw = fabsf(ka->in[6][lane]), lb = ka->in[7][lane]; float mw = lw;
#pragma unroll
          for (int o = 1; o < 64; o <<= 1) mw = fmaxf(mw, __shfl_xor(mw, o));
          kbound = 8.0f * mw + sqrtf(wave_sum(lb * lb)); }
        IdxArgs a{(const bf16*)(ws + WS_IQH), (const bf16*)(ws + WS_IQL), (const bf16*)(ws + WS_IKH), (const bf16*)(ws + WS_IKL), (const float*)(ws + WS_IW), (unsigned short*)(ws + WS_MASK), (const float*)(ws + WS_QB), kbound};
        if (G == 256) {
            const int b = bid >> 5, g = (bid & 31) >> 2, j = bid & 3;
            for (int k = 14; k >= 0; --k) { const int r = (k < 14) ? ((k >> 1) * 8 + ((k & 1) ? 7 - j : j)) : 56 + j;
                indexer_unit<0>(a, b, 4 + r, g, ldsg, tid, probe); }
        } else {
            for (int it = bid; it < BATCH * 30 * 8; it += G) {
                const int b = it / 240, rem = it % 240, p = rem >> 3, g = rem & 7;
                indexer_unit<0>(a, b, 4 + p, g, ldsg, tid, probe); indexer_unit<0>(a, b, 63 - p, g, ldsg, tid, probe); }
        }
        SEAM(3);
    }
    if (IN(4)) {
        GLA_ARGS;
        if (sub != 2) gla_out_phase(ga, ldsg, bid, G, tid);
        if (sub != 1) for (int it = bid; it < BATCH * 32; it += G) {
            const int b = it & 7, p = it >> 3;
            for (int half = 0; half < 2; ++half)
                att::attn_unit((const bf16*)(ws + WS_QR), (const bf16*)(ws + WS_KR), pmain, (const unsigned long long*)(ws + WS_MASK), mix, b, half ? p : 63 - p, ldsg);
        }
        SEAM(4);
    }
    if (IN(5)) {
        __syncthreads();
        pg8::Gemm g{mix, wo, M, DM, 1024, 1024, 1024, 1 << 30}; pg8::StaticOrder S; S.init(M, DM, G, bid);
        pg8::EpiBf16X<0, false> E{oraw, DM, nullptr};
        pg8::gemm_phase<pg8::EpiBf16X<0, false>, pg8::StaticOrder, true, true>(ldsl, g, S, E);
        SEAM(5);
    }
    if (IN(6)) {
        p6_rows(ka->in[0], oraw, ka->in[9], ka->in[10], hn, gw, NGW, lane);
        SEAM(6);
    }
    if (IN(7)) {
        pg8::Gemm g{hn, w1t, M, DFF, 1024, 1024, 1024, 1 << 30}; pg8::StaticOrder S; S.init(M, DFF, G, bid);
        pg8::EpiBf16X<2, false> E{hid, DFF, nullptr};
        pg8::gemm_phase<pg8::EpiBf16X<2, false>, pg8::StaticOrder, true, true>(ldsl, g, S, E);
        SEAM(7);
    }
    if (IN(8)) {
        pg8::Gemm g{hid, w2t, M, DM, DFF, DFF, DFF, 1 << 30}; pg8::StaticOrder S; S.init(M, DM, G, bid);
        pg8::EpiBf16X<0, false> E{ffraw, DM, nullptr};
        pg8::gemm_phase<pg8::EpiBf16X<0, false>, pg8::StaticOrder, true, true>(ldsl, g, S, E);
        SEAM(8);
    }
    if (IN(9)) {
        p9_rows(oraw, ffraw, ka->in[13], ka->out, gw, NGW, lane);
    }
#undef IN
#undef SEAM
#undef hcat
#undef winm
#undef wspl
#undef wo
#undef w1t
#undef w2t
#undef tab128
#undef tab64
#undef pmain
#undef pspl
#undef mix
#undef oraw
#undef hn
#undef hid
#undef ffraw
#undef ss1
#undef ss2
#undef GLA_ARGS
}

extern "C" void kernel_launch(void* const* d_in, const int* in_sizes, int n_in, void* d_out, int out_size, void* d_ws, size_t ws_size, hipStream_t stream) {
    static int grid = 0;
    if (grid == 0) {
        if (n_in != 14 || in_sizes[0] != M * DM || out_size != M * DM || ws_size < WS_END) { fprintf(stderr, "kernel_launch: shape/workspace mismatch (n_in %d, in0 %d, out %d, ws %zu < %zu); nothing launched\n", n_in, n_in > 0 ? in_sizes[0] : -1, out_size, ws_size, (size_t)WS_END); grid = -1; return; }
        int dev = 0, cus = 0, per_cu = 0;
        if (hipGetDevice(&dev) != hipSuccess || hipDeviceGetAttribute(&cus, hipDeviceAttributeMultiprocessorCount, dev) != hipSuccess) { fprintf(stderr, "kernel_launch: device query failed\n"); grid = -1; return; }
        if (hipFuncSetAttribute((const void*)fwd_kernel, hipFuncAttributeMaxDynamicSharedMemorySize, LDS_BYTES) != hipSuccess) { fprintf(stderr, "kernel_launch: hipFuncSetAttribute(%d B LDS) failed\n", LDS_BYTES); grid = -1; return; }
        if (hipOccupancyMaxActiveBlocksPerMultiprocessor(&per_cu, (const void*)fwd_kernel, NTHR, LDS_BYTES) != hipSuccess || per_cu < 1) fprintf(stderr, "kernel_launch: note: occupancy query reports %d workgroups per CU\n", per_cu);
        (void)hipGetLastError();
        grid = cus;
    }
    if (grid < 0) return;
    if (hipMemsetAsync((char*)d_ws + WS_CTL, 0, CTL_ZERO_BYTES, stream) != hipSuccess) { fprintf(stderr, "kernel_launch: memset failed\n"); return; }
    Args a{};
    for (int i = 0; i < 14; ++i) a.in[i] = (const float*)d_in[i];
    a.out = (float*)d_out; a.ws = (unsigned char*)d_ws;
#if MK_ONE_LAUNCH && PROBE_REPEAT >= 0
    { const int k = PROBE_REPEAT; const int lo3[3] = {0, k, k + 1}, hi3[3] = {k + 1, k + 1, NPHASE};
      for (int li = 0; li < 3; ++li) { if (lo3[li] >= hi3[li]) continue; a.ph_lo = lo3[li]; a.ph_hi = hi3[li]; a.li = li;
          hipLaunchKernelGGL(fwd_kernel, dim3(grid), dim3(NTHR), LDS_BYTES, stream, a); } }
#elif MK_ONE_LAUNCH
    a.ph_lo = 0; a.ph_hi = NPHASE; a.li = 0;
    hipLaunchKernelGGL(fwd_kernel, dim3(grid), dim3(NTHR), LDS_BYTES, stream, a);
#else
    for (int ph = 0; ph < NPHASE; ++ph) { a.ph_lo = ph; a.ph_hi = ph + 1; a.li = ph;
        hipLaunchKernelGGL(fwd_kernel, dim3(grid), dim3(NTHR), LDS_BYTES, stream, a); }
#endif
    const hipError_t le = hipPeekAtLastError();
    if (le != hipSuccess) fprintf(stderr, "kernel_launch: launch failed: %s\n", hipGetErrorName(le));
}
```

```cpp
#include <hip/hip_runtime.h>
#include <cstdio>
#include <cstdint>
#include <cmath>
namespace pg8 {
#define PG8_LAS __attribute__((address_space(3)))
typedef unsigned short bf16_t;
typedef short bf16x8 __attribute__((ext_vector_type(8)));
typedef _Float16 f16x8_t __attribute__((ext_vector_type(8)));
typedef float f32x4 __attribute__((ext_vector_type(4)));
typedef unsigned u32x4 __attribute__((ext_vector_type(4)));
constexpr int BM = 256, BK = 64, HALF = 128, HTB = HALF * BK * 2  , STAGE_BYTES = 8 * HTB, NXCD = 8, WGM = 8;

__host__ __device__ __forceinline__ int lds_byte(int r, int c) { const int st = (r >> 4) * 2 + (c >> 5), rr = r & 15, cc = c & 31, ob = rr * 64 + cc * 2; return st * 1024 + (ob ^ (((ob >> 9) & 1) << 5)); }
__host__ __device__ __forceinline__ void stage_rc(int b, int& R, int& C) { const int st = b / 1024, sb = b % 1024, swz = sb ^ (((sb >> 9) & 1) << 5); R = (st >> 1) * 16 + swz / 64; C = (st & 1) * 32 + (swz % 64) / 2; }
__host__ __device__ __forceinline__ int perm32(int rho) { const int n = rho >> 4, i = rho & 15; return 8 * (i >> 2) + 4 * n + (i & 3); }

struct Unit { int pm, pn; };
struct Gemm { const bf16_t* A; const bf16_t* Bt; int M, N, K, lda, ldb, awrap; };

struct StaticOrder {
    int nM, nN, nwg, G, c;
    __host__ __device__ void init(int M, int N, int G_, int c_) { nM = M / BM; nN = N / BM; nwg = nM * nN; G = G_; c = c_; }
    __host__ __device__ bool next(int i, Unit& u) const {
        const long L = (long)i * G + c; if (L >= nwg) return false;
        int wgid = (int)L; { const int q = nwg / NXCD, r = nwg % NXCD, xcd = wgid % NXCD, off = wgid / NXCD; wgid = (xcd < r ? xcd * (q + 1) : r * (q + 1) + (xcd - r) * q) + off; }
        const int nig = WGM * nN, gid = wgid / nig, fm = gid * WGM, gsz = (nM - fm) < WGM ? (nM - fm) : WGM;
        u.pm = fm + ((wgid % nig) % gsz); u.pn = (wgid % nig) / gsz; return true;
    }
    __device__ __forceinline__ void a_ready(const Unit&) const {}
    __device__ __forceinline__ void done(const Unit&) const {}
};

__device__ __forceinline__ unsigned cvt_pk_bf16(float lo, float hi) { unsigned r; asm volatile("v_cvt_pk_bf16_f32 %0, %1, %2" : "=v"(r) : "v"(lo), "v"(hi)); return r; }
template <int ACT  , bool SS> struct EpiBf16X {
    static constexpr bool PERM = true, AFTER_DRAIN = false;
    bf16_t* O; int ldc; float* ss;
    __device__ __forceinline__ void operator()(const f32x4 (&acc)[2][2][4][2], const Unit& u, int wr, int wc, int fr, int fq) const {
        const int row0 = u.pm * BM + wr * 64 + fr; const int col0 = u.pn * BM + wc * 32 + 8 * fq;
#pragma unroll
        for (int ai = 0; ai < 2; ++ai)
#pragma unroll
            for (int m = 0; m < 4; ++m) { const int row = row0 + ai * HALF + m * 16; bf16_t* rowp = O + (size_t)row * ldc + col0; float s = 0.f;
#pragma unroll
                for (int bj = 0; bj < 2; ++bj) { f32x4 v0 = acc[ai][bj][m][0], v1 = acc[ai][bj][m][1];
                    if (ACT == 2) {
#pragma unroll
                        for (int e = 0; e < 4; ++e) { const float a = fmaxf(v0[e], 0.f), b = fmaxf(v1[e], 0.f); v0[e] = a * a; v1[e] = b * b; } }
                    if (SS) s += (v0[0] * v0[0] + v0[1] * v0[1]) + (v0[2] * v0[2] + v0[3] * v0[3]) + (v1[0] * v1[0] + v1[1] * v1[1]) + (v1[2] * v1[2] + v1[3] * v1[3]);
                    u32x4 w; w.x = cvt_pk_bf16(v0[0], v0[1]); w.y = cvt_pk_bf16(v0[2], v0[3]); w.z = cvt_pk_bf16(v1[0], v1[1]); w.w = cvt_pk_bf16(v1[2], v1[3]);
                    *(u32x4*)(rowp + bj * HALF) = w; }
                if (SS) { s += __shfl_xor(s, 16); s += __shfl_xor(s, 32); if (fq == 0) atomicAdd(ss + row, s); } }
    }
};
struct EpiF32 {
    static constexpr bool PERM = false, AFTER_DRAIN = false;
    float* O; int ldc;
    __device__ __forceinline__ void operator()(const f32x4 (&acc)[2][2][4][2], const Unit& u, int wr, int wc, int fr, int fq) const {
        const int row0 = u.pm * BM + wr * 64 + fr; const int col0 = u.pn * BM + wc * 32 + 4 * fq;
#pragma unroll
        for (int ai = 0; ai < 2; ++ai)
#pragma unroll
            for (int m = 0; m < 4; ++m) { float* rowp = O + (size_t)(row0 + ai * HALF + m * 16) * ldc + col0;
#pragma unroll
                for (int bj = 0; bj < 2; ++bj)
#pragma unroll
                    for (int n = 0; n < 2; ++n) *(f32x4*)(rowp + bj * HALF + n * 16) = acc[ai][bj][m][n]; }
    }
};
template <class Epi, class Sched, bool ALIGN_EPI = false, bool SP2 = false, bool F16 = false>
__device__ __forceinline__ void gemm_phase(PG8_LAS unsigned char* lds, const Gemm g, const Sched& S, const Epi& E) {
    const int tid = threadIdx.x, wid = __builtin_amdgcn_readfirstlane(tid >> 6), lane = tid & 63, wr = wid >> 2, wc = wid & 3, fr = lane & 15, fq = lane >> 4;
    const int K = g.K, nt = K / BK;
    unsigned voffA[2], voffB[2];
#pragma unroll
    for (int i = 0; i < 2; ++i) { int R, C; stage_rc(tid * 16 + i * 8192, R, C); const int Rb = Epi::PERM ? ((R & ~31) + perm32(R & 31)) : R;
        voffA[i] = (unsigned)(R * g.lda + C) * 2u; voffB[i] = (unsigned)(Rb * g.ldb + C) * 2u; }
    const size_t kstep = (size_t)(BK * 2);
    const size_t hstepA = (size_t)HALF * g.lda * 2, hstepB = (size_t)HALF * g.ldb * 2;
    const size_t tstepA = 2 * hstepA, tstepB = 2 * hstepB; const int awrap = g.awrap;
    const unsigned ldsw = (unsigned)wid * 1024u;
    const int aoff = lds_byte(wr * 64 + fr, fq * 8), boff = lds_byte(wc * 32 + fr, fq * 8);
#define PG8_SA(b, h) (((b) * 2 + (h)) * HTB)
#define PG8_SB(b, h) ((4 + (b) * 2 + (h)) * HTB)
#define PG8_STAGE(bufoff, gbase, voff) do { _Pragma("unroll") for (int _i = 0; _i < 2; ++_i) \
        __builtin_amdgcn_global_load_lds((const unsigned*)((const char*)(gbase) + (voff)[_i]), (PG8_LAS unsigned*)(lds + (bufoff) + ldsw + _i * 8192), 16, 0, 0); } while (0)
#define PG8_LDA(dst, b, h) do { _Pragma("unroll") for (int m = 0; m < 4; ++m) _Pragma("unroll") for (int k = 0; k < 2; ++k) dst[m][k] = *(const PG8_LAS bf16x8*)(lds + PG8_SA(b, h) + aoff + m * 2048 + k * 1024); } while (0)
#define PG8_LDB(dst, b, h) do { _Pragma("unroll") for (int n = 0; n < 2; ++n) _Pragma("unroll") for (int k = 0; k < 2; ++k) dst[n][k] = *(const PG8_LAS bf16x8*)(lds + PG8_SB(b, h) + boff + n * 2048 + k * 1024); } while (0)
#define PG8_MMA(ai, bj, At, Bt) do { __builtin_amdgcn_s_setprio(1); _Pragma("unroll") for (int m = 0; m < 4; ++m) _Pragma("unroll") for (int n = 0; n < 2; ++n) _Pragma("unroll") for (int k = 0; k < 2; ++k) \
        acc[ai][bj][m][n] = F16 ? __builtin_amdgcn_mfma_f32_16x16x32_f16(__builtin_bit_cast(f16x8_t, Bt[n][k]), __builtin_bit_cast(f16x8_t, At[m][k]), acc[ai][bj][m][n], 0, 0, 0) \
                                : __builtin_amdgcn_mfma_f32_16x16x32_bf16(Bt[n][k], At[m][k], acc[ai][bj][m][n], 0, 0, 0); __builtin_amdgcn_s_setprio(0); } while (0)
#define PG8_WAIT_V(n) asm volatile("s_waitcnt vmcnt(" #n ")" ::: "memory")
#define PG8_WAIT_L(n) asm volatile("s_waitcnt lgkmcnt(" #n ")" ::: "memory")
#define PG8_BAR __builtin_amdgcn_s_barrier()
#define PG8_SCHED __builtin_amdgcn_sched_barrier(0)
    Unit cur, nxt; int ui = 0;
    if (!S.next(0, cur)) return;
    f32x4 acc[2][2][4][2];
#pragma unroll
    for (int a = 0; a < 2; ++a)
#pragma unroll
        for (int b = 0; b < 2; ++b)
#pragma unroll
            for (int m = 0; m < 4; ++m)
#pragma unroll
                for (int n = 0; n < 2; ++n) acc[a][b][m][n] = (f32x4){0.f, 0.f, 0.f, 0.f};
    bf16x8 At[4][2], B0[2][2], B1[2][2];
    const char* cA = (const char*)g.A + (size_t)cur.pm * tstepA; const char* cB = (const char*)g.Bt + (size_t)cur.pn * tstepB;
    S.a_ready(cur);
    if constexpr (SP2) {
        PG8_STAGE(PG8_SB(0, 0), cB, voffB); PG8_STAGE(PG8_SB(0, 1), cB + hstepB, voffB); PG8_STAGE(PG8_SA(0, 0), cA, voffA); PG8_STAGE(PG8_SA(0, 1), cA + hstepA, voffA);
        if (wr == 1) PG8_BAR;
        PG8_WAIT_V(2); PG8_BAR;
        PG8_STAGE(PG8_SB(1, 0), cB + kstep, voffB); PG8_STAGE(PG8_SA(1, 0), cA + kstep, voffA); PG8_STAGE(PG8_SB(1, 1), cB + hstepB + kstep, voffB);
        PG8_WAIT_V(6); PG8_BAR;
    } else {
        PG8_STAGE(PG8_SB(0, 0), cB, voffB); PG8_STAGE(PG8_SA(0, 0), cA, voffA); PG8_STAGE(PG8_SB(0, 1), cB + hstepB, voffB); PG8_STAGE(PG8_SA(0, 1), cA + hstepA, voffA);
        if (wr == 1) PG8_BAR;
        PG8_WAIT_V(4); PG8_BAR;
        PG8_STAGE(PG8_SB(1, 0), cB + kstep, voffB); PG8_STAGE(PG8_SA(1, 0), cA + kstep, voffA); PG8_STAGE(PG8_SB(1, 1), cB + hstepB + kstep, voffB);
        PG8_WAIT_V(6); PG8_BAR;
    }
    for (;;) {
        const bool has_next = S.next(ui + 1, nxt);
        const char* nA = has_next ? (const char*)g.A + (size_t)nxt.pm * tstepA : cA; const char* nB = has_next ? (const char*)g.Bt + (size_t)nxt.pn * tstepB : cB;
        for (int t = 0; t < nt; t += 2) {
            const bool last = (t == nt - 2);
            const int t1 = t + 1, t2 = t + 2; const char* a1 = cA + (size_t)(t1 >= awrap ? t1 - awrap : t1) * kstep;
            const char* a2 = last ? nA : cA + (size_t)(t2 >= awrap ? t2 - awrap : t2) * kstep; const char* b2 = last ? nB : cB + (size_t)(t + 2) * kstep;
            const char* a3 = a2 + kstep; const char* b3 = b2 + kstep;
            if (last && has_next) S.a_ready(nxt);
            if constexpr (SP2) {
            PG8_LDB(B0, 0, 0); PG8_LDB(B1, 0, 1); PG8_SCHED; PG8_LDA(At, 0, 0); PG8_STAGE(PG8_SA(1, 1), a1 + hstepA, voffA);
            PG8_WAIT_V(8); PG8_WAIT_L(0); PG8_BAR; PG8_MMA(0, 0, At, B0); PG8_MMA(0, 1, At, B1); PG8_BAR; PG8_SCHED;
            PG8_LDA(At, 0, 1); PG8_STAGE(PG8_SB(0, 0), b2, voffB); PG8_STAGE(PG8_SB(0, 1), b2 + hstepB, voffB); PG8_STAGE(PG8_SA(0, 0), a2, voffA);
            PG8_WAIT_V(8); PG8_WAIT_L(0); PG8_BAR; PG8_MMA(1, 0, At, B0); PG8_MMA(1, 1, At, B1); PG8_BAR; PG8_SCHED;
            PG8_LDB(B0, 1, 0); PG8_LDB(B1, 1, 1); PG8_SCHED; PG8_LDA(At, 1, 0); PG8_STAGE(PG8_SA(0, 1), a2 + hstepA, voffA);
            PG8_WAIT_V(8); PG8_WAIT_L(0); PG8_BAR; PG8_MMA(0, 0, At, B0); PG8_MMA(0, 1, At, B1); PG8_BAR; PG8_SCHED;
            PG8_LDA(At, 1, 1); PG8_STAGE(PG8_SB(1, 0), b3, voffB); PG8_STAGE(PG8_SB(1, 1), b3 + hstepB, voffB); PG8_STAGE(PG8_SA(1, 0), a3, voffA);
            PG8_WAIT_V(8); PG8_WAIT_L(0); PG8_BAR; PG8_MMA(1, 0, At, B0); PG8_MMA(1, 1, At, B1); PG8_BAR; PG8_SCHED;
            } else {
            PG8_LDB(B0, 0, 0); PG8_SCHED; PG8_LDA(At, 0, 0); PG8_STAGE(PG8_SA(1, 1), a1 + hstepA, voffA);
            PG8_WAIT_L(8); PG8_BAR; PG8_WAIT_L(0); PG8_MMA(0, 0, At, B0); PG8_BAR; PG8_SCHED;
            PG8_LDB(B1, 0, 1); PG8_STAGE(PG8_SB(0, 0), b2, voffB);
            PG8_BAR; PG8_WAIT_L(0); PG8_MMA(0, 1, At, B1); PG8_BAR;
            PG8_LDA(At, 0, 1); PG8_STAGE(PG8_SA(0, 0), a2, voffA);
            PG8_BAR; PG8_WAIT_L(0); PG8_MMA(1, 0, At, B0); PG8_BAR; PG8_SCHED;
            PG8_STAGE(PG8_SB(0, 1), b2 + hstepB, voffB);
            PG8_WAIT_V(6); PG8_BAR; PG8_MMA(1, 1, At, B1); PG8_BAR;
            PG8_LDB(B0, 1, 0); PG8_SCHED; PG8_LDA(At, 1, 0); PG8_STAGE(PG8_SA(0, 1), a2 + hstepA, voffA);
            PG8_WAIT_L(8); PG8_BAR; PG8_WAIT_L(0); PG8_MMA(0, 0, At, B0); PG8_BAR; PG8_SCHED;
            PG8_LDB(B1, 1, 1); PG8_STAGE(PG8_SB(1, 0), b3, voffB);
            PG8_BAR; PG8_WAIT_L(0); PG8_MMA(0, 1, At, B1); PG8_BAR;
            PG8_LDA(At, 1, 1); PG8_STAGE(PG8_SA(1, 0), a3, voffA);
            PG8_BAR; PG8_WAIT_L(0); PG8_MMA(1, 0, At, B0); PG8_BAR; PG8_SCHED;
            PG8_STAGE(PG8_SB(1, 1), b3 + hstepB, voffB);
            PG8_WAIT_V(6); PG8_BAR; PG8_MMA(1, 1, At, B1); PG8_BAR;
            }
        }
        if constexpr (ALIGN_EPI) { if (wr == 0) PG8_BAR; }
        if constexpr (!Epi::AFTER_DRAIN) { E(acc, cur, wr, wc, fr, fq); S.done(cur); }
        if (!has_next) break;
#pragma unroll
        for (int a = 0; a < 2; ++a)
#pragma unroll
            for (int b = 0; b < 2; ++b)
#pragma unroll
                for (int m = 0; m < 4; ++m)
#pragma unroll
                    for (int n = 0; n < 2; ++n) acc[a][b][m][n] = (f32x4){0.f, 0.f, 0.f, 0.f};
        cur = nxt; cA = nA; cB = nB; ++ui;
        if constexpr (ALIGN_EPI) { if (wr == 1) PG8_BAR; }
    }
    PG8_WAIT_V(0);
    if constexpr (!ALIGN_EPI) { if (wr == 0) PG8_BAR; }
    PG8_BAR;
    if constexpr (Epi::AFTER_DRAIN) { E.fused(acc, cur, wr, wc, fr, fq, lds, wid, lane); S.done(cur); }
#undef PG8_SA
#undef PG8_SB
#undef PG8_STAGE
#undef PG8_LDA
#undef PG8_LDB
#undef PG8_MMA
#undef PG8_WAIT_V
#undef PG8_WAIT_L
#undef PG8_BAR
#undef PG8_SCHED
}
}
constexpr int BATCH = 8, SEQ = 4096, DM = 1024, M = BATCH * SEQ;
constexpr int D_IN = 2644, NMAIN = 2304, NSPLIT = 512, KSPLIT = 2048, DFF = 4096;
constexpr int PM_GQ = 0, PM_GK = 256, PM_GV = 512, PM_GR = 1024, PM_DQ = 1536, PM_DK = 2048, PM_DV = 2176;
constexpr int PS_IQ = 0, PS_IK = 256, PS_IW = 320, PS_GLR = 324;
constexpr float EPS = 1e-6f;
constexpr int NWAVES = 8, NTHR = 512;
constexpr int NUNIT_GLA = BATCH * 4 * 64;
constexpr int TOPK = 256;

constexpr size_t MiB = 1u << 20;
constexpr size_t WS_CTL = 0, CTL_ZERO_BYTES = 1 * MiB;
constexpr int CW_BAR = 4096, CW_SS1 = 65536, CW_SS2 = 98304;
constexpr size_t WS_IW = 1 * MiB, WS_DECAY = 1 * MiB + 512 * 1024;
constexpr size_t WS_WINM = 2 * MiB, WS_WSPL = 7 * MiB, WS_WO = 10 * MiB, WS_W1 = 12 * MiB, WS_W2 = 20 * MiB;
constexpr size_t WS_TAB128 = 28 * MiB, WS_TAB64 = 30 * MiB, WS_QB = 31 * MiB;
constexpr size_t WS_HCAT = 32 * MiB;
constexpr size_t WS_QR = 32 * MiB, WS_KR = 64 * MiB, WS_IKH = 72 * MiB, WS_IKL = 76 * MiB, WS_IQH = 80 * MiB, WS_IQL = 96 * MiB, WS_MASK = 112 * MiB, WS_SIN = 128 * MiB;
constexpr size_t WS_PMAIN = 160 * MiB, WS_PSPL = 304 * MiB, WS_UT = 368 * MiB, WS_GQD = 400 * MiB, WS_GKI = 416 * MiB, WS_MIX = 432 * MiB;
constexpr size_t WS_ORAW = 160 * MiB, WS_HN = 32 * MiB, WS_HID = 256 * MiB, WS_FFRAW = 96 * MiB;
constexpr size_t WS_END = 512 * MiB;
constexpr int RING_BYTES = 131072, LDS_BYTES = 147456, MISC_OFF = LDS_BYTES - 256;

#define LAS __attribute__((address_space(3)))
typedef unsigned short bf16;
typedef unsigned v4u __attribute__((ext_vector_type(4)));
typedef unsigned v2u __attribute__((ext_vector_type(2)));
typedef float f32x4 __attribute__((ext_vector_type(4)));
typedef float f32x2 __attribute__((ext_vector_type(2)));
typedef short bf16x8 __attribute__((ext_vector_type(8)));
#define LDS_WAIT() asm volatile("s_waitcnt lgkmcnt(0)" ::: "memory")
__device__ __forceinline__ unsigned f2bf(float f) { unsigned u = __float_as_uint(f); return (u + 0x7fffu + ((u >> 16) & 1u)) >> 16; }
__device__ __forceinline__ float bf2f(unsigned h) { return __uint_as_float(h << 16); }
__device__ __forceinline__ unsigned pk2(float lo, float hi) { return f2bf(lo) | (f2bf(hi) << 16); }
__device__ __forceinline__ float wave_sum(float v) {
#pragma unroll
    for (int o = 1; o < 64; o <<= 1) v += __shfl_xor(v, o);
    return v;
}
__device__ __forceinline__ f32x4 mfma16(bf16x8 a, bf16x8 b, f32x4 c) { return __builtin_amdgcn_mfma_f32_16x16x32_bf16(a, b, c, 0, 0, 0); }
#define XB_TMO      128
#define XB_XCNT(j)  (256  + 64 * (j))
#define XB_XSUB(j)  (1280 + 64 * (j))
#define XB_XGEN(j)  (2304 + 64 * (j))
#define XB_TOP      3328
#define XB_TOPGEN   3392
#define XCD_BAR_WORDS 3456
#define XB_SPIN_CAP (1u << 18)

__device__ __forceinline__ unsigned xb_ld(unsigned* p)              { return __hip_atomic_load(p, __ATOMIC_RELAXED, __HIP_MEMORY_SCOPE_AGENT); }
__device__ __forceinline__ unsigned xb_add(unsigned* p, unsigned v) { return __hip_atomic_fetch_add(p, v, __ATOMIC_RELAXED, __HIP_MEMORY_SCOPE_AGENT); }
__device__ __forceinline__ unsigned xb_xcc_id() { return (unsigned)__builtin_amdgcn_s_getreg((3 << 11) | 20) & 0xFu; }
#define XB_SPIN(cond, bar) do { unsigned _sp = 0; while (cond) { __builtin_amdgcn_s_sleep(1); \
    if ((++_sp & 255u) == 0u) { if (xb_ld(&(bar)[XB_TMO])) break; if (_sp > XB_SPIN_CAP) { atomicAdd(&(bar)[XB_TMO], 1u); break; } } } } while (0)

struct XcdBarrier {
    unsigned* bar; unsigned x;
    volatile LAS unsigned* st;
};

__device__ __forceinline__ XcdBarrier xcd_barrier_post(unsigned* bar, volatile LAS unsigned* st) {
    XcdBarrier b; b.bar = bar; b.x = xb_xcc_id(); b.st = st;
    if (threadIdx.x == 0) (void)xb_add(&bar[XB_XCNT(b.x)], 1u);
    return b;
}
__device__ __forceinline__ void xcd_barrier_complete(unsigned* bar, unsigned x, unsigned& nloc, unsigned& nx) {
    const unsigned G = gridDim.x * gridDim.y * gridDim.z;
    unsigned sum, cnt, mine, sp = 0u;
    for (;;) {
        sum = 0u; cnt = 0u; mine = 0u;
#pragma unroll
        for (unsigned j = 0; j < 16; ++j) { const unsigned c = xb_ld(&bar[XB_XCNT(j)]); sum += c; cnt += (c > 0u) ? 1u : 0u; mine = (j == x) ? c : mine; }
        if (sum == G) break;
        __builtin_amdgcn_s_sleep(1);
        if ((++sp & 255u) == 0u) { if (xb_ld(&bar[XB_TMO])) break; if (sp > XB_SPIN_CAP) { atomicAdd(&bar[XB_TMO], 1u); break; } }
    }
    nloc = mine > 0u ? mine : 1u; nx = cnt > 0u ? cnt : 1u;
}

__device__ __forceinline__ void xcd_barrier(const XcdBarrier& b) {
    asm volatile("s_waitcnt vmcnt(0)" ::: "memory");
    __syncthreads();
    if (threadIdx.x == 0) {
        unsigned* bar = b.bar;
        __builtin_amdgcn_s_waitcnt(0);
        unsigned nloc = b.st[0], nx = b.st[1];
        if (nloc == 0u) { xcd_barrier_complete(bar, b.x, nloc, nx); b.st[0] = nloc; b.st[1] = nx; }
        const unsigned old = xb_add(&bar[XB_XSUB(b.x)], 1u);
        const unsigned gen = old / nloc;
        if (old + 1u == (gen + 1u) * nloc) {
            __builtin_amdgcn_fence(__ATOMIC_RELEASE, "agent");
            asm volatile("s_waitcnt vmcnt(0)" ::: "memory");
            const unsigned og = xb_add(&bar[XB_TOP], 1u);
            const unsigned tg = og / nx;
            if (og + 1u == (tg + 1u) * nx) xb_add(&bar[XB_TOPGEN], 1u);
            else XB_SPIN(xb_ld(&bar[XB_TOPGEN]) == tg, bar);
            __builtin_amdgcn_fence(__ATOMIC_ACQUIRE, "agent");
            xb_add(&bar[XB_XGEN(b.x)], 1u);
            asm volatile("s_waitcnt vmcnt(0)" ::: "memory");
        } else {
            XB_SPIN(xb_ld(&bar[XB_XGEN(b.x)]) == gen, bar);
            __builtin_amdgcn_fence(__ATOMIC_ACQUIRE, "agent");
            asm volatile("s_waitcnt vmcnt(0)" ::: "memory");
        }
    }
    __syncthreads();
}

__device__ __forceinline__ unsigned short f16bits(_Float16 h) { return __builtin_bit_cast(unsigned short, h); }
__device__ __forceinline__ unsigned pkh2(float lo, float hi) { return (unsigned)f16bits((_Float16)lo) | ((unsigned)f16bits((_Float16)hi) << 16); }
__device__ __forceinline__ float h2f(unsigned bits16) { return (float)__builtin_bit_cast(_Float16, (unsigned short)bits16); }
__device__ __forceinline__ int win_src_main(int j) { return j < 1024 ? j : j + 16; }
__device__ __forceinline__ int win_src_split(int j) { return j < 256 ? 2320 + j : (j < 320 ? 2576 + (j - 256) : (j < 324 ? 2640 + (j - 320) : (j < 340 ? 1024 + (j - 324) : -1))); }
template <int MODE>
__device__ __forceinline__ void p0_transpose_item(const float* W, int ldw, bf16* WT, int ldo, float* scr, int item, int nblk, int lane) {
    const int kb = item / nblk, nb = item % nblk, k0 = 64 * kb, n0 = 32 * nb;
    const int n = n0 + (lane & 31);
    const int sc = MODE == 0 ? n : (MODE == 1 ? win_src_main(n) : win_src_split(n));
    float wv[32];
#pragma unroll
    for (int i = 0; i < 32; ++i) { const int kk = 2 * i + (lane >> 5); wv[i] = sc >= 0 ? W[(size_t)(k0 + kk) * ldw + sc] : 0.f; }
#pragma unroll
    for (int i = 0; i < 32; ++i) { const int kk = 2 * i + (lane >> 5); scr[kk * 33 + (lane & 31)] = wv[i]; }
    LDS_WAIT();
    const int c = lane & 7;
#pragma unroll
    for (int j = 0; j < 4; ++j) { const int nn = (lane >> 3) + 8 * j; const float* s = scr + (8 * c) * 33 + nn;
        const float v0 = s[0 * 33], v1 = s[1 * 33], v2 = s[2 * 33], v3 = s[3 * 33], v4 = s[4 * 33], v5 = s[5 * 33], v6 = s[6 * 33], v7 = s[7 * 33];
        v4u o; if (MODE == 0) { o.x = pk2(v0, v1); o.y = pk2(v2, v3); o.z = pk2(v4, v5); o.w = pk2(v6, v7); } else { o.x = pkh2(v0, v1); o.y = pkh2(v2, v3); o.z = pkh2(v4, v5); o.w = pkh2(v6, v7); }
        bf16* dst = WT + (size_t)(n0 + nn) * ldo + k0 + 8 * c;
        *(v4u*)dst = o;
        if (MODE == 2) *(v4u*)(dst + 1024) = o; }
    LDS_WAIT();
}
__device__ __forceinline__ void p0_rms_finish(const f32x4 (&v)[4], const float* w, bf16* orow, int lane) {
    const f32x4* wr = (const f32x4*)w + lane; float s = 0.f;
#pragma unroll
    for (int j = 0; j < 4; ++j) s += (v[j].x * v[j].x + v[j].y * v[j].y) + (v[j].z * v[j].z + v[j].w * v[j].w);
    const float r = 1.0f / sqrtf(wave_sum(s) * (1.f / DM) + EPS);
    unsigned long long* oh = (unsigned long long*)orow + lane; unsigned long long* ol = (unsigned long long*)(orow + 1024) + lane;
#pragma unroll
    for (int j = 0; j < 4; ++j) { const f32x4 y = (v[j] * r) * wr[64 * j];
        const unsigned h0 = pkh2(y.x, y.y), h1 = pkh2(y.z, y.w);
        const unsigned l0 = pkh2(y.x - h2f(h0 & 0xffffu), y.y - h2f(h0 >> 16)), l1 = pkh2(y.z - h2f(h1 & 0xffffu), y.w - h2f(h1 >> 16));
        oh[64 * j] = (unsigned long long)h0 | ((unsigned long long)h1 << 32); ol[64 * j] = (unsigned long long)l0 | ((unsigned long long)l1 << 32); }
}
__device__ __forceinline__ void p0_rms_rows(const float* x, const float* w, bf16* hcat, int gw, int NGW, int lane) {
    if (gw >= M) return;
    f32x4 cur[4], nxt[4];
#pragma unroll
    for (int j = 0; j < 4; ++j) cur[j] = __builtin_nontemporal_load((const f32x4*)(x + (size_t)gw * DM) + lane + 64 * j);
    for (int m = gw; m < M; m += NGW) { const int mn = (m + NGW < M) ? m + NGW : m;
#pragma unroll
        for (int j = 0; j < 4; ++j) nxt[j] = __builtin_nontemporal_load((const f32x4*)(x + (size_t)mn * DM) + lane + 64 * j);
        p0_rms_finish(cur, w, hcat + (size_t)m * 2048, lane);
#pragma unroll
        for (int j = 0; j < 4; ++j) cur[j] = nxt[j]; }
}
__device__ __forceinline__ void sincos_f64(double a, double& sn, double& cs) {
    const double kd = rint(a * 0.63661977236758134308);
    const double r = (a - kd * 1.57079632673412561417e+00) - kd * 6.07710050650619224932e-11;
    const double z = r * r;
    const double ps = 8.33333333332248946124e-03 + z * (-1.98412698298579493134e-04 + z * (2.75573137070700676789e-06 + z * (-2.50507602534068634195e-08 + z * 1.58969099521155010221e-10)));
    const double s = r + (z * r) * (-1.66666666666666324348e-01 + z * ps);
    const double pc = z * (4.16666666666666019037e-02 + z * (-1.38888888888741095749e-03 + z * (2.48015872894767294178e-05 + z * (-2.75573143513906633035e-07 + z * (2.08757232129817482790e-09 + z * -1.13596475577881948265e-11)))));
    const double c = 1.0 - (0.5 * z - z * pc);
    const int q = ((int)kd) & 3;
    sn = (q == 0) ? s : (q == 1) ? c : (q == 2) ? -s : -c;
    cs = (q == 0) ? c : (q == 1) ? -s : (q == 2) ? -c : s;
}
struct P0Args { const float *x, *nw, *w_in, *w_out, *w1, *w2; bf16 *hcat, *winm, *wspl, *wo, *w1t, *w2t; f32x2 *tab128, *tab64; };
__device__ __forceinline__ void p0_prologue(const P0Args& a, char* ldsg, int bid, int G, int tid) {
    const int lane = tid & 63, wave = tid >> 6;
    float* scr = (float*)(ldsg + wave * 16384);
    const int gw = bid * NWAVES + wave, NGW = G * NWAVES;
    constexpr int I_M = 16 * (NMAIN / 32), I_S = 16 * (NSPLIT / 32), I_O = 16 * (DM / 32), I_1 = 16 * (DFF / 32), I_2 = 64 * (DM / 32);
    for (int it = gw; it < I_M + I_S + I_O + I_1 + I_2; it += NGW) {
        int r = it;
        if (r < I_M) { p0_transpose_item<1>(a.w_in, D_IN, a.winm, 1024, scr, r, NMAIN / 32, lane); continue; } r -= I_M;
        if (r < I_S) { p0_transpose_item<2>(a.w_in, D_IN, a.wspl, KSPLIT, scr, r, NSPLIT / 32, lane); continue; } r -= I_S;
        if (r < I_O) { p0_transpose_item<0>(a.w_out, DM, a.wo, 1024, scr, r, DM / 32, lane); continue; } r -= I_O;
        if (r < I_1) { p0_transpose_item<0>(a.w1, DFF, a.w1t, 1024, scr, r, DFF / 32, lane); continue; } r -= I_1;
        p0_transpose_item<0>(a.w2, DM, a.w2t, DFF, scr, r, DM / 32, lane);
    }
    p0_rms_rows(a.x, a.nw, a.hcat, gw, NGW, lane);
    for (int e = bid * NTHR + tid; e < SEQ * 96; e += G * NTHR) {
        const int s = e / 96, j = e % 96; const bool big = j < 64; const int i = big ? j : j - 64;
        const double base = big ? 0.8659643233600653 : 0.7498942093324558;
        double p = 1.0; for (int k = 0; k < i; ++k) p *= base;
        const double ang = (double)s * (double)(float)p; double sn, cs; sincos_f64(ang, sn, cs);
        const f32x2 o = {(float)cs, (float)sn};
        if (big) a.tab128[s * 64 + i] = o; else a.tab64[s * 32 + i] = o;
    }
}

struct P2Args { const bf16* pmain; const float* pspl; const f32x2 *tab128, *tab64; const float *lnw, *lnb; bf16 *qr, *kr, *ikh, *ikl, *iqh, *iql; float* iw; float* qb; };
struct P2In { unsigned short k1, k2, q1[4], q2[4]; float iq1[2], iq2[2], iwr[2], ik, iw4; f32x2 cs, c2; };
__device__ __forceinline__ void p2_load(P2In& r, const P2Args& a, int m, int lane) {
    const int s = m & (SEQ - 1);
    const bf16* pm = a.pmain + (size_t)m * NMAIN; const float* ps = a.pspl + (size_t)m * NSPLIT;
    r.cs = a.tab128[s * 64 + lane]; r.c2 = a.tab64[s * 32 + (lane & 31)];
    r.k1 = pm[PM_DK + lane]; r.k2 = pm[PM_DK + 64 + lane];
#pragma unroll
    for (int h = 0; h < 4; ++h) { r.q1[h] = pm[PM_DQ + h * 128 + lane]; r.q2[h] = pm[PM_DQ + h * 128 + 64 + lane]; }
#pragma unroll
    for (int e = 0; e < 2; ++e) { const int h = 2 * e + (lane >> 5), i = lane & 31; r.iq1[e] = ps[PS_IQ + h * 64 + i]; r.iq2[e] = ps[PS_IQ + h * 64 + 32 + i]; r.iwr[e] = ps[PS_IW + h]; }
    r.ik = ps[PS_IK + lane]; r.iw4 = ps[PS_IW + (lane & 3)];
}
__device__ __forceinline__ void p2_post_row(const P2In& r, const P2Args& a, int m, int lane) {
    const int s = m & (SEQ - 1);
    const f32x2 cs = r.cs;
    { const float x1 = bf2f(r.k1), x2 = bf2f(r.k2);
      a.kr[(size_t)m * 128 + lane] = (bf16)f2bf(x1 * cs.x - x2 * cs.y); a.kr[(size_t)m * 128 + 64 + lane] = (bf16)f2bf(x2 * cs.x + x1 * cs.y); }
#pragma unroll
    for (int h = 0; h < 4; ++h) { const float x1 = bf2f(r.q1[h]), x2 = bf2f(r.q2[h]);
      a.qr[(size_t)m * 512 + h * 128 + lane] = (bf16)f2bf(x1 * cs.x - x2 * cs.y); a.qr[(size_t)m * 512 + h * 128 + 64 + lane] = (bf16)f2bf(x2 * cs.x + x1 * cs.y); }
    const f32x2 c2 = r.c2;
    float qn = 0.f;
#pragma unroll
    for (int e = 0; e < 2; ++e) { const int h = 2 * e + (lane >> 5), i = lane & 31;
      const float x1 = r.iq1[e], x2 = r.iq2[e];
      const float wr = r.iwr[e];
      const float o1 = (x1 * c2.x - x2 * c2.y) * wr, o2 = (x2 * c2.x + x1 * c2.y) * wr;
      float sq = o1 * o1 + o2 * o2;
#pragma unroll
      for (int o = 1; o < 32; o <<= 1) sq += __shfl_xor(sq, o);
      qn += sqrtf(sq);
      const _Float16 h1 = (_Float16)o1, h2 = (_Float16)o2; const size_t p = ((size_t)m * 4 + h) * 64 + i;
      a.iqh[p] = f16bits(h1); a.iqh[p + 32] = f16bits(h2); a.iql[p] = f16bits((_Float16)(o1 - (float)h1)); a.iql[p + 32] = f16bits((_Float16)(o2 - (float)h2)); }
    qn += __shfl_xor(qn, 32);
    if (lane == 0) a.qb[m] = qn;
    { const float v = r.ik; const float mu = wave_sum(v) * (1.f / 64.f); const float d = v - mu; const float var = wave_sum(d * d) * (1.f / 64.f);
      const float y = d * (1.0f / sqrtf(var + EPS)) * a.lnw[lane] + a.lnb[lane];
      const float other = __shfl_xor(y, 32);
      const float o = lane < 32 ? (y * c2.x - other * c2.y) : (y * c2.x + other * c2.y);
      const size_t p = (size_t)(m >> 12) * (SEQ * 64) + (size_t)(s >> 4) * 1024 + (lane >> 5) * 512 + ((((lane & 31) >> 3) * 16 + (s & 15)) * 8) + (lane & 7);
      a.ikh[p] = f16bits((_Float16)o); }
    if (lane < 4) a.iw[(size_t)m * 4 + lane] = (r.iw4 < 0.f) ? -__builtin_inff() : __builtin_inff();
}
__device__ __forceinline__ void p2_post_rows(const P2Args& a, int gw, int NGW, int lane) {
    if (gw >= M) return;
    P2In cur, nxt; p2_load(cur, a, gw, lane);
    for (int m = gw; m < M; m += NGW) { const int mn = (m + NGW < M) ? m + NGW : m;
        p2_load(nxt, a, mn, lane); p2_post_row(cur, a, m, lane); cur = nxt; }
}

constexpr int GLA_LD = 72;
struct GlaArgs { const bf16* pmain; const float* pspl; const float *gw2, *gb, *gnw; bf16* ut; float* decay; bf16* sin_; bf16* mix; bf16* gqd; bf16* gki; };
struct GlaPre { f32x2 glr, w2; float gbv; v4u k, q, v0, v1; };
template <bool WITH_Q>
__device__ __forceinline__ void gla_prefetch(GlaPre& p, const GlaArgs& a, int u, int tid) {
    const int b = u >> 8, h = (u >> 6) & 3, n = u & 63, m0 = b * SEQ + n * 64;
    { const int i = 2 * tid, t = i >> 4, j = i & 15; p.glr = *(const f32x2*)(a.pspl + (size_t)(m0 + t) * NSPLIT + PS_GLR + j); }
    { const int i = 2 * tid, j = i >> 6, d = i & 63; p.w2 = *(const f32x2*)(a.gw2 + j * 256 + h * 64 + d); }
    p.gbv = a.gb[h * 64 + (tid & 63)];
    const bf16* row = a.pmain + (size_t)(m0 + (tid & 63)) * NMAIN;
    p.k = *(const v4u*)(row + PM_GK + h * 64 + 8 * (tid >> 6));
    if (WITH_Q) p.q = *(const v4u*)(row + PM_GQ + h * 64 + 8 * (tid >> 6));
    p.v0 = *(const v4u*)(row + PM_GV + h * 128 + 8 * (tid >> 6)); p.v1 = *(const v4u*)(row + PM_GV + h * 128 + 64 + 8 * (tid >> 6));
}
constexpr int GS_LD = 65;
__device__ __forceinline__ void gla_bcum(const GlaPre& p, float* Gs, float* glr, float* w2s, float* gbs, int tid) {
    *(f32x2*)(glr + 2 * tid) = p.glr; *(f32x2*)(w2s + 2 * tid) = p.w2; if (tid < 64) gbs[tid] = p.gbv;
    __syncthreads();
    { const int d = tid & 63; float wc[16];
#pragma unroll
      for (int j = 0; j < 16; ++j) wc[j] = w2s[j * 64 + d];
      const float bias = gbs[d];
#pragma unroll
      for (int e = 0; e < 8; ++e) { const int t = (tid >> 6) + 8 * e; const f32x4* g4 = (const f32x4*)(glr + t * 16); float z = 0.f;
#pragma unroll
          for (int j4 = 0; j4 < 4; ++j4) { const f32x4 gv = g4[j4]; z += gv.x * wc[4 * j4]; z += gv.y * wc[4 * j4 + 1]; z += gv.z * wc[4 * j4 + 2]; z += gv.w * wc[4 * j4 + 3]; }
          z += bias;
          Gs[t * GS_LD + d] = (fminf(z, 0.f) - __logf(1.f + __expf(-fabsf(z)))) * (1.f / 16.f); } }
    __syncthreads();
    if (tid < 64) { float c[64];
#pragma unroll
        for (int t = 0; t < 64; ++t) c[t] = Gs[t * GS_LD + tid];
#pragma unroll
        for (int t = 1; t < 64; ++t) c[t] += c[t - 1];
#pragma unroll
        for (int t = 0; t < 64; ++t) Gs[t * GS_LD + tid] = c[t]; }
    __syncthreads();
}
__device__ __forceinline__ float bfl(unsigned w) { return __uint_as_float(w << 16); }
__device__ __forceinline__ float bfh(unsigned w) { return __uint_as_float(w & 0xffff0000u); }
__device__ __forceinline__ void gla_local_phase(const GlaArgs& a, char* ldsg, int bid, int G, int tid) {
    const int lane = tid & 63, w = tid >> 6, quad = lane >> 4, l15 = lane & 15;
    float* Gs = (float*)ldsg; float* glr = Gs + 64 * GS_LD + 32; float* w2s = glr + 1024; float* gbs = w2s + 1024; bf16* kT = (bf16*)(gbs + 64); bf16* vT = kT + 64 * GLA_LD;
    if (bid >= NUNIT_GLA) return;
    GlaPre cur, nxt; gla_prefetch<true>(cur, a, bid, tid);
    for (int u = bid; u < NUNIT_GLA; u += G) {
        const int un = (u + G < NUNIT_GLA) ? u + G : u; gla_prefetch<true>(nxt, a, un, tid);
        __syncthreads();
        gla_bcum(cur, Gs, glr, w2s, gbs, tid);
        { const int t = tid & 63, d0 = 8 * (tid >> 6); const unsigned kw[4] = {cur.k.x, cur.k.y, cur.k.z, cur.k.w}, qw[4] = {cur.q.x, cur.q.y, cur.q.z, cur.q.w}; unsigned qo[4], ko[4]; const unsigned v0w[4] = {cur.v0.x, cur.v0.y, cur.v0.z, cur.v0.w}, v1w[4] = {cur.v1.x, cur.v1.y, cur.v1.z, cur.v1.w};
#pragma unroll
          for (int e = 0; e < 4; ++e) { const int d = d0 + 2 * e; const float g0 = Gs[t * GS_LD + d], g1 = Gs[t * GS_LD + d + 1];
              qo[e] = pk2(bfl(qw[e]) * 0.125f * __expf(g0), bfh(qw[e]) * 0.125f * __expf(g1)); ko[e] = pk2(bfl(kw[e]) * __expf(-g0), bfh(kw[e]) * __expf(-g1));
              kT[d * GLA_LD + t] = (bf16)f2bf(bfl(kw[e]) * __expf(Gs[63 * GS_LD + d] - Gs[t * GS_LD + d])); kT[(d + 1) * GLA_LD + t] = (bf16)f2bf(bfh(kw[e]) * __expf(Gs[63 * GS_LD + d + 1] - Gs[t * GS_LD + d + 1]));
              vT[d * GLA_LD + t] = (bf16)(v0w[e] & 0xffffu); vT[(d + 1) * GLA_LD + t] = (bf16)(v0w[e] >> 16);
              vT[(64 + d) * GLA_LD + t] = (bf16)(v1w[e] & 0xffffu); vT[(64 + d + 1) * GLA_LD + t] = (bf16)(v1w[e] >> 16); }
          *(v4u*)(a.gqd + (size_t)u * 4096 + t * 64 + d0) = (v4u){qo[0], qo[1], qo[2], qo[3]}; *(v4u*)(a.gki + (size_t)u * 4096 + t * 64 + d0) = (v4u){ko[0], ko[1], ko[2], ko[3]}; }
        if (tid < 64) a.decay[(size_t)u * 64 + tid] = __expf(Gs[63 * GS_LD + tid]);
        __syncthreads();
        f32x4 acc[4];
#pragma unroll
        for (int dt = 0; dt < 4; ++dt) acc[dt] = (f32x4){0.f, 0.f, 0.f, 0.f};
#pragma unroll
        for (int ks = 0; ks < 2; ++ks) { const bf16x8 af = *(const bf16x8*)(vT + (16 * w + l15) * GLA_LD + ks * 32 + 8 * quad);
#pragma unroll
            for (int dt = 0; dt < 4; ++dt) { const bf16x8 bfr = *(const bf16x8*)(kT + (16 * dt + l15) * GLA_LD + ks * 32 + 8 * quad); acc[dt] = mfma16(af, bfr, acc[dt]); } }
        bf16* uo = a.ut + (size_t)u * 8192;
#pragma unroll
        for (int dt = 0; dt < 4; ++dt)
#pragma unroll
            for (int r = 0; r < 4; ++r) uo[(16 * w + 4 * quad + r) * 64 + 16 * dt + l15] = (bf16)f2bf(acc[dt][r]);
        cur = nxt;
    }
}
__device__ __forceinline__ void gla_scan(const GlaArgs& a, int bid, int G, int tid) {
    for (int idx = bid * NTHR + tid; idx < 32 * 4096; idx += G * NTHR) {
        const int bh = idx >> 12, e = idx & 4095, d = e & 63; float s0 = 0.f, s1 = 0.f;
        const bf16* up = a.ut + (size_t)bh * 64 * 8192 + e; const float* dp = a.decay + (size_t)bh * 64 * 64 + d; bf16* sp = a.sin_ + (size_t)bh * 64 * 8192 + e;
#pragma nounroll
        for (int n0 = 0; n0 < 64; n0 += 8) {
            float u0[8], u1[8], dc[8];
#pragma unroll
            for (int k = 0; k < 8; ++k) { u0[k] = bf2f(up[(size_t)(n0 + k) * 8192]); u1[k] = bf2f(up[(size_t)(n0 + k) * 8192 + 4096]); dc[k] = dp[(n0 + k) * 64]; }
#pragma unroll
            for (int k = 0; k < 8; ++k) { sp[(size_t)(n0 + k) * 8192] = (bf16)f2bf(s0); sp[(size_t)(n0 + k) * 8192 + 4096] = (bf16)f2bf(s1); s0 = dc[k] * s0 + u0[k]; s1 = dc[k] * s1 + u1[k]; }
        }
    }
}
struct GlaPreO { v4u qd, ki, v0, v1; };
__device__ __forceinline__ void gla_prefetch_o(GlaPreO& p, const GlaArgs& a, int u, int tid) {
    const int b = u >> 8, h = (u >> 6) & 3, n = u & 63, m0 = b * SEQ + n * 64, t = tid & 63, d0 = 8 * (tid >> 6);
    p.qd = *(const v4u*)(a.gqd + (size_t)u * 4096 + t * 64 + d0); p.ki = *(const v4u*)(a.gki + (size_t)u * 4096 + t * 64 + d0);
    const bf16* row = a.pmain + (size_t)(m0 + t) * NMAIN + PM_GV + h * 128;
    p.v0 = *(const v4u*)(row + d0); p.v1 = *(const v4u*)(row + 64 + d0);
}
__device__ __forceinline__ void gla_out_phase(const GlaArgs& a, char* ldsg, int bid, int G, int tid) {
    const int lane = tid & 63, w = tid >> 6, quad = lane >> 4, l15 = lane & 15;
    bf16* Qd = (bf16*)ldsg; bf16* Ki = Qd + 64 * GLA_LD; bf16* vT = Ki + 64 * GLA_LD; bf16* At = vT + 128 * GLA_LD;
    float* part = (float*)(At + 64 * GLA_LD);
    if (bid >= NUNIT_GLA) return;
    const int rt = w & 3, ch = w >> 2;
    GlaPreO cur, nxt; gla_prefetch_o(cur, a, bid, tid);
    for (int u = bid; u < NUNIT_GLA; u += G) {
        const int b = u >> 8, h = (u >> 6) & 3, n = u & 63, m0 = b * SEQ + n * 64;
        const int un = (u + G < NUNIT_GLA) ? u + G : u; gla_prefetch_o(nxt, a, un, tid);
        bf16x8 sfr[2][4]; unsigned short rg[4][4];
        { const bf16* Sg = a.sin_ + (size_t)u * 8192;
#pragma unroll
          for (int ks = 0; ks < 2; ++ks)
#pragma unroll
            for (int vt = 0; vt < 4; ++vt) sfr[ks][vt] = *(const bf16x8*)(Sg + (16 * (4 * ch + vt) + l15) * 64 + ks * 32 + 8 * quad);
#pragma unroll
          for (int r = 0; r < 4; ++r)
#pragma unroll
            for (int vt = 0; vt < 4; ++vt) rg[r][vt] = a.pmain[(size_t)(m0 + 16 * rt + 4 * quad + r) * NMAIN + PM_GR + h * 128 + 16 * (4 * ch + vt) + l15]; }
        __syncthreads();
        { const int t = tid & 63, d0 = 8 * (tid >> 6);
          const unsigned v0w[4] = {cur.v0.x, cur.v0.y, cur.v0.z, cur.v0.w}, v1w[4] = {cur.v1.x, cur.v1.y, cur.v1.z, cur.v1.w};
#pragma unroll
          for (int e = 0; e < 4; ++e) { const int d = d0 + 2 * e;
              vT[d * GLA_LD + t] = (bf16)(v0w[e] & 0xffffu); vT[(d + 1) * GLA_LD + t] = (bf16)(v0w[e] >> 16);
              vT[(64 + d) * GLA_LD + t] = (bf16)(v1w[e] & 0xffffu); vT[(64 + d + 1) * GLA_LD + t] = (bf16)(v1w[e] >> 16); }
          *(v4u*)(Qd + t * GLA_LD + d0) = cur.qd; *(v4u*)(Ki + t * GLA_LD + d0) = cur.ki; }
        __syncthreads();
        {
            f32x4 s2[2] = {(f32x4){0.f, 0.f, 0.f, 0.f}, (f32x4){0.f, 0.f, 0.f, 0.f}};
#pragma unroll
            for (int ks = 0; ks < 2; ++ks) { const bf16x8 af = *(const bf16x8*)(Qd + (16 * rt + l15) * GLA_LD + ks * 32 + 8 * quad);
#pragma unroll
                for (int j2 = 0; j2 < 2; ++j2) { const bf16x8 bfr = *(const bf16x8*)(Ki + (16 * (2 * ch + j2) + l15) * GLA_LD + ks * 32 + 8 * quad); s2[j2] = mfma16(af, bfr, s2[j2]); } }
#pragma unroll
            for (int j2 = 0; j2 < 2; ++j2)
#pragma unroll
                for (int r = 0; r < 4; ++r) { const int i = 16 * rt + 4 * quad + r, j = 16 * (2 * ch + j2) + l15; At[i * GLA_LD + j] = (bf16)f2bf(j <= i ? s2[j2][r] : 0.f); }
        }
        __syncthreads();
        f32x4 o[4];
#pragma unroll
        for (int vt = 0; vt < 4; ++vt) o[vt] = (f32x4){0.f, 0.f, 0.f, 0.f};
#pragma unroll
        for (int ks = 0; ks < 2; ++ks) {
            const bf16x8 a1 = *(const bf16x8*)(At + (16 * rt + l15) * GLA_LD + ks * 32 + 8 * quad);
            const bf16x8 a2 = *(const bf16x8*)(Qd + (16 * rt + l15) * GLA_LD + ks * 32 + 8 * quad);
#pragma unroll
            for (int vt = 0; vt < 4; ++vt) { const bf16x8 b1 = *(const bf16x8*)(vT + (16 * (4 * ch + vt) + l15) * GLA_LD + ks * 32 + 8 * quad);
                o[vt] = mfma16(a1, b1, o[vt]); o[vt] = mfma16(a2, sfr[ks][vt], o[vt]); } }
#pragma unroll
        for (int r = 0; r < 4; ++r) { float sq = 0.f;
#pragma unroll
            for (int vt = 0; vt < 4; ++vt) sq += o[vt][r] * o[vt][r];
            sq += __shfl_xor(sq, 1); sq += __shfl_xor(sq, 2); sq += __shfl_xor(sq, 4); sq += __shfl_xor(sq, 8);
            if (l15 == 0) part[ch * 64 + 16 * rt + 4 * quad + r] = sq; }
        __syncthreads();
#pragma unroll
        for (int r = 0; r < 4; ++r) { const int i = 16 * rt + 4 * quad + r; const float rstd = 1.0f / sqrtf((part[i] + part[64 + i]) * (1.f / 128.f) + EPS);
#pragma unroll
            for (int vt = 0; vt < 4; ++vt) { const int v = 16 * (4 * ch + vt) + l15; const float rgf = bf2f(rg[r][vt]);
                a.mix[(size_t)(m0 + i) * 1024 + h * 128 + v] = (bf16)f2bf(o[vt][r] * rstd * a.gnw[v] * (rgf / (1.f + __expf(-rgf)))); } }
        cur = nxt;
    }
}

template <class T> __device__ __forceinline__ T ntl(const T* p) { return __builtin_nontemporal_load(p); }
template <class T> __device__ __forceinline__ void nts(T* p, T v) { __builtin_nontemporal_store(v, p); }
struct RowBuf { f32x4 x[4]; v2u r[4]; };
__device__ __forceinline__ void row_load(RowBuf& b, const float* xrow, const bf16* raw, int lane) {
#pragma unroll
    for (int j = 0; j < 4; ++j) { b.x[j] = ntl((const f32x4*)xrow + lane + 64 * j); b.r[j] = ntl((const v2u*)raw + lane + 64 * j); }
}
__device__ __forceinline__ f32x4 bf4(v2u rw);
__device__ __forceinline__ float row_ss(const v2u (&r)[4]);
__device__ __forceinline__ f32x4 bf4(v2u rw) { return (f32x4){bf2f(rw.x & 0xffffu), bf2f(rw.x >> 16), bf2f(rw.y & 0xffffu), bf2f(rw.y >> 16)}; }
__device__ __forceinline__ void p6_finish(const RowBuf& b, const float* wpost, const float* wpre, bf16* x1b, bf16* hn, int lane) {
    const float r1 = 1.0f / sqrtf(row_ss(b.r) * (1.f / DM) + EPS);
    f32x4 v[4]; float s = 0.f;
#pragma unroll
    for (int j = 0; j < 4; ++j) { v[j] = b.x[j] + (bf4(b.r[j]) * r1) * ((const f32x4*)wpost)[lane + 64 * j];
        s += (v[j].x * v[j].x + v[j].y * v[j].y) + (v[j].z * v[j].z + v[j].w * v[j].w);
        v2u o; o.x = pk2(v[j].x, v[j].y); o.y = pk2(v[j].z, v[j].w); ((v2u*)x1b)[lane + 64 * j] = o; }
    const float r2 = 1.0f / sqrtf(wave_sum(s) * (1.f / DM) + EPS);
#pragma unroll
    for (int j = 0; j < 4; ++j) { const f32x4 wv = ((const f32x4*)wpre)[lane + 64 * j]; const f32x4 y = (v[j] * r2) * wv;
        v2u o; o.x = pk2(y.x, y.y); o.y = pk2(y.z, y.w); ((v2u*)hn)[lane + 64 * j] = o; }
}
__device__ __forceinline__ float row_ss(const v2u (&r)[4]) { float s = 0.f;
#pragma unroll
    for (int j = 0; j < 4; ++j) { const f32x4 o = bf4(r[j]); s += (o.x * o.x + o.y * o.y) + (o.z * o.z + o.w * o.w); }
    return wave_sum(s); }
__device__ __forceinline__ void p6_rows(const float* x, bf16* raw, const float* wpost, const float* wpre, bf16* hn, int gw, int NGW, int lane) {
    if (gw >= M) return;
    RowBuf cur, nxt; row_load(cur, x + (size_t)gw * DM, raw + (size_t)gw * DM, lane);
    for (int m = gw; m < M; m += NGW) { const int mn = (m + NGW < M) ? m + NGW : m;
        if (mn != m) row_load(nxt, x + (size_t)mn * DM, raw + (size_t)mn * DM, lane);
        p6_finish(cur, wpost, wpre, raw + (size_t)m * DM, hn + (size_t)m * DM, lane); cur = nxt; }
}
__device__ __forceinline__ void p9_rows(const bf16* x1b, const bf16* raw2, const float* wpost2, float* out, int gw, int NGW, int lane) {
    if (gw >= M) return;
    v2u cx[4], c2[4], nx[4], n2[4];
#pragma unroll
    for (int j = 0; j < 4; ++j) { cx[j] = ntl((const v2u*)(x1b + (size_t)gw * DM) + lane + 64 * j); c2[j] = ntl((const v2u*)(raw2 + (size_t)gw * DM) + lane + 64 * j); }
    for (int m = gw; m < M; m += NGW) { const int mn = (m + NGW < M) ? m + NGW : m;
#pragma unroll
        for (int j = 0; j < 4; ++j) { nx[j] = ntl((const v2u*)(x1b + (size_t)mn * DM) + lane + 64 * j); n2[j] = ntl((const v2u*)(raw2 + (size_t)mn * DM) + lane + 64 * j); }
        const float r2 = 1.0f / sqrtf(row_ss(c2) * (1.f / DM) + EPS);
#pragma unroll
        for (int j = 0; j < 4; ++j) nts((f32x4*)(out + (size_t)m * DM) + lane + 64 * j, bf4(cx[j]) + (bf4(c2[j]) * r2) * ((const f32x4*)wpost2)[lane + 64 * j]);
#pragma unroll
        for (int j = 0; j < 4; ++j) { cx[j] = nx[j]; c2[j] = n2[j]; } }
}
__device__ __forceinline__ unsigned okey_of(float s) { const unsigned u = __float_as_uint(s); return (u & 0x80000000u) ? ~u : (u | 0x80000000u); }
__device__ __forceinline__ void cnt_ge(unsigned& n, unsigned k, unsigned c) { asm volatile("v_cmp_ge_u32 vcc, %1, %2\n\tv_addc_co_u32 %0, vcc, 0, %0, vcc" : "+v"(n) : "v"(k), "v"(c) : "vcc"); }
__device__ __forceinline__ void cnt_gt(unsigned& n, unsigned k, unsigned c) { asm volatile("v_cmp_gt_u32 vcc, %1, %2\n\tv_addc_co_u32 %0, vcc, 0, %0, vcc" : "+v"(n) : "v"(k), "v"(c) : "vcc"); }
__device__ __forceinline__ void cnt_tie(unsigned& n, unsigned k, unsigned T, unsigned lo, unsigned c) { unsigned tmp;
    asm volatile("v_cmp_eq_u32 vcc, %2, %3\n\tv_cndmask_b32 %1, 0, %4, vcc\n\tv_cmp_ge_u32 vcc, %1, %5\n\tv_addc_co_u32 %0, vcc, 0, %0, vcc" : "+v"(n), "=&v"(tmp) : "v"(k), "v"(T), "v"(lo), "v"(c) : "vcc"); }
#ifndef PROBE_IDX
#define PROBE_IDX 0
#endif
typedef _Float16 f16x8 __attribute__((ext_vector_type(8)));
__device__ __forceinline__ f32x4 mfma16h(f16x8 a, f16x8 b, f32x4 c) { return __builtin_amdgcn_mfma_f32_16x16x32_f16(a, b, c, 0, 0, 0); }
struct IdxArgs { const bf16 *iqh, *iql, *ikh, *ikl; const float* iw; unsigned short* mask16; const float* qb; float kbound; };
constexpr int IDX_ROUNDS = 45;
constexpr int IDX_NB = 2048, IDX_CAP = 512;
constexpr int IDX_HIST = 0, IDX_CAND = 8 * IDX_NB * 4, IDX_SMALL = IDX_CAND + 8 * IDX_CAP * 8;
__device__ __forceinline__ float okey_to_f(unsigned k) { return __uint_as_float((k & 0x80000000u) ? (k & 0x7fffffffu) : ~k); }
__device__ __forceinline__ unsigned idx_bin(float s, float inv) { return min((unsigned)__builtin_fmaf(s, inv, 0.5f * IDX_NB), (unsigned)(IDX_NB - 1)); }
template <int NI, int PV>
__device__ __forceinline__ void indexer_unit_t(const IdxArgs& a, int b, int c, int g, char* ldsg, int tid, int probe) {
    int lane_ = tid & 63; asm volatile("" : "+v"(lane_));
    const int lane = lane_, w = __builtin_amdgcn_readfirstlane(tid >> 6), quad = lane >> 4, l15 = lane & 15;
    const int q0 = b * SEQ + c * 64 + g * 8, ntile = 4 * (c + 1), nloc = (ntile - w + 7) >> 3;
    unsigned* hist = (unsigned*)(ldsg + IDX_HIST); unsigned long long* cand = (unsigned long long*)(ldsg + IDX_CAND); unsigned* sm = (unsigned*)(ldsg + IDX_SMALL);
    unsigned* qmin = sm; unsigned* qmax = sm + 8; unsigned* bstar = sm + 16; unsigned* above = sm + 24; unsigned* candn = sm + 32; unsigned* Tq = sm + 40; unsigned* Lq = sm + 48; unsigned* ovf = sm + 56; unsigned* dump = sm + 60; unsigned* cnt = sm + 64;
    __syncthreads();
    { v4u z = {0u, 0u, 0u, 0u}; v4u* h4 = (v4u*)hist;
#pragma unroll
      for (int k = 0; k < 8; ++k) h4[tid + k * NTHR] = z;
      if (tid < 8) candn[tid] = 0u;
      if (tid == 8) ovf[0] = 0u; }
    f16x8 aqh[2][2], aql[2][2]; f32x4 wq[2];
#pragma unroll
    for (int rt = 0; rt < 2; ++rt) {
#pragma unroll
        for (int ks = 0; ks < 2; ++ks) { const size_t p = ((size_t)(q0 + rt * 4 + (l15 >> 2)) * 4 + (l15 & 3)) * 64 + ks * 32 + 8 * quad;
            aqh[rt][ks] = *(const f16x8*)(a.iqh + p); aql[rt][ks] = *(const f16x8*)(a.iql + p); }
        wq[rt] = *(const f32x4*)(a.iw + (size_t)(q0 + rt * 4 + quad) * 4); }
    float sc[NI][2];
    const float kmx = a.kbound * 0.1666667f; const float inv0 = (0.5f * IDX_NB) / (a.qb[q0 + quad] * kmx), inv1 = (0.5f * IDX_NB) / (a.qb[q0 + 4 + quad] * kmx);
    __syncthreads();
    const char* khb = (const char*)a.ikh + (size_t)b * SEQ * 128;
    const unsigned koff = (unsigned)lane * 16u;
    constexpr int RING = 8;
    f16x8 kb[RING][2];
#define IDX_LOAD(i) do { const int tc_ = (probe >= 4) ? 0 : min(w + 8 * (i), ntile - 1); const unsigned o_ = koff + (unsigned)tc_ * 2048u; kb[(i) % RING][0] = *(const f16x8*)(khb + o_); kb[(i) % RING][1] = *(const f16x8*)(khb + (o_ + 1024u)); } while (0)
#pragma unroll
    for (int i = 0; i < RING - 1; ++i) IDX_LOAD(i);
#pragma unroll
    for (int i = 0; i < NI; ++i) {
        if (i + RING - 1 < NI) IDX_LOAD(i + RING - 1);
        const f16x8 bh0 = kb[i % RING][0], bh1 = kb[i % RING][1];
#pragma unroll
        for (int rt = 0; rt < 2; ++rt) { f32x4 acc = {0.f, 0.f, 0.f, 0.f};
            acc = mfma16h(aqh[rt][0], bh0, acc); acc = mfma16h(aqh[rt][1], bh1, acc); acc = mfma16h(aql[rt][0], bh0, acc); acc = mfma16h(aql[rt][1], bh1, acc);
            if constexpr (PV == 5) sc[i][rt] = acc[0] + acc[1] + acc[2] + acc[3]; else
            sc[i][rt] = ((__builtin_amdgcn_fmed3f(acc[0], 0.f, wq[rt][0]) + __builtin_amdgcn_fmed3f(acc[1], 0.f, wq[rt][1])) + __builtin_amdgcn_fmed3f(acc[2], 0.f, wq[rt][2])) + __builtin_amdgcn_fmed3f(acc[3], 0.f, wq[rt][3]); }
        { const unsigned one = (i < nloc) ? 1u : 0u;
          atomicAdd(&hist[quad * IDX_NB + idx_bin(sc[i][0], inv0)], one); atomicAdd(&hist[(4 + quad) * IDX_NB + idx_bin(sc[i][1], inv1)], one); }
        __builtin_amdgcn_sched_barrier(0);
    }
#undef IDX_LOAD
    if (probe == 1 || probe >= 4) return;
    __syncthreads();
    { const v4u* hq = (const v4u*)(hist + w * IDX_NB) + lane * 8; unsigned cntv[32]; unsigned tot = 0u;
#pragma unroll
      for (int k = 0; k < 8; ++k) { const v4u v = hq[k]; cntv[4 * k] = v.x; cntv[4 * k + 1] = v.y; cntv[4 * k + 2] = v.z; cntv[4 * k + 3] = v.w; tot += (v.x + v.y) + (v.z + v.w); }
      unsigned suf = tot;
#pragma unroll
      for (int o = 1; o < 64; o <<= 1) { const unsigned t = __shfl_down(suf, o); if (lane + o < 64) suf += t; }
      unsigned run = suf - tot;
      int bj = -1; unsigned ab = 0u;
#pragma unroll
      for (int j = 31; j >= 0; --j) { const unsigned cj = cntv[j]; const bool hit = (run < (unsigned)TOPK) && (run + cj >= (unsigned)TOPK); bj = hit ? j : bj; ab = hit ? run : ab; run += cj; }
      if (bj >= 0) { bstar[w] = (unsigned)(lane * 32 + bj); above[w] = ab; } }
    __syncthreads();
    if (probe == 2) return;
    const unsigned lo_base = 4095u - (unsigned)(16 * w + l15);
    { const unsigned bs0 = bstar[quad], bs1 = bstar[4 + quad];
#pragma unroll
      for (int i = 0; i < NI; ++i) { const unsigned lo = lo_base - 128u * (unsigned)i; const bool act = (i < nloc);
          if (act && idx_bin(sc[i][0], inv0) == bs0) { const unsigned slot = atomicAdd(&candn[quad], 1u); if (slot < (unsigned)IDX_CAP) cand[quad * IDX_CAP + slot] = ((unsigned long long)okey_of(sc[i][0]) << 12) | lo; }
          if (act && idx_bin(sc[i][1], inv1) == bs1) { const unsigned slot = atomicAdd(&candn[4 + quad], 1u); if (slot < (unsigned)IDX_CAP) cand[(4 + quad) * IDX_CAP + slot] = ((unsigned long long)okey_of(sc[i][1]) << 12) | lo; } } }
    __syncthreads();
    if (probe == 7) return;
    { const unsigned L = candn[w], need = (unsigned)TOPK - above[w];
      if (L > (unsigned)IDX_CAP) { if (lane == 0) ovf[0] = 1u; }
      else if (L <= 64u) {
        const unsigned long long mine = ((unsigned)lane < L) ? cand[w * IDX_CAP + lane] : 0ull; const unsigned mlo = (unsigned)mine, mhi = (unsigned)(mine >> 32); unsigned rank = 0u;
        for (unsigned i = 0; i < L; ++i) { const unsigned long long o = ((unsigned long long)(unsigned)__builtin_amdgcn_readlane((int)mhi, (int)i) << 32) | (unsigned)__builtin_amdgcn_readlane((int)mlo, (int)i); rank += (o > mine) ? 1u : 0u; }
        const unsigned long long bal = __ballot((unsigned)lane < L && rank + 1u == need); const int src = (int)__ffsll((long long)bal) - 1;
        const unsigned klo = (unsigned)__builtin_amdgcn_readlane((int)mlo, src), khi = (unsigned)__builtin_amdgcn_readlane((int)mhi, src);
        if (lane == 0) { Tq[w] = (khi << 20) | (klo >> 12); Lq[w] = klo & 0xfffu; } }
      else { unsigned long long ck[8];
#pragma unroll
        for (int j = 0; j < 8; ++j) ck[j] = ((unsigned)(j * 64 + lane) < L) ? cand[w * IDX_CAP + j * 64 + lane] : 0ull;
        unsigned long long Kth = 0ull;
#pragma nounroll
        for (int bit = 43; bit >= 0; --bit) { const unsigned long long cv = Kth | (1ull << bit); unsigned n = 0u;
#pragma unroll
            for (int j = 0; j < 8; ++j) if ((unsigned)(j * 64) < L) n += (unsigned)__popcll(__ballot(ck[j] >= cv));
            if (n >= need) Kth = cv; }
        if (lane == 0) { Tq[w] = (unsigned)(Kth >> 12); Lq[w] = (unsigned)Kth & 0xfffu; } } }
    __syncthreads();
    if (probe == 3) return;
    unsigned T0, T1, L0, L1; float Tf0, Tf1;
    if (ovf[0] == 0u) { Tf0 = okey_to_f(Tq[quad]); Tf1 = okey_to_f(Tq[4 + quad]); L0 = Lq[quad]; L1 = Lq[4 + quad];
    } else {
#pragma unroll
        for (int i = 0; i < NI; ++i) { sc[i][0] = (i < nloc) ? __uint_as_float(okey_of(sc[i][0])) : 0.f; sc[i][1] = (i < nloc) ? __uint_as_float(okey_of(sc[i][1])) : 0.f; }
        for (int i = tid; i < IDX_ROUNDS * 8; i += NTHR) cnt[i] = 0u;
        __syncthreads();
        T0 = 0u; T1 = 0u;
#pragma nounroll
        for (int rd = 0; rd < 32; ++rd) {
            const unsigned c0v = T0 | (0x80000000u >> rd), c1v = T1 | (0x80000000u >> rd); unsigned n0 = 0u, n1 = 0u;
#pragma unroll
            for (int i = 0; i < NI; ++i) { cnt_ge(n0, __float_as_uint(sc[i][0]), c0v); cnt_ge(n1, __float_as_uint(sc[i][1]), c1v); }
#pragma unroll
            for (int o = 1; o < 16; o <<= 1) { n0 += __shfl_xor(n0, o); n1 += __shfl_xor(n1, o); }
            if (l15 == 0) { atomicAdd(&cnt[rd * 8 + quad], n0); atomicAdd(&cnt[rd * 8 + 4 + quad], n1); }
            __syncthreads();
            if (cnt[rd * 8 + quad] >= (unsigned)TOPK) T0 = c0v;
            if (cnt[rd * 8 + 4 + quad] >= (unsigned)TOPK) T1 = c1v;
        }
        { unsigned n0 = 0u, n1 = 0u;
#pragma unroll
          for (int i = 0; i < NI; ++i) { cnt_gt(n0, __float_as_uint(sc[i][0]), T0); cnt_gt(n1, __float_as_uint(sc[i][1]), T1); }
#pragma unroll
          for (int o = 1; o < 16; o <<= 1) { n0 += __shfl_xor(n0, o); n1 += __shfl_xor(n1, o); }
          if (l15 == 0) { atomicAdd(&cnt[32 * 8 + quad], n0); atomicAdd(&cnt[32 * 8 + 4 + quad], n1); }
          __syncthreads(); }
        const unsigned need0 = (unsigned)TOPK - cnt[32 * 8 + quad], need1 = (unsigned)TOPK - cnt[32 * 8 + 4 + quad];
        L0 = 0u; L1 = 0u;
#pragma nounroll
        for (int rd = 0; rd < 12; ++rd) {
            const unsigned c0v = L0 | (0x800u >> rd), c1v = L1 | (0x800u >> rd); unsigned n0 = 0u, n1 = 0u;
#pragma unroll
            for (int i = 0; i < NI; ++i) { const unsigned lo = lo_base - 128u * (unsigned)i; cnt_tie(n0, __float_as_uint(sc[i][0]), T0, lo, c0v); cnt_tie(n1, __float_as_uint(sc[i][1]), T1, lo, c1v); }
#pragma unroll
            for (int o = 1; o < 16; o <<= 1) { n0 += __shfl_xor(n0, o); n1 += __shfl_xor(n1, o); }
            if (l15 == 0) { atomicAdd(&cnt[(33 + rd) * 8 + quad], n0); atomicAdd(&cnt[(33 + rd) * 8 + 4 + quad], n1); }
            __syncthreads();
            if (cnt[(33 + rd) * 8 + quad] >= need0) L0 = c0v;
            if (cnt[(33 + rd) * 8 + 4 + quad] >= need1) L1 = c1v;
        }
        Tf0 = okey_to_f(T0); Tf1 = okey_to_f(T1);
#pragma unroll
        for (int i = 0; i < NI; ++i) { sc[i][0] = okey_to_f(__float_as_uint(sc[i][0])); sc[i][1] = okey_to_f(__float_as_uint(sc[i][1])); }
    }
#pragma unroll
    for (int i = 0; i < NI; ++i) {
        const int t = w + 8 * i; const unsigned lo = lo_base - 128u * (unsigned)i; const bool act = (i < nloc);
#pragma unroll
        for (int rt = 0; rt < 2; ++rt) { const float k = sc[i][rt], T = rt ? Tf1 : Tf0; const unsigned L = rt ? L1 : L0;
            const bool sel = (k > T) || (k == T && lo >= L);
            const unsigned long long bal = __ballot(sel);
            if (lane < 4 && act) a.mask16[(size_t)(q0 + rt * 4 + lane) * 256 + t] = (unsigned short)((bal >> (16 * lane)) & 0xffffull); }
        __builtin_amdgcn_sched_barrier(0);
    }
}
template <int PV>
__device__ __forceinline__ void indexer_unit(const IdxArgs& a, int b, int c, int g, char* ldsg, int tid, int probe) {
    if (c < 8) indexer_unit_t<4, PV>(a, b, c, g, ldsg, tid, probe); else if (c < 16) indexer_unit_t<8, PV>(a, b, c, g, ldsg, tid, probe); else if (c < 24) indexer_unit_t<12, PV>(a, b, c, g, ldsg, tid, probe); else if (c < 32) indexer_unit_t<16, PV>(a, b, c, g, ldsg, tid, probe);
    else if (c < 40) indexer_unit_t<20, PV>(a, b, c, g, ldsg, tid, probe); else if (c < 48) indexer_unit_t<24, PV>(a, b, c, g, ldsg, tid, probe); else if (c < 56) indexer_unit_t<28, PV>(a, b, c, g, ldsg, tid, probe); else indexer_unit_t<32, PV>(a, b, c, g, ldsg, tid, probe);
}

namespace att {
using s16x4  = __attribute__((ext_vector_type(4))) short;
using f32x16 = __attribute__((ext_vector_type(16))) float;
using u32x4  = __attribute__((ext_vector_type(4))) unsigned;
constexpr int D = 128, NW = 8, QBLK = 32, KVBLK = 64;
constexpr float SCALE = 0.088388347648318440f, THR = 8.f;
constexpr int SHM_V = KVBLK * D * 2, SHM_K = KVBLK * D * 2, SHM_Q0 = 2 * SHM_V + 2 * SHM_K + NW * 64 * 4, SHM_ATTN = SHM_Q0 + 256 * D * 2;
constexpr int LDK = 128, LDV = NMAIN;
#define KSWZ(row, colB) ((row) * 256 + ((colB) ^ (((row) & 7) << 4)))
#define SBAR() __builtin_amdgcn_sched_barrier(0)
__device__ __forceinline__ int crow(int r, int hi) { return (r & 3) + 8 * (r >> 2) + 4 * hi; }
__device__ __forceinline__ unsigned cvtpk(float lo, float hi) { unsigned r; asm volatile("v_cvt_pk_bf16_f32 %0, %1, %2" : "=v"(r) : "v"(lo), "v"(hi)); return r; }
__device__ __forceinline__ float mask_and(float e, unsigned m, int pos) { float r; asm("v_bfe_i32 %0, %1, %2, 1\n\tv_and_b32 %0, %0, %3" : "=&v"(r) : "v"(m), "n"(pos), "v"(e)); return r; }
__device__ __forceinline__ void partialSM(f32x16& p0, f32x16& p1, float& m_reg, float& mn, float& alpha, unsigned ml) {
  constexpr float C = SCALE * 1.4426950408889634f;
  float pmax = p0[0];
#pragma unroll
  for (int r = 1; r < 16; ++r) pmax = fmaxf(pmax, p0[r]);
#pragma unroll
  for (int r = 0; r < 16; ++r) pmax = fmaxf(pmax, p1[r]);
  { auto rr = __builtin_amdgcn_permlane32_swap(__float_as_uint(pmax), __float_as_uint(pmax), false, false);
    pmax = fmaxf(__uint_as_float(rr[0]), __uint_as_float(rr[1])); }
  if (__builtin_expect(__all(pmax - m_reg <= THR / SCALE), 1)) { mn = m_reg; alpha = 1.f; }
  else { mn = fmaxf(m_reg, pmax); alpha = __builtin_amdgcn_exp2f((m_reg - mn) * C); m_reg = mn; }
  const float mnC = -mn * C;
#pragma unroll
  for (int r = 0; r < 16; ++r) p0[r] = fmaf(p0[r], C, mnC);
#pragma unroll
  for (int r = 0; r < 16; ++r) p1[r] = fmaf(p1[r], C, mnC);
#pragma unroll
  for (int r = 0; r < 16; ++r) p0[r] = mask_and(__builtin_amdgcn_exp2f(p0[r]), ml, (r & 3) + 8 * (r >> 2));
}
__device__ __forceinline__ void finishSM(f32x16& p0, f32x16& p1, float alpha, float& l_reg, bf16x8& pa0, bf16x8& pa1, bf16x8& pa2, bf16x8& pa3, unsigned mh) {
#pragma unroll
  for (int r = 0; r < 16; ++r) p1[r] = mask_and(__builtin_amdgcn_exp2f(p1[r]), mh, (r & 3) + 8 * (r >> 2));
  float ps = 0;
#pragma unroll
  for (int r = 0; r < 16; ++r) ps += p0[r];
#pragma unroll
  for (int r = 0; r < 16; ++r) ps += p1[r];
  { auto rr = __builtin_amdgcn_permlane32_swap(__float_as_uint(ps), __float_as_uint(ps), false, false);
    ps = __uint_as_float(rr[0]) + __uint_as_float(rr[1]); }
  l_reg = l_reg * alpha + ps;
#define PK4(P, BASE, OUT) do { unsigned a0 = cvtpk(P[BASE + 0], P[BASE + 1]), a1 = cvtpk(P[BASE + 2], P[BASE + 3]);   \
    unsigned b0 = cvtpk(P[BASE + 4], P[BASE + 5]), b1 = cvtpk(P[BASE + 6], P[BASE + 7]);                              \
    auto r0 = __builtin_amdgcn_permlane32_swap(a0, b0, false, false); auto r1 = __builtin_amdgcn_permlane32_swap(a1, b1, false, false); \
    u32x4 w = {r0[0], r1[0], r0[1], r1[1]}; OUT = *reinterpret_cast<bf16x8*>(&w); } while (0)
  PK4(p0, 0, pa0); PK4(p0, 8, pa1); PK4(p1, 0, pa2); PK4(p1, 8, pa3);
#undef PK4
}
__device__ __forceinline__ void qkt(f32x16& p0, f32x16& p1, const bf16* Ks, const char* Qs, int r32, int hi) {
  p0 = f32x16{}; p1 = f32x16{};
#pragma unroll
  for (int d0 = 0; d0 < 8; ++d0) { int cb = (d0 * 16 + hi * 8) * 2;
    bf16x8 b0 = *reinterpret_cast<const bf16x8*>((const char*)Ks + KSWZ(r32, cb));
    bf16x8 b1 = *reinterpret_cast<const bf16x8*>((const char*)Ks + KSWZ(32 + r32, cb));
    bf16x8 q = *reinterpret_cast<const bf16x8*>(Qs + KSWZ(r32, cb));
    p0 = __builtin_amdgcn_mfma_f32_32x32x16_bf16(b0, q, p0, 0, 0, 0);
    p1 = __builtin_amdgcn_mfma_f32_32x32x16_bf16(b1, q, p1, 0, 0, 0); }
}
__device__ __forceinline__ int v_st(int k, int c) { const int kk = (k & ~0xC) | ((k & 4) << 1) | ((k & 8) >> 1); return ((kk >> 3) * 4 + (c >> 5)) * 512 + ((kk & 7) * 32 + (c & 31)) * 2; }
__device__ __forceinline__ int v_rd_base(int lane) { return ((lane & 3) << 3) | (((lane >> 2) & 3) << 6) | (((lane >> 4) & 1) << 5) | (((lane >> 5) & 1) << 8); }
constexpr int v_rd_off(int d0, int ks, int half) { return d0 * 512 + ks * 4096 + half * 2048; }
template <int OFF> __device__ __forceinline__ s16x4 tr_read(int vb) {
  s16x4 r; asm volatile("ds_read_b64_tr_b16 %0, %1 offset:%2" : "=&v"(r) : "v"(vb), "i"(OFF) : "memory"); return r;
}
template <int D0> __device__ __forceinline__ void pv_one(f32x16& od, int vb, bf16x8 pa0, bf16x8 pa1, bf16x8 pa2, bf16x8 pa3) {
  const s16x4 l0 = tr_read<v_rd_off(D0, 0, 0)>(vb), h0 = tr_read<v_rd_off(D0, 0, 1)>(vb), l1 = tr_read<v_rd_off(D0, 1, 0)>(vb), h1 = tr_read<v_rd_off(D0, 1, 1)>(vb);
  const s16x4 l2 = tr_read<v_rd_off(D0, 2, 0)>(vb), h2 = tr_read<v_rd_off(D0, 2, 1)>(vb), l3 = tr_read<v_rd_off(D0, 3, 0)>(vb), h3 = tr_read<v_rd_off(D0, 3, 1)>(vb);
  asm volatile("s_waitcnt lgkmcnt(0)" ::: "memory"); SBAR();
#define PK(L, H) (bf16x8){L[0], L[1], L[2], L[3], H[0], H[1], H[2], H[3]}
  od = __builtin_amdgcn_mfma_f32_32x32x16_bf16(pa0, PK(l0, h0), od, 0, 0, 0);
  od = __builtin_amdgcn_mfma_f32_32x32x16_bf16(pa1, PK(l1, h1), od, 0, 0, 0);
  od = __builtin_amdgcn_mfma_f32_32x32x16_bf16(pa2, PK(l2, h2), od, 0, 0, 0);
  od = __builtin_amdgcn_mfma_f32_32x32x16_bf16(pa3, PK(l3, h3), od, 0, 0, 0);
#undef PK
}
__device__ __forceinline__ void pv_d0(f32x16* o, int vb, bf16x8 pa0, bf16x8 pa1, bf16x8 pa2, bf16x8 pa3) {
  pv_one<0>(o[0], vb, pa0, pa1, pa2, pa3); pv_one<1>(o[1], vb, pa0, pa1, pa2, pa3); pv_one<2>(o[2], vb, pa0, pa1, pa2, pa3); pv_one<3>(o[3], vb, pa0, pa1, pa2, pa3);
}
__device__ __forceinline__ void attn_unit(const bf16* __restrict__ QR, const bf16* __restrict__ KR, const bf16* __restrict__ PMAIN, const unsigned long long* __restrict__ MASK,
                                          bf16* __restrict__ MIX, int b, int c, char* lds) {
  const int tid = threadIdx.x, wid = tid >> 6, lane = tid & 63, r32 = lane & 31, hi = lane >> 5;
  bf16* V_lds = (bf16*)lds; bf16* K_lds = (bf16*)(lds + 2 * SHM_V);
  float* ws = (float*)(lds + 2 * SHM_V + 2 * SHM_K) + wid * 64; float* li_l = ws; float* al_l = ws + 32;
  float m_reg = -1e30f, l_reg = 0; f32x16 o[4] = {};
  const char* qr = lds + SHM_Q0 + wid * (QBLK * 256);
  const int tok0 = b * SEQ + c * 64, qloc = 8 * wid + (r32 >> 2);
  const bf16* Kh = KR + (size_t)b * SEQ * LDK; const bf16* Vh = PMAIN + (size_t)b * SEQ * LDV + PM_DV;
  const char* mb = (const char*)MASK + (size_t)tok0 * 512; const unsigned moff = (unsigned)qloc * 512u; const bool allsel = (c <= 3);
  const int NTR = c + 1, NT = (NTR + 1) & ~1;
#define GETMASK(kt, ML, MH) do { unsigned long long mm_ = allsel ? ~0ull : *(const unsigned long long*)(mb + (moff + 8u * (unsigned)(kt))); if ((kt) >= NTR) mm_ = 0ull; ML = (unsigned)mm_ >> (4 * hi); MH = (unsigned)(mm_ >> 32) >> (4 * hi); } while (0)
  const int sr = tid >> 4, sc = (tid & 15) * 8, vst0 = v_st(sr, sc), vst1 = v_st(32 + sr, sc);
  const int vb0 = (int)(uintptr_t)V_lds + v_rd_base(lane);
  struct { bf16x8 vs0, vs1, ks0, ks1; } sr_[1];
const unsigned offV0 = (unsigned)(sr * LDV + sc) * 2u, offV1 = offV0 + 32u * LDV * 2u, offK0 = (unsigned)(sr * LDK + sc) * 2u, offK1 = offK0 + 32u * LDK * 2u;
#define SLOAD(i, k0) do { const char* vb_ = (const char*)Vh + (size_t)(k0) * (LDV * 2); const char* kb_ = (const char*)Kh + (size_t)(k0) * (LDK * 2); \
    sr_[i].vs0 = *(const bf16x8*)(vb_ + offV0); sr_[i].vs1 = *(const bf16x8*)(vb_ + offV1); sr_[i].ks0 = *(const bf16x8*)(kb_ + offK0); sr_[i].ks1 = *(const bf16x8*)(kb_ + offK1); } while (0)
#define SWRITE(bb, i) do { *(bf16x8*)((char*)V_lds + (bb) * SHM_V + vst0) = sr_[i].vs0;          \
    *(bf16x8*)((char*)V_lds + (bb) * SHM_V + vst1) = sr_[i].vs1; int kc = sc * 2;               \
    *(bf16x8*)((char*)K_lds + (bb) * SHM_K + KSWZ(sr, kc)) = sr_[i].ks0;                       \
    *(bf16x8*)((char*)K_lds + (bb) * SHM_K + KSWZ(32 + sr, kc)) = sr_[i].ks1; } while (0)
#define SWAIT() asm volatile("s_waitcnt vmcnt(0)" ::: "memory")
#define RESC(a) do { if (__any((a) < 1.f)) { if (hi == 0) al_l[r32] = (a); asm volatile("s_waitcnt lgkmcnt(0)" ::: "memory"); \
    _Pragma("unroll") for (int d = 0; d < 4; ++d) _Pragma("unroll") for (int r = 0; r < 16; ++r) o[d][r] *= al_l[crow(r, hi)]; } } while (0)
  f32x16 pA0, pA1, pB0, pB1; float mnA, mnB, alA, alB; bf16x8 pa0, pa1, pa2, pa3; unsigned mlA, mhA, mlB, mhB;
  constexpr int SE = 0, SO = 0;
  __syncthreads();
  { const char* qb = (const char*)QR + (size_t)tok0 * 1024; const unsigned qoff = (unsigned)(qloc * 512 + (r32 & 3) * 128 + hi * 8) * 2u;
#pragma unroll
    for (int d0 = 0; d0 < 8; ++d0) { const bf16x8 t = *reinterpret_cast<const bf16x8*>(qb + (qoff + 32u * d0)); *(bf16x8*)(const_cast<char*>(qr) + KSWZ(r32, (d0 * 16 + hi * 8) * 2)) = t; }
    asm volatile("s_waitcnt lgkmcnt(0)" ::: "memory"); }
  SLOAD(SE, 0); asm volatile("s_waitcnt vmcnt(0)" ::: "memory"); SWRITE(0, SE); __syncthreads();
  GETMASK(0, mlA, mhA);
  qkt(pA0, pA1, K_lds, qr, r32, hi); partialSM(pA0, pA1, m_reg, mnA, alA, mlA);
  SLOAD(SO, KVBLK);
  SWAIT(); SWRITE(1, SO); __syncthreads();
  for (int j = 1; j + 1 < NT; j += 2) {
    GETMASK(j, mlB, mhB);
    SBAR(); qkt(pB0, pB1, (bf16*)((char*)K_lds + SHM_K), qr, r32, hi);
    finishSM(pA0, pA1, alA, l_reg, pa0, pa1, pa2, pa3, mhA); SBAR();
    SLOAD(SO, (j + 1) * KVBLK); SBAR();
    pv_d0(o, vb0, pa0, pa1, pa2, pa3); partialSM(pB0, pB1, m_reg, mnB, alB, mlB);
    __syncthreads(); SWAIT(); SWRITE(0, SE);
    RESC(alB); __syncthreads();
    GETMASK(j + 1, mlA, mhA);
    SBAR(); qkt(pA0, pA1, K_lds, qr, r32, hi);
    finishSM(pB0, pB1, alB, l_reg, pa0, pa1, pa2, pa3, mhB); SBAR();
    SLOAD(SE, (j + 2) * KVBLK); SBAR();
    pv_d0(o, vb0 + (int)SHM_V, pa0, pa1, pa2, pa3); partialSM(pA0, pA1, m_reg, mnA, alA, mlA);
    __syncthreads(); SWAIT(); SWRITE(1, SO);
    RESC(alA); __syncthreads();
  }
  GETMASK(NT - 1, mlB, mhB);
  SBAR(); qkt(pB0, pB1, (bf16*)((char*)K_lds + SHM_K), qr, r32, hi);
  finishSM(pA0, pA1, alA, l_reg, pa0, pa1, pa2, pa3, mhA); SBAR();
  pv_d0(o, vb0, pa0, pa1, pa2, pa3); partialSM(pB0, pB1, m_reg, mnB, alB, mlB);
  __syncthreads(); RESC(alB);
  finishSM(pB0, pB1, alB, l_reg, pa0, pa1, pa2, pa3, mhB); SBAR();
  pv_d0(o, vb0 + (int)SHM_V, pa0, pa1, pa2, pa3);
  if (hi == 0) li_l[r32] = l_reg; asm volatile("s_waitcnt lgkmcnt(0)" ::: "memory");
  float rli[16];
#pragma unroll
  for (int r = 0; r < 16; ++r) rli[r] = __builtin_amdgcn_rcpf(li_l[crow(r, hi)]);
  { char* ob = (char*)MIX + (size_t)tok0 * 2048; const unsigned ooff = (unsigned)((8 * wid + hi) * 1024 + 512 + r32) * 2u;
#pragma unroll
    for (int r = 0; r < 16; ++r)
#pragma unroll
      for (int d0 = 0; d0 < 4; ++d0) *(bf16*)(ob + (size_t)((2 * (r >> 2) * 1024 + (r & 3) * 128 + d0 * 32) * 2) + ooff) = (bf16)f2bf(o[d0][r] * rli[r]); }
#undef GETMASK
#undef SLOAD
#undef SWRITE
#undef SWAIT
#undef RESC
}
}
#ifndef MK_ONE_LAUNCH
#define MK_ONE_LAUNCH 1
#endif
constexpr int NPHASE = 10;
static_assert(att::SHM_ATTN <= MISC_OFF && pg8::STAGE_BYTES <= MISC_OFF, "LDS map");
struct Args { const float* in[14]; float* out; unsigned char* ws; int ph_lo, ph_hi, li, pad; };
__global__ void __launch_bounds__(NTHR, 2) fwd_kernel(Args args) {
    extern __shared__ __attribute__((aligned(16))) unsigned char lds[];
    const int tid = threadIdx.x, lane = tid & 63, wave = __builtin_amdgcn_readfirstlane(tid >> 6), bid = blockIdx.x, G = gridDim.x;
    typedef const __attribute__((address_space(4))) Args* KArgs;
    const KArgs ka = (KArgs)__builtin_amdgcn_kernarg_segment_ptr(); (void)args;
    unsigned char* ws = ka->ws; char* ldsg = (char*)lds; LAS unsigned char* ldsl = (LAS unsigned char*)lds;
    if (tid < 64) ((LAS unsigned*)(ldsl + MISC_OFF))[tid] = 0u;
    __syncthreads();
    volatile LAS unsigned* MISC = (volatile LAS unsigned*)(ldsl + MISC_OFF);
    unsigned* ctl = (unsigned*)(ws + WS_CTL);
    const int lo = ka->ph_lo, hi = ka->ph_hi;
    XcdBarrier bar; bar.bar = ctl + CW_BAR + ka->li * XCD_BAR_WORDS; bar.x = 0; bar.st = nullptr;
    if (hi - lo > 1) bar = xcd_barrier_post(ctl + CW_BAR + ka->li * XCD_BAR_WORDS, MISC + 8);
#ifndef PROBE_REPEAT
#define PROBE_REPEAT (-1)
#endif
#ifndef PROBE_SUB
#define PROBE_SUB 0
#endif
#ifndef PH_ENABLE
#define PH_ENABLE 0x3ff
#endif
#define IN(k) (((PH_ENABLE >> (k)) & 1) && lo <= (k) && (k) < hi)
#define SEAM(k) do { if (IN(k) && IN((k) + 1)) xcd_barrier(bar); } while (0)
#define hcat ((bf16*)(ws + WS_HCAT))
#define winm ((bf16*)(ws + WS_WINM))
#define wspl ((bf16*)(ws + WS_WSPL))
#define wo ((bf16*)(ws + WS_WO))
#define w1t ((bf16*)(ws + WS_W1))
#define w2t ((bf16*)(ws + WS_W2))
#define tab128 ((f32x2*)(ws + WS_TAB128))
#define tab64 ((f32x2*)(ws + WS_TAB64))
#define pmain ((bf16*)(ws + WS_PMAIN))
#define pspl ((float*)(ws + WS_PSPL))
#define mix ((bf16*)(ws + WS_MIX))
#define oraw ((bf16*)(ws + WS_ORAW))
#define hn ((bf16*)(ws + WS_HN))
#define hid ((bf16*)(ws + WS_HID))
#define ffraw ((bf16*)(ws + WS_FFRAW))
#define ss1 ((float*)(ctl + CW_SS1))
#define ss2 ((float*)(ctl + CW_SS2))
#define GLA_ARGS GlaArgs ga{pmain, pspl, ka->in[3], ka->in[4], ka->in[5], (bf16*)(ws + WS_UT), (float*)(ws + WS_DECAY), (bf16*)(ws + WS_SIN), mix, (bf16*)(ws + WS_GQD), (bf16*)(ws + WS_GKI)}
    const int gw = bid * NWAVES + wave, NGW = G * NWAVES;
    const int sub = (PROBE_SUB != 0 && ka->li == 1) ? PROBE_SUB : 0;

    if (IN(0)) {
        P0Args a{ka->in[0], ka->in[1], ka->in[2], ka->in[8], ka->in[11], ka->in[12], hcat, winm, wspl, wo, w1t, w2t, tab128, tab64};
        p0_prologue(a, ldsg, bid, G, tid);
        SEAM(0);
    }
    if (IN(1)) {
        { pg8::Gemm g{hcat, winm, M, NMAIN, 1024, 2048, 1024, 1 << 30}; pg8::StaticOrder S; S.init(M, NMAIN, G, bid);
          pg8::EpiBf16X<0, false> E{pmain, NMAIN, nullptr};
          pg8::gemm_phase<pg8::EpiBf16X<0, false>, pg8::StaticOrder, true, true, true>(ldsl, g, S, E); }
        __syncthreads();
        { pg8::Gemm g{hcat, wspl, M, NSPLIT, KSPLIT, 2048, KSPLIT, 1 << 30}; pg8::StaticOrder S; S.init(M, NSPLIT, G, bid);
          pg8::EpiF32 E{pspl, NSPLIT};
          pg8::gemm_phase<pg8::EpiF32, pg8::StaticOrder, true, true, true>(ldsl, g, S, E); }
        SEAM(1);
    }
    if (IN(2)) {
        GLA_ARGS;
        P2Args a{pmain, pspl, tab128, tab64, ka->in[6], ka->in[7], (bf16*)(ws + WS_QR), (bf16*)(ws + WS_KR), (bf16*)(ws + WS_IKH), (bf16*)(ws + WS_IKL), (bf16*)(ws + WS_IQH), (bf16*)(ws + WS_IQL), (float*)(ws + WS_IW), (float*)(ws + WS_QB)};
        if (sub != 2) p2_post_rows(a, gw, NGW, lane);
        if (sub != 1) gla_local_phase(ga, ldsg, bid, G, tid);
        SEAM(2);
    }
    if (IN(3)) {
        GLA_ARGS;
#ifndef PROBE_IDX
#define PROBE_IDX 0
#endif
        const int probe = (PROBE_IDX != 0 && ka->li == 1) ? PROBE_IDX : 0;
        if (probe == 0) gla_scan(ga, bid, G, tid);
        float kbound; { const float lw = fabsf(ka->in[6][lane]), lb = ka->in[7][lane]; float mw = lw;
#pragma unroll
          for (int o = 1; o < 64; o <<= 1) mw = fmaxf(mw, __shfl_xor(mw, o));
          kbound = 8.0f * mw + sqrtf(wave_sum(lb * lb)); }
        IdxArgs a{(const bf16*)(ws + WS_IQH), (const bf16*)(ws + WS_IQL), (const bf16*)(ws + WS_IKH), (const bf16*)(ws + WS_IKL), (const float*)(ws + WS_IW), (unsigned short*)(ws + WS_MASK), (const float*)(ws + WS_QB), kbound};
        if (G == 256) {
            const int b = bid >> 5, g = (bid & 31) >> 2, j = bid & 3;
            for (int k = 14; k >= 0; --k) { const int r = (k < 14) ? ((k >> 1) * 8 + ((k & 1) ? 7 - j : j)) : 56 + j;
                indexer_unit<0>(a, b, 4 + r, g, ldsg, tid, probe); }
        } else {
            for (int it = bid; it < BATCH * 30 * 8; it += G) {
                const int b = it / 240, rem = it % 240, p = rem >> 3, g = rem & 7;
                indexer_unit<0>(a, b, 4 + p, g, ldsg, tid, probe); indexer_unit<0>(a, b, 63 - p, g, ldsg, tid, probe); }
        }
        SEAM(3);
    }
    if (IN(4)) {
        GLA_ARGS;
        if (sub != 2) gla_out_phase(ga, ldsg, bid, G, tid);
        if (sub != 1) for (int it = bid; it < BATCH * 32; it += G) {
            const int b = it & 7, p = it >> 3;
            for (int half = 0; half < 2; ++half)
                att::attn_unit((const bf16*)(ws + WS_QR), (const bf16*)(ws + WS_KR), pmain, (const unsigned long long*)(ws + WS_MASK), mix, b, half ? p : 63 - p, ldsg);
        }
        SEAM(4);
    }
    if (IN(5)) {
        __syncthreads();
        pg8::Gemm g{mix, wo, M, DM, 1024, 1024, 1024, 1 << 30}; pg8::StaticOrder S; S.init(M, DM, G, bid);
        pg8::EpiBf16X<0, false> E{oraw, DM, nullptr};
        pg8::gemm_phase<pg8::EpiBf16X<0, false>, pg8::StaticOrder, true, true>(ldsl, g, S, E);
        SEAM(5);
    }
    if (IN(6)) {
        p6_rows(ka->in[0], oraw, ka->in[9], ka->in[10], hn, gw, NGW, lane);
        SEAM(6);
    }
    if (IN(7)) {
        pg8::Gemm g{hn, w1t, M, DFF, 1024, 1024, 1024, 1 << 30}; pg8::StaticOrder S; S.init(M, DFF, G, bid);
        pg8::EpiBf16X<2, false> E{hid, DFF, nullptr};
        pg8::gemm_phase<pg8::EpiBf16X<2, false>, pg8::StaticOrder, true, true>(ldsl, g, S, E);
        SEAM(7);
    }
    if (IN(8)) {
        pg8::Gemm g{hid, w2t, M, DM, DFF, DFF, DFF, 1 << 30}; pg8::StaticOrder S; S.init(M, DM, G, bid);
        pg8::EpiBf16X<0, false> E{ffraw, DM, nullptr};
        pg8::gemm_phase<pg8::EpiBf16X<0, false>, pg8::StaticOrder, true, true>(ldsl, g, S, E);
        SEAM(8);
    }
    if (IN(9)) {
        p9_rows(oraw, ffraw, ka->in[13], ka->out, gw, NGW, lane);
    }
#undef IN
#undef SEAM
#undef hcat
#undef winm
#undef wspl
#undef wo
#undef w1t
#undef w2t
#undef tab128
#undef tab64
#undef pmain
#undef pspl
#undef mix
#undef oraw
#undef hn
#undef hid
#undef ffraw
#undef ss1
#undef ss2
#undef GLA_ARGS
}

extern "C" void kernel_launch(void* const* d_in, const int* in_sizes, int n_in, void* d_out, int out_size, void* d_ws, size_t ws_size, hipStream_t stream) {
    static int grid = 0;
    if (grid == 0) {
        if (n_in != 14 || in_sizes[0] != M * DM || out_size != M * DM || ws_size < WS_END) { fprintf(stderr, "kernel_launch: shape/workspace mismatch (n_in %d, in0 %d, out %d, ws %zu < %zu); nothing launched\n", n_in, n_in > 0 ? in_sizes[0] : -1, out_size, ws_size, (size_t)WS_END); grid = -1; return; }
        int dev = 0, cus = 0, per_cu = 0;
        if (hipGetDevice(&dev) != hipSuccess || hipDeviceGetAttribute(&cus, hipDeviceAttributeMultiprocessorCount, dev) != hipSuccess) { fprintf(stderr, "kernel_launch: device query failed\n"); grid = -1; return; }
        if (hipFuncSetAttribute((const void*)fwd_kernel, hipFuncAttributeMaxDynamicSharedMemorySize, LDS_BYTES) != hipSuccess) { fprintf(stderr, "kernel_launch: hipFuncSetAttribute(%d B LDS) failed\n", LDS_BYTES); grid = -1; return; }
        if (hipOccupancyMaxActiveBlocksPerMultiprocessor(&per_cu, (const void*)fwd_kernel, NTHR, LDS_BYTES) != hipSuccess || per_cu < 1) fprintf(stderr, "kernel_launch: note: occupancy query reports %d workgroups per CU\n", per_cu);
        (void)hipGetLastError();
        grid = cus;
    }
    if (grid < 0) return;
    if (hipMemsetAsync((char*)d_ws + WS_CTL, 0, CTL_ZERO_BYTES, stream) != hipSuccess) { fprintf(stderr, "kernel_launch: memset failed\n"); return; }
    Args a{};
    for (int i = 0; i < 14; ++i) a.in[i] = (const float*)d_in[i];
    a.out = (float*)d_out; a.ws = (unsigned char*)d_ws;
#if MK_ONE_LAUNCH && PROBE_REPEAT >= 0
    { const int k = PROBE_REPEAT; const int lo3[3] = {0, k, k + 1}, hi3[3] = {k + 1, k + 1, NPHASE};
      for (int li = 0; li < 3; ++li) { if (lo3[li] >= hi3[li]) continue; a.ph_lo = lo3[li]; a.ph_hi = hi3[li]; a.li = li;
          hipLaunchKernelGGL(fwd_kernel, dim3(grid), dim3(NTHR), LDS_BYTES, stream, a); } }
#elif MK_ONE_LAUNCH
    a.ph_lo = 0; a.ph_hi = NPHASE; a.li = 0;
    hipLaunchKernelGGL(fwd_kernel, dim3(grid), dim3(NTHR), LDS_BYTES, stream, a);
#else
    for (int ph = 0; ph < NPHASE; ++ph) { a.ph_lo = ph; a.ph_hi = ph + 1; a.li = ph;
        hipLaunchKernelGGL(fwd_kernel, dim3(grid), dim3(NTHR), LDS_BYTES, stream, a); }
#endif
    const hipError_t le = hipPeekAtLastError();
    if (le != hipSuccess) fprintf(stderr, "kernel_launch: launch failed: %s\n", hipGetErrorName(le));
}
```

```cpp
#include <hip/hip_runtime.h>
#include <cstdio>
#include <cstdint>
#include <cmath>
namespace pg8 {
#define PG8_LAS __attribute__((address_space(3)))
typedef unsigned short bf16_t;
typedef short bf16x8 __attribute__((ext_vector_type(8)));
typedef _Float16 f16x8_t __attribute__((ext_vector_type(8)));
typedef float f32x4 __attribute__((ext_vector_type(4)));
typedef unsigned u32x4 __attribute__((ext_vector_type(4)));
constexpr int BM = 256, BK = 64, HALF = 128, HTB = HALF * BK * 2  , STAGE_BYTES = 8 * HTB, NXCD = 8, WGM = 8;

__host__ __device__ __forceinline__ int lds_byte(int r, int c) { const int st = (r >> 4) * 2 + (c >> 5), rr = r & 15, cc = c & 31, ob = rr * 64 + cc * 2; return st * 1024 + (ob ^ (((ob >> 9) & 1) << 5)); }
__host__ __device__ __forceinline__ void stage_rc(int b, int& R, int& C) { const int st = b / 1024, sb = b % 1024, swz = sb ^ (((sb >> 9) & 1) << 5); R = (st >> 1) * 16 + swz / 64; C = (st & 1) * 32 + (swz % 64) / 2; }
__host__ __device__ __forceinline__ int perm32(int rho) { const int n = rho >> 4, i = rho & 15; return 8 * (i >> 2) + 4 * n + (i & 3); }

struct Unit { int pm, pn; };
struct Gemm { const bf16_t* A; const bf16_t* Bt; int M, N, K, lda, ldb, awrap; };

struct StaticOrder {
    int nM, nN, nwg, G, c;
    __host__ __device__ void init(int M, int N, int G_, int c_) { nM = M / BM; nN = N / BM; nwg = nM * nN; G = G_; c = c_; }
    __host__ __device__ bool next(int i, Unit& u) const {
        const long L = (long)i * G + c; if (L >= nwg) return false;
        int wgid = (int)L; { const int q = nwg / NXCD, r = nwg % NXCD, xcd = wgid % NXCD, off = wgid / NXCD; wgid = (xcd < r ? xcd * (q + 1) : r * (q + 1) + (xcd - r) * q) + off; }
        const int nig = WGM * nN, gid = wgid / nig, fm = gid * WGM, gsz = (nM - fm) < WGM ? (nM - fm) : WGM;
        u.pm = fm + ((wgid % nig) % gsz); u.pn = (wgid % nig) / gsz; return true;
    }
    __device__ __forceinline__ void a_ready(const Unit&) const {}
    __device__ __forceinline__ void done(const Unit&) const {}
};

__device__ __forceinline__ unsigned cvt_pk_bf16(float lo, float hi) { unsigned r; asm volatile("v_cvt_pk_bf16_f32 %0, %1, %2" : "=v"(r) : "v"(lo), "v"(hi)); return r; }
template <int ACT  , bool SS> struct EpiBf16X {
    static constexpr bool PERM = true, AFTER_DRAIN = false;
    bf16_t* O; int ldc; float* ss;
    __device__ __forceinline__ void operator()(const f32x4 (&acc)[2][2][4][2], const Unit& u, int wr, int wc, int fr, int fq) const {
        const int row0 = u.pm * BM + wr * 64 + fr; const int col0 = u.pn * BM + wc * 32 + 8 * fq;
#pragma unroll
        for (int ai = 0; ai < 2; ++ai)
#pragma unroll
            for (int m = 0; m < 4; ++m) { const int row = row0 + ai * HALF + m * 16; bf16_t* rowp = O + (size_t)row * ldc + col0; float s = 0.f;
#pragma unroll
                for (int bj = 0; bj < 2; ++bj) { f32x4 v0 = acc[ai][bj][m][0], v1 = acc[ai][bj][m][1];
                    if (ACT == 2) {
#pragma unroll
                        for (int e = 0; e < 4; ++e) { const float a = fmaxf(v0[e], 0.f), b = fmaxf(v1[e], 0.f); v0[e] = a * a; v1[e] = b * b; } }
                    if (SS) s += (v0[0] * v0[0] + v0[1] * v0[1]) + (v0[2] * v0[2] + v0[3] * v0[3]) + (v1[0] * v1[0] + v1[1] * v1[1]) + (v1[2] * v1[2] + v1[3] * v1[3]);
                    u32x4 w; w.x = cvt_pk_bf16(v0[0], v0[1]); w.y = cvt_pk_bf16(v0[2], v0[3]); w.z = cvt_pk_bf16(v1[0], v1[1]); w.w = cvt_pk_bf16(v1[2], v1[3]);
                    *(u32x4*)(rowp + bj * HALF) = w; }
                if (SS) { s += __shfl_xor(s, 16); s += __shfl_xor(s, 32); if (fq == 0) atomicAdd(ss + row, s); } }
    }
};
struct EpiF32 {
    static constexpr bool PERM = false, AFTER_DRAIN = false;
    float* O; int ldc;
    __device__ __forceinline__ void operator()(const f32x4 (&acc)[2][2][4][2], const Unit& u, int wr, int wc, int fr, int fq) const {
        const int row0 = u.pm * BM + wr * 64 + fr; const int col0 = u.pn * BM + wc * 32 + 4 * fq;
#pragma unroll
        for (int ai = 0; ai < 2; ++ai)
#pragma unroll
            for (int m = 0; m < 4; ++m) { float* rowp = O + (size_t)(row0 + ai * HALF + m * 16) * ldc + col0;
#pragma unroll
                for (int bj = 0; bj < 2; ++bj)
#pragma unroll
                    for (int n = 0; n < 2; ++n) *(f32x4*)(rowp + bj * HALF + n * 16) = acc[ai][bj][m][n]; }
    }
};
template <class Epi, class Sched, bool ALIGN_EPI = false, bool SP2 = false, bool F16 = false>
__device__ __forceinline__ void gemm_phase(PG8_LAS unsigned char* lds, const Gemm g, const Sched& S, const Epi& E) {
    const int tid = threadIdx.x, wid = __builtin_amdgcn_readfirstlane(tid >> 6), lane = tid & 63, wr = wid >> 2, wc = wid & 3, fr = lane & 15, fq = lane >> 4;
    const int K = g.K, nt = K / BK;
    unsigned voffA[2], voffB[2];
#pragma unroll
    for (int i = 0; i < 2; ++i) { int R, C; stage_rc(tid * 16 + i * 8192, R, C); const int Rb = Epi::PERM ? ((R & ~31) + perm32(R & 31)) : R;
        voffA[i] = (unsigned)(R * g.lda + C) * 2u; voffB[i] = (unsigned)(Rb * g.ldb + C) * 2u; }
    const size_t kstep = (size_t)(BK * 2);
    const size_t hstepA = (size_t)HALF * g.lda * 2, hstepB = (size_t)HALF * g.ldb * 2;
    const size_t tstepA = 2 * hstepA, tstepB = 2 * hstepB; const int awrap = g.awrap;
    const unsigned ldsw = (unsigned)wid * 1024u;
    const int aoff = lds_byte(wr * 64 + fr, fq * 8), boff = lds_byte(wc * 32 + fr, fq * 8);
#define PG8_SA(b, h) (((b) * 2 + (h)) * HTB)
#define PG8_SB(b, h) ((4 + (b) * 2 + (h)) * HTB)
#define PG8_STAGE(bufoff, gbase, voff) do { _Pragma("unroll") for (int _i = 0; _i < 2; ++_i) \
        __builtin_amdgcn_global_load_lds((const unsigned*)((const char*)(gbase) + (voff)[_i]), (PG8_LAS unsigned*)(lds + (bufoff) + ldsw + _i * 8192), 16, 0, 0); } while (0)
#define PG8_LDA(dst, b, h) do { _Pragma("unroll") for (int m = 0; m < 4; ++m) _Pragma("unroll") for (int k = 0; k < 2; ++k) dst[m][k] = *(const PG8_LAS bf16x8*)(lds + PG8_SA(b, h) + aoff + m * 2048 + k * 1024); } while (0)
#define PG8_LDB(dst, b, h) do { _Pragma("unroll") for (int n = 0; n < 2; ++n) _Pragma("unroll") for (int k = 0; k < 2; ++k) dst[n][k] = *(const PG8_LAS bf16x8*)(lds + PG8_SB(b, h) + boff + n * 2048 + k * 1024); } while (0)
#define PG8_MMA(ai, bj, At, Bt) do { __builtin_amdgcn_s_setprio(1); _Pragma("unroll") for (int m = 0; m < 4; ++m) _Pragma("unroll") for (int n = 0; n < 2; ++n) _Pragma("unroll") for (int k = 0; k < 2; ++k) \
        acc[ai][bj][m][n] = F16 ? __builtin_amdgcn_mfma_f32_16x16x32_f16(__builtin_bit_cast(f16x8_t, Bt[n][k]), __builtin_bit_cast(f16x8_t, At[m][k]), acc[ai][bj][m][n], 0, 0, 0) \
                                : __builtin_amdgcn_mfma_f32_16x16x32_bf16(Bt[n][k], At[m][k], acc[ai][bj][m][n], 0, 0, 0); __builtin_amdgcn_s_setprio(0); } while (0)
#define PG8_WAIT_V(n) asm volatile("s_waitcnt vmcnt(" #n ")" ::: "memory")
#define PG8_WAIT_L(n) asm volatile("s_waitcnt lgkmcnt(" #n ")" ::: "memory")
#define PG8_BAR __builtin_amdgcn_s_barrier()
#define PG8_SCHED __builtin_amdgcn_sched_barrier(0)
    Unit cur, nxt; int ui = 0;
    if (!S.next(0, cur)) return;
    f32x4 acc[2][2][4][2];
#pragma unroll
    for (int a = 0; a < 2; ++a)
#pragma unroll
        for (int b = 0; b < 2; ++b)
#pragma unroll
            for (int m = 0; m < 4; ++m)
#pragma unroll
                for (int n = 0; n < 2; ++n) acc[a][b][m][n] = (f32x4){0.f, 0.f, 0.f, 0.f};
    bf16x8 At[4][2], B0[2][2], B1[2][2];
    const char* cA = (const char*)g.A + (size_t)cur.pm * tstepA; const char* cB = (const char*)g.Bt + (size_t)cur.pn * tstepB;
    S.a_ready(cur);
    if constexpr (SP2) {
        PG8_STAGE(PG8_SB(0, 0), cB, voffB); PG8_STAGE(PG8_SB(0, 1), cB + hstepB, voffB); PG8_STAGE(PG8_SA(0, 0), cA, voffA); PG8_STAGE(PG8_SA(0, 1), cA + hstepA, voffA);
        if (wr == 1) PG8_BAR;
        PG8_WAIT_V(2); PG8_BAR;
        PG8_STAGE(PG8_SB(1, 0), cB + kstep, voffB); PG8_STAGE(PG8_SA(1, 0), cA + kstep, voffA); PG8_STAGE(PG8_SB(1, 1), cB + hstepB + kstep, voffB);
        PG8_WAIT_V(6); PG8_BAR;
    } else {
        PG8_STAGE(PG8_SB(0, 0), cB, voffB); PG8_STAGE(PG8_SA(0, 0), cA, voffA); PG8_STAGE(PG8_SB(0, 1), cB + hstepB, voffB); PG8_STAGE(PG8_SA(0, 1), cA + hstepA, voffA);
        if (wr == 1) PG8_BAR;
        PG8_WAIT_V(4); PG8_BAR;
        PG8_STAGE(PG8_SB(1, 0), cB + kstep, voffB); PG8_STAGE(PG8_SA(1, 0), cA + kstep, voffA); PG8_STAGE(PG8_SB(1, 1), cB + hstepB + kstep, voffB);
        PG8_WAIT_V(6); PG8_BAR;
    }
    for (;;) {
        const bool has_next = S.next(ui + 1, nxt);
        const char* nA = has_next ? (const char*)g.A + (size_t)nxt.pm * tstepA : cA; const char* nB = has_next ? (const char*)g.Bt + (size_t)nxt.pn * tstepB : cB;
        for (int t = 0; t < nt; t += 2) {
            const bool last = (t == nt - 2);
            const int t1 = t + 1, t2 = t + 2; const char* a1 = cA + (size_t)(t1 >= awrap ? t1 - awrap : t1) * kstep;
            const char* a2 = last ? nA : cA + (size_t)(t2 >= awrap ? t2 - awrap : t2) * kstep; const char* b2 = last ? nB : cB + (size_t)(t + 2) * kstep;
            const char* a3 = a2 + kstep; const char* b3 = b2 + kstep;
            if (last && has_next) S.a_ready(nxt);
            if constexpr (SP2) {
            PG8_LDB(B0, 0, 0); PG8_LDB(B1, 0, 1); PG8_SCHED; PG8_LDA(At, 0, 0); PG8_STAGE(PG8_SA(1, 1), a1 + hstepA, voffA);
            PG8_WAIT_V(8); PG8_WAIT_L(0); PG8_BAR; PG8_MMA(0, 0, At, B0); PG8_MMA(0, 1, At, B1); PG8_BAR; PG8_SCHED;
            PG8_LDA(At, 0, 1); PG8_STAGE(PG8_SB(0, 0), b2, voffB); PG8_STAGE(PG8_SB(0, 1), b2 + hstepB, voffB); PG8_STAGE(PG8_SA(0, 0), a2, voffA);
            PG8_WAIT_V(8); PG8_WAIT_L(0); PG8_BAR; PG8_MMA(1, 0, At, B0); PG8_MMA(1, 1, At, B1); PG8_BAR; PG8_SCHED;
            PG8_LDB(B0, 1, 0); PG8_LDB(B1, 1, 1); PG8_SCHED; PG8_LDA(At, 1, 0); PG8_STAGE(PG8_SA(0, 1), a2 + hstepA, voffA);
            PG8_WAIT_V(8); PG8_WAIT_L(0); PG8_BAR; PG8_MMA(0, 0, At, B0); PG8_MMA(0, 1, At, B1); PG8_BAR; PG8_SCHED;
            PG8_LDA(At, 1, 1); PG8_STAGE(PG8_SB(1, 0), b3, voffB); PG8_STAGE(PG8_SB(1, 1), b3 + hstepB, voffB); PG8_STAGE(PG8_SA(1, 0), a3, voffA);
            PG8_WAIT_V(8); PG8_WAIT_L(0); PG8_BAR; PG8_MMA(1, 0, At, B0); PG8_MMA(1, 1, At, B1); PG8_BAR; PG8_SCHED;
            } else {
            PG8_LDB(B0, 0, 0); PG8_SCHED; PG8_LDA(At, 0, 0); PG8_STAGE(PG8_SA(1, 1), a1 + hstepA, voffA);
            PG8_WAIT_L(8); PG8_BAR; PG8_WAIT_L(0); PG8_MMA(0, 0, At, B0); PG8_BAR; PG8_SCHED;
            PG8_LDB(B1, 0, 1); PG8_STAGE(PG8_SB(0, 0), b2, voffB);
            PG8_BAR; PG8_WAIT_L(0); PG8_MMA(0, 1, At, B1); PG8_BAR;
            PG8_LDA(At, 0, 1); PG8_STAGE(PG8_SA(0, 0), a2, voffA);
            PG8_BAR; PG8_WAIT_L(0); PG8_MMA(1, 0, At, B0); PG8_BAR; PG8_SCHED;
            PG8_STAGE(PG8_SB(0, 1), b2 + hstepB, voffB);
            PG8_WAIT_V(6); PG8_BAR; PG8_MMA(1, 1, At, B1); PG8_BAR;
            PG8_LDB(B0, 1, 0); PG8_SCHED; PG8_LDA(At, 1, 0); PG8_STAGE(PG8_SA(0, 1), a2 + hstepA, voffA);
            PG8_WAIT_L(8); PG8_BAR; PG8_WAIT_L(0); PG8_MMA(0, 0, At, B0); PG8_BAR; PG8_SCHED;
            PG8_LDB(B1, 1, 1); PG8_STAGE(PG8_SB(1, 0), b3, voffB);
            PG8_BAR; PG8_WAIT_L(0); PG8_MMA(0, 1, At, B1); PG8_BAR;
            PG8_LDA(At, 1, 1); PG8_STAGE(PG8_SA(1, 0), a3, voffA);
            PG8_BAR; PG8_WAIT_L(0); PG8_MMA(1, 0, At, B0); PG8_BAR; PG8_SCHED;
            PG8_STAGE(PG8_SB(1, 1), b3 + hstepB, voffB);
            PG8_WAIT_V(6); PG8_BAR; PG8_MMA(1, 1, At, B1); PG8_BAR;
            }
        }
        if constexpr (ALIGN_EPI) { if (wr == 0) PG8_BAR; }
        if constexpr (!Epi::AFTER_DRAIN) { E(acc, cur, wr, wc, fr, fq); S.done(cur); }
        if (!has_next) break;
#pragma unroll
        for (int a = 0; a < 2; ++a)
#pragma unroll
            for (int b = 0; b < 2; ++b)
#pragma unroll
                for (int m = 0; m < 4; ++m)
#pragma unroll
                    for (int n = 0; n < 2; ++n) acc[a][b][m][n] = (f32x4){0.f, 0.f, 0.f, 0.f};
        cur = nxt; cA = nA; cB = nB; ++ui;
        if constexpr (ALIGN_EPI) { if (wr == 1) PG8_BAR; }
    }
    PG8_WAIT_V(0);
    if constexpr (!ALIGN_EPI) { if (wr == 0) PG8_BAR; }
    PG8_BAR;
    if constexpr (Epi::AFTER_DRAIN) { E.fused(acc, cur, wr, wc, fr, fq, lds, wid, lane); S.done(cur); }
#undef PG8_SA
#undef PG8_SB
#undef PG8_STAGE
#undef PG8_LDA
#undef PG8_LDB
#undef PG8_MMA
#undef PG8_WAIT_V
#undef PG8_WAIT_L
#undef PG8_BAR
#undef PG8_SCHED
}
}
constexpr int BATCH = 8, SEQ = 4096, DM = 1024, M = BATCH * SEQ;
constexpr int D_IN = 2644, NMAIN = 2304, NSPLIT = 512, KSPLIT = 1024, DFF = 4096;
constexpr int PM_GQ = 0, PM_GK = 256, PM_GV = 512, PM_GR = 1024, PM_DQ = 1536, PM_DK = 2048, PM_DV = 2176;
constexpr int PS_IQ = 0, PS_IK = 256, PS_IW = 320, PS_GLR = 324;
constexpr float EPS = 1e-6f;
constexpr int NWAVES = 8, NTHR = 512;
constexpr int NUNIT_GLA = BATCH * 4 * 64;
constexpr int TOPK = 256;

constexpr size_t MiB = 1u << 20;
constexpr size_t WS_CTL = 0, CTL_ZERO_BYTES = 1 * MiB;
constexpr int CW_BAR = 4096, CW_SS1 = 65536, CW_SS2 = 98304;
constexpr size_t WS_IW = 1 * MiB, WS_DECAY = 1 * MiB + 512 * 1024;
constexpr size_t WS_WINM = 2 * MiB, WS_WSPL = 7 * MiB, WS_WO = 10 * MiB, WS_W1 = 12 * MiB, WS_W2 = 20 * MiB;
constexpr size_t WS_TAB128 = 28 * MiB, WS_TAB64 = 30 * MiB, WS_QB = 31 * MiB;
constexpr size_t WS_HCAT = 32 * MiB;
constexpr size_t WS_QR = 32 * MiB, WS_KR = 64 * MiB, WS_IKH = 72 * MiB, WS_IKL = 76 * MiB, WS_IQH = 80 * MiB, WS_IQL = 96 * MiB, WS_MASK = 112 * MiB, WS_SIN = 128 * MiB;
constexpr size_t WS_PMAIN = 160 * MiB, WS_PSPL = 304 * MiB, WS_UT = 368 * MiB, WS_GQD = 400 * MiB, WS_GKI = 416 * MiB, WS_MIX = 432 * MiB;
constexpr size_t WS_ORAW = 160 * MiB, WS_HN = 32 * MiB, WS_HID = 256 * MiB, WS_FFRAW = 96 * MiB;
constexpr size_t WS_END = 512 * MiB;
constexpr int RING_BYTES = 131072, LDS_BYTES = 147456, MISC_OFF = LDS_BYTES - 256;

#define LAS __attribute__((address_space(3)))
typedef unsigned short bf16;
typedef unsigned v4u __attribute__((ext_vector_type(4)));
typedef unsigned v2u __attribute__((ext_vector_type(2)));
typedef float f32x4 __attribute__((ext_vector_type(4)));
typedef float f32x2 __attribute__((ext_vector_type(2)));
typedef short bf16x8 __attribute__((ext_vector_type(8)));
#define LDS_WAIT() asm volatile("s_waitcnt lgkmcnt(0)" ::: "memory")
__device__ __forceinline__ unsigned f2bf(float f) { unsigned u = __float_as_uint(f); return (u + 0x7fffu + ((u >> 16) & 1u)) >> 16; }
__device__ __forceinline__ float bf2f(unsigned h) { return __uint_as_float(h << 16); }
__device__ __forceinline__ unsigned pk2(float lo, float hi) { return f2bf(lo) | (f2bf(hi) << 16); }
__device__ __forceinline__ float wave_sum(float v) {
#pragma unroll
    for (int o = 1; o < 64; o <<= 1) v += __shfl_xor(v, o);
    return v;
}
__device__ __forceinline__ f32x4 mfma16(bf16x8 a, bf16x8 b, f32x4 c) { return __builtin_amdgcn_mfma_f32_16x16x32_bf16(a, b, c, 0, 0, 0); }
#define XB_TMO      128
#define XB_XCNT(j)  (256  + 64 * (j))
#define XB_XSUB(j)  (1280 + 64 * (j))
#define XB_XGEN(j)  (2304 + 64 * (j))
#define XB_TOP      3328
#define XB_TOPGEN   3392
#define XCD_BAR_WORDS 3456
#define XB_SPIN_CAP (1u << 18)

__device__ __forceinline__ unsigned xb_ld(unsigned* p)              { return __hip_atomic_load(p, __ATOMIC_RELAXED, __HIP_MEMORY_SCOPE_AGENT); }
__device__ __forceinline__ unsigned xb_add(unsigned* p, unsigned v) { return __hip_atomic_fetch_add(p, v, __ATOMIC_RELAXED, __HIP_MEMORY_SCOPE_AGENT); }
__device__ __forceinline__ unsigned xb_xcc_id() { return (unsigned)__builtin_amdgcn_s_getreg((3 << 11) | 20) & 0xFu; }
#define XB_SPIN(cond, bar) do { unsigned _sp = 0; while (cond) { __builtin_amdgcn_s_sleep(1); \
    if ((++_sp & 255u) == 0u) { if (xb_ld(&(bar)[XB_TMO])) break; if (_sp > XB_SPIN_CAP) { atomicAdd(&(bar)[XB_TMO], 1u); break; } } } } while (0)

struct XcdBarrier {
    unsigned* bar; unsigned x;
    volatile LAS unsigned* st;
};

__device__ __forceinline__ XcdBarrier xcd_barrier_post(unsigned* bar, volatile LAS unsigned* st) {
    XcdBarrier b; b.bar = bar; b.x = xb_xcc_id(); b.st = st;
    if (threadIdx.x == 0) (void)xb_add(&bar[XB_XCNT(b.x)], 1u);
    return b;
}
__device__ __forceinline__ void xcd_barrier_complete(unsigned* bar, unsigned x, unsigned& nloc, unsigned& nx) {
    const unsigned G = gridDim.x * gridDim.y * gridDim.z;
    unsigned sum, cnt, mine, sp = 0u;
    for (;;) {
        sum = 0u; cnt = 0u; mine = 0u;
#pragma unroll
        for (unsigned j = 0; j < 16; ++j) { const unsigned c = xb_ld(&bar[XB_XCNT(j)]); sum += c; cnt += (c > 0u) ? 1u : 0u; mine = (j == x) ? c : mine; }
        if (sum == G) break;
        __builtin_amdgcn_s_sleep(1);
        if ((++sp & 255u) == 0u) { if (xb_ld(&bar[XB_TMO])) break; if (sp > XB_SPIN_CAP) { atomicAdd(&bar[XB_TMO], 1u); break; } }
    }
    nloc = mine > 0u ? mine : 1u; nx = cnt > 0u ? cnt : 1u;
}

__device__ __forceinline__ void xcd_barrier(const XcdBarrier& b) {
    asm volatile("s_waitcnt vmcnt(0)" ::: "memory");
    __syncthreads();
    if (threadIdx.x == 0) {
        unsigned* bar = b.bar;
        __builtin_amdgcn_s_waitcnt(0);
        unsigned nloc = b.st[0], nx = b.st[1];
        if (nloc == 0u) { xcd_barrier_complete(bar, b.x, nloc, nx); b.st[0] = nloc; b.st[1] = nx; }
        const unsigned old = xb_add(&bar[XB_XSUB(b.x)], 1u);
        const unsigned gen = old / nloc;
        if (old + 1u == (gen + 1u) * nloc) {
            __builtin_amdgcn_fence(__ATOMIC_RELEASE, "agent");
            asm volatile("s_waitcnt vmcnt(0)" ::: "memory");
            const unsigned og = xb_add(&bar[XB_TOP], 1u);
            const unsigned tg = og / nx;
            if (og + 1u == (tg + 1u) * nx) xb_add(&bar[XB_TOPGEN], 1u);
            else XB_SPIN(xb_ld(&bar[XB_TOPGEN]) == tg, bar);
            __builtin_amdgcn_fence(__ATOMIC_ACQUIRE, "agent");
            xb_add(&bar[XB_XGEN(b.x)], 1u);
            asm volatile("s_waitcnt vmcnt(0)" ::: "memory");
        } else {
            XB_SPIN(xb_ld(&bar[XB_XGEN(b.x)]) == gen, bar);
            __builtin_amdgcn_fence(__ATOMIC_ACQUIRE, "agent");
            asm volatile("s_waitcnt vmcnt(0)" ::: "memory");
        }
    }
    __syncthreads();
}

__device__ __forceinline__ unsigned short f16bits(_Float16 h) { return __builtin_bit_cast(unsigned short, h); }
__device__ __forceinline__ unsigned pkh2(float lo, float hi) { return (unsigned)f16bits((_Float16)lo) | ((unsigned)f16bits((_Float16)hi) << 16); }
__device__ __forceinline__ float h2f(unsigned bits16) { return (float)__builtin_bit_cast(_Float16, (unsigned short)bits16); }
__device__ __forceinline__ int win_src_main(int j) { return j < 1024 ? j : j + 16; }
__device__ __forceinline__ int win_src_split(int j) { return j < 256 ? 2320 + j : (j < 320 ? 2576 + (j - 256) : (j < 324 ? 2640 + (j - 320) : (j < 340 ? 1024 + (j - 324) : -1))); }
template <int MODE>
__device__ __forceinline__ void p0_transpose_item(const float* W, int ldw, bf16* WT, int ldo, float* scr, int item, int nblk, int lane) {
    const int kb = item / nblk, nb = item % nblk, k0 = 64 * kb, n0 = 32 * nb;
    const int n = n0 + (lane & 31);
    const int sc = MODE == 0 ? n : (MODE == 1 ? win_src_main(n) : win_src_split(n));
    float wv[32];
#pragma unroll
    for (int i = 0; i < 32; ++i) { const int kk = 2 * i + (lane >> 5); wv[i] = sc >= 0 ? W[(size_t)(k0 + kk) * ldw + sc] : 0.f; }
#pragma unroll
    for (int i = 0; i < 32; ++i) { const int kk = 2 * i + (lane >> 5); scr[kk * 33 + (lane & 31)] = wv[i]; }
    LDS_WAIT();
    const int c = lane & 7;
#pragma unroll
    for (int j = 0; j < 4; ++j) { const int nn = (lane >> 3) + 8 * j; const float* s = scr + (8 * c) * 33 + nn;
        const float v0 = s[0 * 33], v1 = s[1 * 33], v2 = s[2 * 33], v3 = s[3 * 33], v4 = s[4 * 33], v5 = s[5 * 33], v6 = s[6 * 33], v7 = s[7 * 33];
        v4u o; if (MODE == 0) { o.x = pk2(v0, v1); o.y = pk2(v2, v3); o.z = pk2(v4, v5); o.w = pk2(v6, v7); } else { o.x = pkh2(v0, v1); o.y = pkh2(v2, v3); o.z = pkh2(v4, v5); o.w = pkh2(v6, v7); }
        bf16* dst = WT + (size_t)(n0 + nn) * ldo + k0 + 8 * c;
        *(v4u*)dst = o;
        }
    LDS_WAIT();
}
__device__ __forceinline__ void p0_rms_finish(const f32x4 (&v)[4], const float* w, bf16* orow, int lane) {
    const f32x4* wr = (const f32x4*)w + lane; float s = 0.f;
#pragma unroll
    for (int j = 0; j < 4; ++j) s += (v[j].x * v[j].x + v[j].y * v[j].y) + (v[j].z * v[j].z + v[j].w * v[j].w);
    const float r = 1.0f / sqrtf(wave_sum(s) * (1.f / DM) + EPS);
    unsigned long long* oh = (unsigned long long*)orow + lane;
#pragma unroll
    for (int j = 0; j < 4; ++j) { const f32x4 y = (v[j] * r) * wr[64 * j];
        const unsigned h0 = pkh2(y.x, y.y), h1 = pkh2(y.z, y.w);
        oh[64 * j] = (unsigned long long)h0 | ((unsigned long long)h1 << 32); }
}
__device__ __forceinline__ void p0_rms_rows(const float* x, const float* w, bf16* hcat, int gw, int NGW, int lane) {
    if (gw >= M) return;
    f32x4 cur[4], nxt[4];
#pragma unroll
    for (int j = 0; j < 4; ++j) cur[j] = __builtin_nontemporal_load((const f32x4*)(x + (size_t)gw * DM) + lane + 64 * j);
    for (int m = gw; m < M; m += NGW) { const int mn = (m + NGW < M) ? m + NGW : m;
#pragma unroll
        for (int j = 0; j < 4; ++j) nxt[j] = __builtin_nontemporal_load((const f32x4*)(x + (size_t)mn * DM) + lane + 64 * j);
        p0_rms_finish(cur, w, hcat + (size_t)m * 1024, lane);
#pragma unroll
        for (int j = 0; j < 4; ++j) cur[j] = nxt[j]; }
}
__device__ __forceinline__ void sincos_f64(double a, double& sn, double& cs) {
    const double kd = rint(a * 0.63661977236758134308);
    const double r = (a - kd * 1.57079632673412561417e+00) - kd * 6.07710050650619224932e-11;
    const double z = r * r;
    const double ps = 8.33333333332248946124e-03 + z * (-1.98412698298579493134e-04 + z * (2.75573137070700676789e-06 + z * (-2.50507602534068634195e-08 + z * 1.58969099521155010221e-10)));
    const double s = r + (z * r) * (-1.66666666666666324348e-01 + z * ps);
    const double pc = z * (4.16666666666666019037e-02 + z * (-1.38888888888741095749e-03 + z * (2.48015872894767294178e-05 + z * (-2.75573143513906633035e-07 + z * (2.08757232129817482790e-09 + z * -1.13596475577881948265e-11)))));
    const double c = 1.0 - (0.5 * z - z * pc);
    const int q = ((int)kd) & 3;
    sn = (q == 0) ? s : (q == 1) ? c : (q == 2) ? -s : -c;
    cs = (q == 0) ? c : (q == 1) ? -s : (q == 2) ? -c : s;
}
struct P0Args { const float *x, *nw, *w_in, *w_out, *w1, *w2; bf16 *hcat, *winm, *wspl, *wo, *w1t, *w2t; f32x2 *tab128, *tab64; };
__device__ __forceinline__ void p0_prologue(const P0Args& a, char* ldsg, int bid, int G, int tid) {
    const int lane = tid & 63, wave = tid >> 6;
    float* scr = (float*)(ldsg + wave * 16384);
    const int gw = bid * NWAVES + wave, NGW = G * NWAVES;
    constexpr int I_M = 16 * (NMAIN / 32), I_S = 16 * (NSPLIT / 32), I_O = 16 * (DM / 32), I_1 = 16 * (DFF / 32), I_2 = 64 * (DM / 32);
    for (int it = gw; it < I_M + I_S + I_O + I_1 + I_2; it += NGW) {
        int r = it;
        if (r < I_M) { p0_transpose_item<1>(a.w_in, D_IN, a.winm, 1024, scr, r, NMAIN / 32, lane); continue; } r -= I_M;
        if (r < I_S) { p0_transpose_item<2>(a.w_in, D_IN, a.wspl, KSPLIT, scr, r, NSPLIT / 32, lane); continue; } r -= I_S;
        if (r < I_O) { p0_transpose_item<0>(a.w_out, DM, a.wo, 1024, scr, r, DM / 32, lane); continue; } r -= I_O;
        if (r < I_1) { p0_transpose_item<0>(a.w1, DFF, a.w1t, 1024, scr, r, DFF / 32, lane); continue; } r -= I_1;
        p0_transpose_item<0>(a.w2, DM, a.w2t, DFF, scr, r, DM / 32, lane);
    }
    p0_rms_rows(a.x, a.nw, a.hcat, gw, NGW, lane);
    for (int e = bid * NTHR + tid; e < SEQ * 96; e += G * NTHR) {
        const int s = e / 96, j = e % 96; const bool big = j < 64; const int i = big ? j : j - 64;
        const double base = big ? 0.8659643233600653 : 0.7498942093324558;
        double p = 1.0; for (int k = 0; k < i; ++k) p *= base;
        const double ang = (double)s * (double)(float)p; double sn, cs; sincos_f64(ang, sn, cs);
        const f32x2 o = {(float)cs, (float)sn};
        if (big) a.tab128[s * 64 + i] = o; else a.tab64[s * 32 + i] = o;
    }
}

struct P2Args { const bf16* pmain; const float* pspl; const f32x2 *tab128, *tab64; const float *lnw, *lnb; bf16 *qr, *kr, *ikh, *ikl, *iqh, *iql; float* iw; float* qb; };
struct P2In { unsigned short k1, k2, q1[4], q2[4]; float iq1[2], iq2[2], iwr[2], ik, iw4; f32x2 cs, c2; };
__device__ __forceinline__ void p2_load(P2In& r, const P2Args& a, int m, int lane) {
    const int s = m & (SEQ - 1);
    const bf16* pm = a.pmain + (size_t)m * NMAIN; const float* ps = a.pspl + (size_t)m * NSPLIT;
    r.cs = a.tab128[s * 64 + lane]; r.c2 = a.tab64[s * 32 + (lane & 31)];
    r.k1 = pm[PM_DK + lane]; r.k2 = pm[PM_DK + 64 + lane];
#pragma unroll
    for (int h = 0; h < 4; ++h) { r.q1[h] = pm[PM_DQ + h * 128 + lane]; r.q2[h] = pm[PM_DQ + h * 128 + 64 + lane]; }
#pragma unroll
    for (int e = 0; e < 2; ++e) { const int h = 2 * e + (lane >> 5), i = lane & 31; r.iq1[e] = ps[PS_IQ + h * 64 + i]; r.iq2[e] = ps[PS_IQ + h * 64 + 32 + i]; r.iwr[e] = ps[PS_IW + h]; }
    r.ik = ps[PS_IK + lane]; r.iw4 = ps[PS_IW + (lane & 3)];
}
__device__ __forceinline__ void p2_post_row(const P2In& r, const P2Args& a, int m, int lane) {
    const int s = m & (SEQ - 1);
    const f32x2 cs = r.cs;
    { const float x1 = bf2f(r.k1), x2 = bf2f(r.k2);
      a.kr[(size_t)m * 128 + lane] = (bf16)f2bf(x1 * cs.x - x2 * cs.y); a.kr[(size_t)m * 128 + 64 + lane] = (bf16)f2bf(x2 * cs.x + x1 * cs.y); }
#pragma unroll
    for (int h = 0; h < 4; ++h) { const float x1 = bf2f(r.q1[h]), x2 = bf2f(r.q2[h]);
      a.qr[(size_t)m * 512 + h * 128 + lane] = (bf16)f2bf(x1 * cs.x - x2 * cs.y); a.qr[(size_t)m * 512 + h * 128 + 64 + lane] = (bf16)f2bf(x2 * cs.x + x1 * cs.y); }
    const f32x2 c2 = r.c2;
    float qn = 0.f;
#pragma unroll
    for (int e = 0; e < 2; ++e) { const int h = 2 * e + (lane >> 5), i = lane & 31;
      const float x1 = r.iq1[e], x2 = r.iq2[e];
      const float wr = r.iwr[e];
      const float o1 = (x1 * c2.x - x2 * c2.y) * wr, o2 = (x2 * c2.x + x1 * c2.y) * wr;
      float sq = o1 * o1 + o2 * o2;
#pragma unroll
      for (int o = 1; o < 32; o <<= 1) sq += __shfl_xor(sq, o);
      qn += sqrtf(sq);
      const _Float16 h1 = (_Float16)o1, h2 = (_Float16)o2; const size_t p = ((size_t)m * 4 + h) * 64 + i;
      a.iqh[p] = f16bits(h1); a.iqh[p + 32] = f16bits(h2); a.iql[p] = f16bits((_Float16)(o1 - (float)h1)); a.iql[p + 32] = f16bits((_Float16)(o2 - (float)h2)); }
    qn += __shfl_xor(qn, 32);
    if (lane == 0) a.qb[m] = qn;
    { const float v = r.ik; const float mu = wave_sum(v) * (1.f / 64.f); const float d = v - mu; const float var = wave_sum(d * d) * (1.f / 64.f);
      const float y = d * (1.0f / sqrtf(var + EPS)) * a.lnw[lane] + a.lnb[lane];
      const float other = __shfl_xor(y, 32);
      const float o = lane < 32 ? (y * c2.x - other * c2.y) : (y * c2.x + other * c2.y);
      const size_t p = (size_t)(m >> 12) * (SEQ * 64) + (size_t)(s >> 4) * 1024 + (lane >> 5) * 512 + ((((lane & 31) >> 3) * 16 + (s & 15)) * 8) + (lane & 7);
      a.ikh[p] = f16bits((_Float16)o); }
    if (lane < 4) a.iw[(size_t)m * 4 + lane] = (r.iw4 < 0.f) ? -__builtin_inff() : __builtin_inff();
}
__device__ __forceinline__ void p2_post_rows(const P2Args& a, int gw, int NGW, int lane) {
    if (gw >= M) return;
    P2In cur, nxt; p2_load(cur, a, gw, lane);
    for (int m = gw; m < M; m += NGW) { const int mn = (m + NGW < M) ? m + NGW : m;
        p2_load(nxt, a, mn, lane); p2_post_row(cur, a, m, lane); cur = nxt; }
}

constexpr int GLA_LD = 72;
struct GlaArgs { const bf16* pmain; const float* pspl; const float *gw2, *gb, *gnw; bf16* ut; float* decay; bf16* sin_; bf16* mix; bf16* gqd; bf16* gki; };
struct GlaPre { f32x2 glr, w2; float gbv; v4u k, q, v0, v1; };
template <bool WITH_Q>
__device__ __forceinline__ void gla_prefetch(GlaPre& p, const GlaArgs& a, int u, int tid) {
    const int b = u >> 8, h = (u >> 6) & 3, n = u & 63, m0 = b * SEQ + n * 64;
    { const int i = 2 * tid, t = i >> 4, j = i & 15; p.glr = *(const f32x2*)(a.pspl + (size_t)(m0 + t) * NSPLIT + PS_GLR + j); }
    { const int i = 2 * tid, j = i >> 6, d = i & 63; p.w2 = *(const f32x2*)(a.gw2 + j * 256 + h * 64 + d); }
    p.gbv = a.gb[h * 64 + (tid & 63)];
    const bf16* row = a.pmain + (size_t)(m0 + (tid & 63)) * NMAIN;
    p.k = *(const v4u*)(row + PM_GK + h * 64 + 8 * (tid >> 6));
    if (WITH_Q) p.q = *(const v4u*)(row + PM_GQ + h * 64 + 8 * (tid >> 6));
    p.v0 = *(const v4u*)(row + PM_GV + h * 128 + 8 * (tid >> 6)); p.v1 = *(const v4u*)(row + PM_GV + h * 128 + 64 + 8 * (tid >> 6));
}
constexpr int GS_LD = 65;
__device__ __forceinline__ void gla_bcum(const GlaPre& p, float* Gs, float* glr, float* w2s, float* gbs, int tid) {
    *(f32x2*)(glr + 2 * tid) = p.glr; *(f32x2*)(w2s + 2 * tid) = p.w2; if (tid < 64) gbs[tid] = p.gbv;
    __syncthreads();
    { const int d = tid & 63; float wc[16];
#pragma unroll
      for (int j = 0; j < 16; ++j) wc[j] = w2s[j * 64 + d];
      const float bias = gbs[d];
#pragma unroll
      for (int e = 0; e < 8; ++e) { const int t = (tid >> 6) + 8 * e; const f32x4* g4 = (const f32x4*)(glr + t * 16); float z = 0.f;
#pragma unroll
          for (int j4 = 0; j4 < 4; ++j4) { const f32x4 gv = g4[j4]; z += gv.x * wc[4 * j4]; z += gv.y * wc[4 * j4 + 1]; z += gv.z * wc[4 * j4 + 2]; z += gv.w * wc[4 * j4 + 3]; }
          z += bias;
          Gs[t * GS_LD + d] = (fminf(z, 0.f) - __logf(1.f + __expf(-fabsf(z)))) * (1.f / 16.f); } }
    __syncthreads();
    if (tid < 64) { float c[64];
#pragma unroll
        for (int t = 0; t < 64; ++t) c[t] = Gs[t * GS_LD + tid];
#pragma unroll
        for (int t = 1; t < 64; ++t) c[t] += c[t - 1];
#pragma unroll
        for (int t = 0; t < 64; ++t) Gs[t * GS_LD + tid] = c[t]; }
    __syncthreads();
}
__device__ __forceinline__ float bfl(unsigned w) { return __uint_as_float(w << 16); }
__device__ __forceinline__ float bfh(unsigned w) { return __uint_as_float(w & 0xffff0000u); }
__device__ __forceinline__ void gla_local_phase(const GlaArgs& a, char* ldsg, int bid, int G, int tid) {
    const int lane = tid & 63, w = tid >> 6, quad = lane >> 4, l15 = lane & 15;
    float* Gs = (float*)ldsg; float* glr = Gs + 64 * GS_LD + 32; float* w2s = glr + 1024; float* gbs = w2s + 1024; bf16* kT = (bf16*)(gbs + 64); bf16* vT = kT + 64 * GLA_LD;
    if (bid >= NUNIT_GLA) return;
    GlaPre cur, nxt; gla_prefetch<true>(cur, a, bid, tid);
    for (int u = bid; u < NUNIT_GLA; u += G) {
        const int un = (u + G < NUNIT_GLA) ? u + G : u; gla_prefetch<true>(nxt, a, un, tid);
        __syncthreads();
        gla_bcum(cur, Gs, glr, w2s, gbs, tid);
        { const int t = tid & 63, d0 = 8 * (tid >> 6); const unsigned kw[4] = {cur.k.x, cur.k.y, cur.k.z, cur.k.w}, qw[4] = {cur.q.x, cur.q.y, cur.q.z, cur.q.w}; unsigned qo[4], ko[4]; const unsigned v0w[4] = {cur.v0.x, cur.v0.y, cur.v0.z, cur.v0.w}, v1w[4] = {cur.v1.x, cur.v1.y, cur.v1.z, cur.v1.w};
#pragma unroll
          for (int e = 0; e < 4; ++e) { const int d = d0 + 2 * e; const float g0 = Gs[t * GS_LD + d], g1 = Gs[t * GS_LD + d + 1];
              qo[e] = pk2(bfl(qw[e]) * 0.125f * __expf(g0), bfh(qw[e]) * 0.125f * __expf(g1)); ko[e] = pk2(bfl(kw[e]) * __expf(-g0), bfh(kw[e]) * __expf(-g1));
              kT[d * GLA_LD + t] = (bf16)f2bf(bfl(kw[e]) * __expf(Gs[63 * GS_LD + d] - Gs[t * GS_LD + d])); kT[(d + 1) * GLA_LD + t] = (bf16)f2bf(bfh(kw[e]) * __expf(Gs[63 * GS_LD + d + 1] - Gs[t * GS_LD + d + 1]));
              vT[d * GLA_LD + t] = (bf16)(v0w[e] & 0xffffu); vT[(d + 1) * GLA_LD + t] = (bf16)(v0w[e] >> 16);
              vT[(64 + d) * GLA_LD + t] = (bf16)(v1w[e] & 0xffffu); vT[(64 + d + 1) * GLA_LD + t] = (bf16)(v1w[e] >> 16); }
          *(v4u*)(a.gqd + (size_t)u * 4096 + t * 64 + d0) = (v4u){qo[0], qo[1], qo[2], qo[3]}; *(v4u*)(a.gki + (size_t)u * 4096 + t * 64 + d0) = (v4u){ko[0], ko[1], ko[2], ko[3]}; }
        if (tid < 64) a.decay[(size_t)u * 64 + tid] = __expf(Gs[63 * GS_LD + tid]);
        __syncthreads();
        f32x4 acc[4];
#pragma unroll
        for (int dt = 0; dt < 4; ++dt) acc[dt] = (f32x4){0.f, 0.f, 0.f, 0.f};
#pragma unroll
        for (int ks = 0; ks < 2; ++ks) { const bf16x8 af = *(const bf16x8*)(vT + (16 * w + l15) * GLA_LD + ks * 32 + 8 * quad);
#pragma unroll
            for (int dt = 0; dt < 4; ++dt) { const bf16x8 bfr = *(const bf16x8*)(kT + (16 * dt + l15) * GLA_LD + ks * 32 + 8 * quad); acc[dt] = mfma16(af, bfr, acc[dt]); } }
        bf16* uo = a.ut + (size_t)u * 8192;
#pragma unroll
        for (int dt = 0; dt < 4; ++dt)
#pragma unroll
            for (int r = 0; r < 4; ++r) uo[(16 * w + 4 * quad + r) * 64 + 16 * dt + l15] = (bf16)f2bf(acc[dt][r]);
        cur = nxt;
    }
}
__device__ __forceinline__ void gla_scan(const GlaArgs& a, int bid, int G, int tid) {
    for (int idx = bid * NTHR + tid; idx < 32 * 4096; idx += G * NTHR) {
        const int bh = idx >> 12, e = idx & 4095, d = e & 63; float s0 = 0.f, s1 = 0.f;
        const bf16* up = a.ut + (size_t)bh * 64 * 8192 + e; const float* dp = a.decay + (size_t)bh * 64 * 64 + d; bf16* sp = a.sin_ + (size_t)bh * 64 * 8192 + e;
#pragma nounroll
        for (int n0 = 0; n0 < 64; n0 += 8) {
            float u0[8], u1[8], dc[8];
#pragma unroll
            for (int k = 0; k < 8; ++k) { u0[k] = bf2f(up[(size_t)(n0 + k) * 8192]); u1[k] = bf2f(up[(size_t)(n0 + k) * 8192 + 4096]); dc[k] = dp[(n0 + k) * 64]; }
#pragma unroll
            for (int k = 0; k < 8; ++k) { sp[(size_t)(n0 + k) * 8192] = (bf16)f2bf(s0); sp[(size_t)(n0 + k) * 8192 + 4096] = (bf16)f2bf(s1); s0 = dc[k] * s0 + u0[k]; s1 = dc[k] * s1 + u1[k]; }
        }
    }
}
struct GlaPreO { v4u qd, ki, v0, v1; };
__device__ __forceinline__ void gla_prefetch_o(GlaPreO& p, const GlaArgs& a, int u, int tid) {
    const int b = u >> 8, h = (u >> 6) & 3, n = u & 63, m0 = b * SEQ + n * 64, t = tid & 63, d0 = 8 * (tid >> 6);
    p.qd = *(const v4u*)(a.gqd + (size_t)u * 4096 + t * 64 + d0); p.ki = *(const v4u*)(a.gki + (size_t)u * 4096 + t * 64 + d0);
    const bf16* row = a.pmain + (size_t)(m0 + t) * NMAIN + PM_GV + h * 128;
    p.v0 = *(const v4u*)(row + d0); p.v1 = *(const v4u*)(row + 64 + d0);
}
__device__ __forceinline__ void gla_out_phase(const GlaArgs& a, char* ldsg, int bid, int G, int tid) {
    const int lane = tid & 63, w = tid >> 6, quad = lane >> 4, l15 = lane & 15;
    bf16* Qd = (bf16*)ldsg; bf16* Ki = Qd + 64 * GLA_LD; bf16* vT = Ki + 64 * GLA_LD; bf16* At = vT + 128 * GLA_LD;
    float* part = (float*)(At + 64 * GLA_LD);
    if (bid >= NUNIT_GLA) return;
    const int rt = w & 3, ch = w >> 2;
    GlaPreO cur, nxt; gla_prefetch_o(cur, a, bid, tid);
    for (int u = bid; u < NUNIT_GLA; u += G) {
        const int b = u >> 8, h = (u >> 6) & 3, n = u & 63, m0 = b * SEQ + n * 64;
        const int un = (u + G < NUNIT_GLA) ? u + G : u; gla_prefetch_o(nxt, a, un, tid);
        bf16x8 sfr[2][4]; unsigned short rg[4][4];
        { const bf16* Sg = a.sin_ + (size_t)u * 8192;
#pragma unroll
          for (int ks = 0; ks < 2; ++ks)
#pragma unroll
            for (int vt = 0; vt < 4; ++vt) sfr[ks][vt] = *(const bf16x8*)(Sg + (16 * (4 * ch + vt) + l15) * 64 + ks * 32 + 8 * quad);
#pragma unroll
          for (int r = 0; r < 4; ++r)
#pragma unroll
            for (int vt = 0; vt < 4; ++vt) rg[r][vt] = a.pmain[(size_t)(m0 + 16 * rt + 4 * quad + r) * NMAIN + PM_GR + h * 128 + 16 * (4 * ch + vt) + l15]; }
        __syncthreads();
        { const int t = tid & 63, d0 = 8 * (tid >> 6);
          const unsigned v0w[4] = {cur.v0.x, cur.v0.y, cur.v0.z, cur.v0.w}, v1w[4] = {cur.v1.x, cur.v1.y, cur.v1.z, cur.v1.w};
#pragma unroll
          for (int e = 0; e < 4; ++e) { const int d = d0 + 2 * e;
              vT[d * GLA_LD + t] = (bf16)(v0w[e] & 0xffffu); vT[(d + 1) * GLA_LD + t] = (bf16)(v0w[e] >> 16);
              vT[(64 + d) * GLA_LD + t] = (bf16)(v1w[e] & 0xffffu); vT[(64 + d + 1) * GLA_LD + t] = (bf16)(v1w[e] >> 16); }
          *(v4u*)(Qd + t * GLA_LD + d0) = cur.qd; *(v4u*)(Ki + t * GLA_LD + d0) = cur.ki; }
        __syncthreads();
        {
            f32x4 s2[2] = {(f32x4){0.f, 0.f, 0.f, 0.f}, (f32x4){0.f, 0.f, 0.f, 0.f}};
#pragma unroll
            for (int ks = 0; ks < 2; ++ks) { const bf16x8 af = *(const bf16x8*)(Qd + (16 * rt + l15) * GLA_LD + ks * 32 + 8 * quad);
#pragma unroll
                for (int j2 = 0; j2 < 2; ++j2) { const bf16x8 bfr = *(const bf16x8*)(Ki + (16 * (2 * ch + j2) + l15) * GLA_LD + ks * 32 + 8 * quad); s2[j2] = mfma16(af, bfr, s2[j2]); } }
#pragma unroll
            for (int j2 = 0; j2 < 2; ++j2)
#pragma unroll
                for (int r = 0; r < 4; ++r) { const int i = 16 * rt + 4 * quad + r, j = 16 * (2 * ch + j2) + l15; At[i * GLA_LD + j] = (bf16)f2bf(j <= i ? s2[j2][r] : 0.f); }
        }
        __syncthreads();
        f32x4 o[4];
#pragma unroll
        for (int vt = 0; vt < 4; ++vt) o[vt] = (f32x4){0.f, 0.f, 0.f, 0.f};
#pragma unroll
        for (int ks = 0; ks < 2; ++ks) {
            const bf16x8 a1 = *(const bf16x8*)(At + (16 * rt + l15) * GLA_LD + ks * 32 + 8 * quad);
            const bf16x8 a2 = *(const bf16x8*)(Qd + (16 * rt + l15) * GLA_LD + ks * 32 + 8 * quad);
#pragma unroll
            for (int vt = 0; vt < 4; ++vt) { const bf16x8 b1 = *(const bf16x8*)(vT + (16 * (4 * ch + vt) + l15) * GLA_LD + ks * 32 + 8 * quad);
                o[vt] = mfma16(a1, b1, o[vt]); o[vt] = mfma16(a2, sfr[ks][vt], o[vt]); } }
#pragma unroll
        for (int r = 0; r < 4; ++r) { float sq = 0.f;
#pragma unroll
            for (int vt = 0; vt < 4; ++vt) sq += o[vt][r] * o[vt][r];
            sq += __shfl_xor(sq, 1); sq += __shfl_xor(sq, 2); sq += __shfl_xor(sq, 4); sq += __shfl_xor(sq, 8);
            if (l15 == 0) part[ch * 64 + 16 * rt + 4 * quad + r] = sq; }
        __syncthreads();
#pragma unroll
        for (int r = 0; r < 4; ++r) { const int i = 16 * rt + 4 * quad + r; const float rstd = 1.0f / sqrtf((part[i] + part[64 + i]) * (1.f / 128.f) + EPS);
#pragma unroll
            for (int vt = 0; vt < 4; ++vt) { const int v = 16 * (4 * ch + vt) + l15; const float rgf = bf2f(rg[r][vt]);
                a.mix[(size_t)(m0 + i) * 1024 + h * 128 + v] = (bf16)f2bf(o[vt][r] * rstd * a.gnw[v] * (rgf / (1.f + __expf(-rgf)))); } }
        cur = nxt;
    }
}

template <class T> __device__ __forceinline__ T ntl(const T* p) { return __builtin_nontemporal_load(p); }
template <class T> __device__ __forceinline__ void nts(T* p, T v) { __builtin_nontemporal_store(v, p); }
struct RowBuf { f32x4 x[4]; v2u r[4]; };
__device__ __forceinline__ void row_load(RowBuf& b, const float* xrow, const bf16* raw, int lane) {
#pragma unroll
    for (int j = 0; j < 4; ++j) { b.x[j] = ntl((const f32x4*)xrow + lane + 64 * j); b.r[j] = ntl((const v2u*)raw + lane + 64 * j); }
}
__device__ __forceinline__ f32x4 bf4(v2u rw);
__device__ __forceinline__ float row_ss(const v2u (&r)[4]);
__device__ __forceinline__ f32x4 bf4(v2u rw) { return (f32x4){bf2f(rw.x & 0xffffu), bf2f(rw.x >> 16), bf2f(rw.y & 0xffffu), bf2f(rw.y >> 16)}; }
__device__ __forceinline__ void p6_finish(const RowBuf& b, const float* wpost, const float* wpre, bf16* x1b, bf16* hn, int lane) {
    const float r1 = 1.0f / sqrtf(row_ss(b.r) * (1.f / DM) + EPS);
    f32x4 v[4]; float s = 0.f;
#pragma unroll
    for (int j = 0; j < 4; ++j) { v[j] = b.x[j] + (bf4(b.r[j]) * r1) * ((const f32x4*)wpost)[lane + 64 * j];
        s += (v[j].x * v[j].x + v[j].y * v[j].y) + (v[j].z * v[j].z + v[j].w * v[j].w);
        v2u o; o.x = pk2(v[j].x, v[j].y); o.y = pk2(v[j].z, v[j].w); ((v2u*)x1b)[lane + 64 * j] = o; }
    const float r2 = 1.0f / sqrtf(wave_sum(s) * (1.f / DM) + EPS);
#pragma unroll
    for (int j = 0; j < 4; ++j) { const f32x4 wv = ((const f32x4*)wpre)[lane + 64 * j]; const f32x4 y = (v[j] * r2) * wv;
        v2u o; o.x = pk2(y.x, y.y); o.y = pk2(y.z, y.w); ((v2u*)hn)[lane + 64 * j] = o; }
}
__device__ __forceinline__ float row_ss(const v2u (&r)[4]) { float s = 0.f;
#pragma unroll
    for (int j = 0; j < 4; ++j) { const f32x4 o = bf4(r[j]); s += (o.x * o.x + o.y * o.y) + (o.z * o.z + o.w * o.w); }
    return wave_sum(s); }
__device__ __forceinline__ void p6_rows(const float* x, bf16* raw, const float* wpost, const float* wpre, bf16* hn, int gw, int NGW, int lane) {
    if (gw >= M) return;
    RowBuf cur, nxt; row_load(cur, x + (size_t)gw * DM, raw + (size_t)gw * DM, lane);
    for (int m = gw; m < M; m += NGW) { const int mn = (m + NGW < M) ? m + NGW : m;
        if (mn != m) row_load(nxt, x + (size_t)mn * DM, raw + (size_t)mn * DM, lane);
        p6_finish(cur, wpost, wpre, raw + (size_t)m * DM, hn + (size_t)m * DM, lane); cur = nxt; }
}
__device__ __forceinline__ void p9_rows(const bf16* x1b, const bf16* raw2, const float* wpost2, float* out, int gw, int NGW, int lane) {
    if (gw >= M) return;
    v2u cx[4], c2[4], nx[4], n2[4];
#pragma unroll
    for (int j = 0; j < 4; ++j) { cx[j] = ntl((const v2u*)(x1b + (size_t)gw * DM) + lane + 64 * j); c2[j] = ntl((const v2u*)(raw2 + (size_t)gw * DM) + lane + 64 * j); }
    for (int m = gw; m < M; m += NGW) { const int mn = (m + NGW < M) ? m + NGW : m;
#pragma unroll
        for (int j = 0; j < 4; ++j) { nx[j] = ntl((const v2u*)(x1b + (size_t)mn * DM) + lane + 64 * j); n2[j] = ntl((const v2u*)(raw2 + (size_t)mn * DM) + lane + 64 * j); }
        const float r2 = 1.0f / sqrtf(row_ss(c2) * (1.f / DM) + EPS);
#pragma unroll
        for (int j = 0; j < 4; ++j) nts((f32x4*)(out + (size_t)m * DM) + lane + 64 * j, bf4(cx[j]) + (bf4(c2[j]) * r2) * ((const f32x4*)wpost2)[lane + 64 * j]);
#pragma unroll
        for (int j = 0; j < 4; ++j) { cx[j] = nx[j]; c2[j] = n2[j]; } }
}
__device__ __forceinline__ unsigned okey_of(float s) { const unsigned u = __float_as_uint(s); return (u & 0x80000000u) ? ~u : (u | 0x80000000u); }
__device__ __forceinline__ void cnt_ge(unsigned& n, unsigned k, unsigned c) { asm volatile("v_cmp_ge_u32 vcc, %1, %2\n\tv_addc_co_u32 %0, vcc, 0, %0, vcc" : "+v"(n) : "v"(k), "v"(c) : "vcc"); }
__device__ __forceinline__ void cnt_gt(unsigned& n, unsigned k, unsigned c) { asm volatile("v_cmp_gt_u32 vcc, %1, %2\n\tv_addc_co_u32 %0, vcc, 0, %0, vcc" : "+v"(n) : "v"(k), "v"(c) : "vcc"); }
__device__ __forceinline__ void cnt_tie(unsigned& n, unsigned k, unsigned T, unsigned lo, unsigned c) { unsigned tmp;
    asm volatile("v_cmp_eq_u32 vcc, %2, %3\n\tv_cndmask_b32 %1, 0, %4, vcc\n\tv_cmp_ge_u32 vcc, %1, %5\n\tv_addc_co_u32 %0, vcc, 0, %0, vcc" : "+v"(n), "=&v"(tmp) : "v"(k), "v"(T), "v"(lo), "v"(c) : "vcc"); }
#ifndef PROBE_IDX
#define PROBE_IDX 0
#endif
typedef _Float16 f16x8 __attribute__((ext_vector_type(8)));
__device__ __forceinline__ f32x4 mfma16h(f16x8 a, f16x8 b, f32x4 c) { return __builtin_amdgcn_mfma_f32_16x16x32_f16(a, b, c, 0, 0, 0); }
struct IdxArgs { const bf16 *iqh, *iql, *ikh, *ikl; const float* iw; unsigned short* mask16; const float* qb; float kbound; };
constexpr int IDX_ROUNDS = 45;
constexpr int IDX_NB = 2048, IDX_CAP = 512;
constexpr int IDX_HIST = 0, IDX_CAND = 8 * IDX_NB * 4, IDX_SMALL = IDX_CAND + 8 * IDX_CAP * 8;
__device__ __forceinline__ float okey_to_f(unsigned k) { return __uint_as_float((k & 0x80000000u) ? (k & 0x7fffffffu) : ~k); }
__device__ __forceinline__ unsigned idx_bin(float s, float inv) { return min((unsigned)__builtin_fmaf(s, inv, 0.5f * IDX_NB), (unsigned)(IDX_NB - 1)); }
template <int NI, int PV>
__device__ __forceinline__ void indexer_unit_t(const IdxArgs& a, int b, int c, int g, char* ldsg, int tid, int probe) {
    int lane_ = tid & 63; asm volatile("" : "+v"(lane_));
    const int lane = lane_, w = __builtin_amdgcn_readfirstlane(tid >> 6), quad = lane >> 4, l15 = lane & 15;
    const int q0 = b * SEQ + c * 64 + g * 8, ntile = 4 * (c + 1), nloc = (ntile - w + 7) >> 3;
    unsigned* hist = (unsigned*)(ldsg + IDX_HIST); unsigned long long* cand = (unsigned long long*)(ldsg + IDX_CAND); unsigned* sm = (unsigned*)(ldsg + IDX_SMALL);
    unsigned* qmin = sm; unsigned* qmax = sm + 8; unsigned* bstar = sm + 16; unsigned* above = sm + 24; unsigned* candn = sm + 32; unsigned* Tq = sm + 40; unsigned* Lq = sm + 48; unsigned* ovf = sm + 56; unsigned* dump = sm + 60; unsigned* cnt = sm + 64;
    __syncthreads();
    { v4u z = {0u, 0u, 0u, 0u}; v4u* h4 = (v4u*)hist;
#pragma unroll
      for (int k = 0; k < 8; ++k) h4[tid + k * NTHR] = z;
      if (tid < 8) candn[tid] = 0u;
      if (tid == 8) ovf[0] = 0u; }
    f16x8 aqh[2][2], aql[2][2]; f32x4 wq[2];
#pragma unroll
    for (int rt = 0; rt < 2; ++rt) {
#pragma unroll
        for (int ks = 0; ks < 2; ++ks) { const size_t p = ((size_t)(q0 + rt * 4 + (l15 >> 2)) * 4 + (l15 & 3)) * 64 + ks * 32 + 8 * quad;
            aqh[rt][ks] = *(const f16x8*)(a.iqh + p); aql[rt][ks] = *(const f16x8*)(a.iql + p); }
        wq[rt] = *(const f32x4*)(a.iw + (size_t)(q0 + rt * 4 + quad) * 4); }
    float sc[NI][2];
    const float kmx = a.kbound * 0.1666667f; const float inv0 = (0.5f * IDX_NB) / (a.qb[q0 + quad] * kmx), inv1 = (0.5f * IDX_NB) / (a.qb[q0 + 4 + quad] * kmx);
    __syncthreads();
    const char* khb = (const char*)a.ikh + (size_t)b * SEQ * 128;
    const unsigned koff = (unsigned)lane * 16u;
    constexpr int RING = 8;
    f16x8 kb[RING][2];
#define IDX_LOAD(i) do { const int tc_ = (probe >= 4) ? 0 : min(w + 8 * (i), ntile - 1); const unsigned o_ = koff + (unsigned)tc_ * 2048u; kb[(i) % RING][0] = *(const f16x8*)(khb + o_); kb[(i) % RING][1] = *(const f16x8*)(khb + (o_ + 1024u)); } while (0)
#pragma unroll
    for (int i = 0; i < RING - 1; ++i) IDX_LOAD(i);
#pragma unroll
    for (int i = 0; i < NI; ++i) {
        if (i + RING - 1 < NI) IDX_LOAD(i + RING - 1);
        const f16x8 bh0 = kb[i % RING][0], bh1 = kb[i % RING][1];
#pragma unroll
        for (int rt = 0; rt < 2; ++rt) { f32x4 acc = {0.f, 0.f, 0.f, 0.f};
            acc = mfma16h(aqh[rt][0], bh0, acc); acc = mfma16h(aqh[rt][1], bh1, acc); acc = mfma16h(aql[rt][0], bh0, acc); acc = mfma16h(aql[rt][1], bh1, acc);
            if constexpr (PV == 5) sc[i][rt] = acc[0] + acc[1] + acc[2] + acc[3]; else
            sc[i][rt] = ((__builtin_amdgcn_fmed3f(acc[0], 0.f, wq[rt][0]) + __builtin_amdgcn_fmed3f(acc[1], 0.f, wq[rt][1])) + __builtin_amdgcn_fmed3f(acc[2], 0.f, wq[rt][2])) + __builtin_amdgcn_fmed3f(acc[3], 0.f, wq[rt][3]); }
        { const unsigned one = (i < nloc) ? 1u : 0u;
          atomicAdd(&hist[quad * IDX_NB + idx_bin(sc[i][0], inv0)], one); atomicAdd(&hist[(4 + quad) * IDX_NB + idx_bin(sc[i][1], inv1)], one); }
        __builtin_amdgcn_sched_barrier(0);
    }
#undef IDX_LOAD
    if (probe == 1 || probe >= 4) return;
    __syncthreads();
    { const v4u* hq = (const v4u*)(hist + w * IDX_NB) + lane * 8; unsigned cntv[32]; unsigned tot = 0u;
#pragma unroll
      for (int k = 0; k < 8; ++k) { const v4u v = hq[k]; cntv[4 * k] = v.x; cntv[4 * k + 1] = v.y; cntv[4 * k + 2] = v.z; cntv[4 * k + 3] = v.w; tot += (v.x + v.y) + (v.z + v.w); }
      unsigned suf = tot;
#pragma unroll
      for (int o = 1; o < 64; o <<= 1) { const unsigned t = __shfl_down(suf, o); if (lane + o < 64) suf += t; }
      unsigned run = suf - tot;
      int bj = -1; unsigned ab = 0u;
#pragma unroll
      for (int j = 31; j >= 0; --j) { const unsigned cj = cntv[j]; const bool hit = (run < (unsigned)TOPK) && (run + cj >= (unsigned)TOPK); bj = hit ? j : bj; ab = hit ? run : ab; run += cj; }
      if (bj >= 0) { bstar[w] = (unsigned)(lane * 32 + bj); above[w] = ab; } }
    __syncthreads();
    if (probe == 2) return;
    const unsigned lo_base = 4095u - (unsigned)(16 * w + l15);
    { const unsigned bs0 = bstar[quad], bs1 = bstar[4 + quad];
#pragma unroll
      for (int i = 0; i < NI; ++i) { const unsigned lo = lo_base - 128u * (unsigned)i; const bool act = (i < nloc);
          if (act && idx_bin(sc[i][0], inv0) == bs0) { const unsigned slot = atomicAdd(&candn[quad], 1u); if (slot < (unsigned)IDX_CAP) cand[quad * IDX_CAP + slot] = ((unsigned long long)okey_of(sc[i][0]) << 12) | lo; }
          if (act && idx_bin(sc[i][1], inv1) == bs1) { const unsigned slot = atomicAdd(&candn[4 + quad], 1u); if (slot < (unsigned)IDX_CAP) cand[(4 + quad) * IDX_CAP + slot] = ((unsigned long long)okey_of(sc[i][1]) << 12) | lo; } } }
    __syncthreads();
    if (probe == 7) return;
    { const unsigned L = candn[w], need = (unsigned)TOPK - above[w];
      if (L > (unsigned)IDX_CAP) { if (lane == 0) ovf[0] = 1u; }
      else if (L <= 64u) {
        const unsigned long long mine = ((unsigned)lane < L) ? cand[w * IDX_CAP + lane] : 0ull; const unsigned mlo = (unsigned)mine, mhi = (unsigned)(mine >> 32); unsigned rank = 0u;
        for (unsigned i = 0; i < L; ++i) { const unsigned long long o = ((unsigned long long)(unsigned)__builtin_amdgcn_readlane((int)mhi, (int)i) << 32) | (unsigned)__builtin_amdgcn_readlane((int)mlo, (int)i); rank += (o > mine) ? 1u : 0u; }
        const unsigned long long bal = __ballot((unsigned)lane < L && rank + 1u == need); const int src = (int)__ffsll((long long)bal) - 1;
        const unsigned klo = (unsigned)__builtin_amdgcn_readlane((int)mlo, src), khi = (unsigned)__builtin_amdgcn_readlane((int)mhi, src);
        if (lane == 0) { Tq[w] = (khi << 20) | (klo >> 12); Lq[w] = klo & 0xfffu; } }
      else { unsigned long long ck[8];
#pragma unroll
        for (int j = 0; j < 8; ++j) ck[j] = ((unsigned)(j * 64 + lane) < L) ? cand[w * IDX_CAP + j * 64 + lane] : 0ull;
        unsigned long long Kth = 0ull;
#pragma nounroll
        for (int bit = 43; bit >= 0; --bit) { const unsigned long long cv = Kth | (1ull << bit); unsigned n = 0u;
#pragma unroll
            for (int j = 0; j < 8; ++j) if ((unsigned)(j * 64) < L) n += (unsigned)__popcll(__ballot(ck[j] >= cv));
            if (n >= need) Kth = cv; }
        if (lane == 0) { Tq[w] = (unsigned)(Kth >> 12); Lq[w] = (unsigned)Kth & 0xfffu; } } }
    __syncthreads();
    if (probe == 3) return;
    unsigned T0, T1, L0, L1; float Tf0, Tf1;
    if (ovf[0] == 0u) { Tf0 = okey_to_f(Tq[quad]); Tf1 = okey_to_f(Tq[4 + quad]); L0 = Lq[quad]; L1 = Lq[4 + quad];
    } else {
#pragma unroll
        for (int i = 0; i < NI; ++i) { sc[i][0] = (i < nloc) ? __uint_as_float(okey_of(sc[i][0])) : 0.f; sc[i][1] = (i < nloc) ? __uint_as_float(okey_of(sc[i][1])) : 0.f; }
        for (int i = tid; i < IDX_ROUNDS * 8; i += NTHR) cnt[i] = 0u;
        __syncthreads();
        T0 = 0u; T1 = 0u;
#pragma nounroll
        for (int rd = 0; rd < 32; ++rd) {
            const unsigned c0v = T0 | (0x80000000u >> rd), c1v = T1 | (0x80000000u >> rd); unsigned n0 = 0u, n1 = 0u;
#pragma unroll
            for (int i = 0; i < NI; ++i) { cnt_ge(n0, __float_as_uint(sc[i][0]), c0v); cnt_ge(n1, __float_as_uint(sc[i][1]), c1v); }
#pragma unroll
            for (int o = 1; o < 16; o <<= 1) { n0 += __shfl_xor(n0, o); n1 += __shfl_xor(n1, o); }
            if (l15 == 0) { atomicAdd(&cnt[rd * 8 + quad], n0); atomicAdd(&cnt[rd * 8 + 4 + quad], n1); }
            __syncthreads();
            if (cnt[rd * 8 + quad] >= (unsigned)TOPK) T0 = c0v;
            if (cnt[rd * 8 + 4 + quad] >= (unsigned)TOPK) T1 = c1v;
        }
        { unsigned n0 = 0u, n1 = 0u;
#pragma unroll
          for (int i = 0; i < NI; ++i) { cnt_gt(n0, __float_as_uint(sc[i][0]), T0); cnt_gt(n1, __float_as_uint(sc[i][1]), T1); }
#pragma unroll
          for (int o = 1; o < 16; o <<= 1) { n0 += __shfl_xor(n0, o); n1 += __shfl_xor(n1, o); }
          if (l15 == 0) { atomicAdd(&cnt[32 * 8 + quad], n0); atomicAdd(&cnt[32 * 8 + 4 + quad], n1); }
          __syncthreads(); }
        const unsigned need0 = (unsigned)TOPK - cnt[32 * 8 + quad], need1 = (unsigned)TOPK - cnt[32 * 8 + 4 + quad];
        L0 = 0u; L1 = 0u;
#pragma nounroll
        for (int rd = 0; rd < 12; ++rd) {
            const unsigned c0v = L0 | (0x800u >> rd), c1v = L1 | (0x800u >> rd); unsigned n0 = 0u, n1 = 0u;
#pragma unroll
            for (int i = 0; i < NI; ++i) { const unsigned lo = lo_base - 128u * (unsigned)i; cnt_tie(n0, __float_as_uint(sc[i][0]), T0, lo, c0v); cnt_tie(n1, __float_as_uint(sc[i][1]), T1, lo, c1v); }
#pragma unroll
            for (int o = 1; o < 16; o <<= 1) { n0 += __shfl_xor(n0, o); n1 += __shfl_xor(n1, o); }
            if (l15 == 0) { atomicAdd(&cnt[(33 + rd) * 8 + quad], n0); atomicAdd(&cnt[(33 + rd) * 8 + 4 + quad], n1); }
            __syncthreads();
            if (cnt[(33 + rd) * 8 + quad] >= need0) L0 = c0v;
            if (cnt[(33 + rd) * 8 + 4 + quad] >= need1) L1 = c1v;
        }
        Tf0 = okey_to_f(T0); Tf1 = okey_to_f(T1);
#pragma unroll
        for (int i = 0; i < NI; ++i) { sc[i][0] = okey_to_f(__float_as_uint(sc[i][0])); sc[i][1] = okey_to_f(__float_as_uint(sc[i][1])); }
    }
#pragma unroll
    for (int i = 0; i < NI; ++i) {
        const int t = w + 8 * i; const unsigned lo = lo_base - 128u * (unsigned)i; const bool act = (i < nloc);
#pragma unroll
        for (int rt = 0; rt < 2; ++rt) { const float k = sc[i][rt], T = rt ? Tf1 : Tf0; const unsigned L = rt ? L1 : L0;
            const bool sel = (k > T) || (k == T && lo >= L);
            const unsigned long long bal = __ballot(sel);
            if (lane < 4 && act) a.mask16[(size_t)(q0 + rt * 4 + lane) * 256 + t] = (unsigned short)((bal >> (16 * lane)) & 0xffffull); }
        __builtin_amdgcn_sched_barrier(0);
    }
}
template <int PV>
__device__ __forceinline__ void indexer_unit(const IdxArgs& a, int b, int c, int g, char* ldsg, int tid, int probe) {
    if (c < 8) indexer_unit_t<4, PV>(a, b, c, g, ldsg, tid, probe); else if (c < 16) indexer_unit_t<8, PV>(a, b, c, g, ldsg, tid, probe); else if (c < 24) indexer_unit_t<12, PV>(a, b, c, g, ldsg, tid, probe); else if (c < 32) indexer_unit_t<16, PV>(a, b, c, g, ldsg, tid, probe);
    else if (c < 40) indexer_unit_t<20, PV>(a, b, c, g, ldsg, tid, probe); else if (c < 48) indexer_unit_t<24, PV>(a, b, c, g, ldsg, tid, probe); else if (c < 56) indexer_unit_t<28, PV>(a, b, c, g, ldsg, tid, probe); else indexer_unit_t<32, PV>(a, b, c, g, ldsg, tid, probe);
}

namespace att {
using s16x4  = __attribute__((ext_vector_type(4))) short;
using f32x16 = __attribute__((ext_vector_type(16))) float;
using u32x4  = __attribute__((ext_vector_type(4))) unsigned;
constexpr int D = 128, NW = 8, QBLK = 32, KVBLK = 64;
constexpr float SCALE = 0.088388347648318440f, THR = 8.f;
constexpr int SHM_V = KVBLK * D * 2, SHM_K = KVBLK * D * 2, SHM_Q0 = 2 * SHM_V + 2 * SHM_K + NW * 64 * 4, SHM_ATTN = SHM_Q0 + 256 * D * 2;
constexpr int LDK = 128, LDV = NMAIN;
#define KSWZ(row, colB) ((row) * 256 + ((colB) ^ (((row) & 7) << 4)))
#define SBAR() __builtin_amdgcn_sched_barrier(0)
__device__ __forceinline__ int crow(int r, int hi) { return (r & 3) + 8 * (r >> 2) + 4 * hi; }
__device__ __forceinline__ unsigned cvtpk(float lo, float hi) { unsigned r; asm volatile("v_cvt_pk_bf16_f32 %0, %1, %2" : "=v"(r) : "v"(lo), "v"(hi)); return r; }
__device__ __forceinline__ float mask_and(float e, unsigned m, int pos) { float r; asm("v_bfe_i32 %0, %1, %2, 1\n\tv_and_b32 %0, %0, %3" : "=&v"(r) : "v"(m), "n"(pos), "v"(e)); return r; }
__device__ __forceinline__ void partialSM(f32x16& p0, f32x16& p1, float& m_reg, float& mn, float& alpha, unsigned ml) {
  constexpr float C = SCALE * 1.4426950408889634f;
  float pmax = p0[0];
#pragma unroll
  for (int r = 1; r < 16; ++r) pmax = fmaxf(pmax, p0[r]);
#pragma unroll
  for (int r = 0; r < 16; ++r) pmax = fmaxf(pmax, p1[r]);
  { auto rr = __builtin_amdgcn_permlane32_swap(__float_as_uint(pmax), __float_as_uint(pmax), false, false);
    pmax = fmaxf(__uint_as_float(rr[0]), __uint_as_float(rr[1])); }
  if (__builtin_expect(__all(pmax - m_reg <= THR / SCALE), 1)) { mn = m_reg; alpha = 1.f; }
  else { mn = fmaxf(m_reg, pmax); alpha = __builtin_amdgcn_exp2f((m_reg - mn) * C); m_reg = mn; }
  const float mnC = -mn * C;
#pragma unroll
  for (int r = 0; r < 16; ++r) p0[r] = fmaf(p0[r], C, mnC);
#pragma unroll
  for (int r = 0; r < 16; ++r) p1[r] = fmaf(p1[r], C, mnC);
#pragma unroll
  for (int r = 0; r < 16; ++r) p0[r] = mask_and(__builtin_amdgcn_exp2f(p0[r]), ml, (r & 3) + 8 * (r >> 2));
}
__device__ __forceinline__ void finishSM(f32x16& p0, f32x16& p1, float alpha, float& l_reg, bf16x8& pa0, bf16x8& pa1, bf16x8& pa2, bf16x8& pa3, unsigned mh) {
#pragma unroll
  for (int r = 0; r < 16; ++r) p1[r] = mask_and(__builtin_amdgcn_exp2f(p1[r]), mh, (r & 3) + 8 * (r >> 2));
  float ps = 0;
#pragma unroll
  for (int r = 0; r < 16; ++r) ps += p0[r];
#pragma unroll
  for (int r = 0; r < 16; ++r) ps += p1[r];
  { auto rr = __builtin_amdgcn_permlane32_swap(__float_as_uint(ps), __float_as_uint(ps), false, false);
    ps = __uint_as_float(rr[0]) + __uint_as_float(rr[1]); }
  l_reg = l_reg * alpha + ps;
#define PK4(P, BASE, OUT) do { unsigned a0 = cvtpk(P[BASE + 0], P[BASE + 1]), a1 = cvtpk(P[BASE + 2], P[BASE + 3]);   \
    unsigned b0 = cvtpk(P[BASE + 4], P[BASE + 5]), b1 = cvtpk(P[BASE + 6], P[BASE + 7]);                              \
    auto r0 = __builtin_amdgcn_permlane32_swap(a0, b0, false, false); auto r1 = __builtin_amdgcn_permlane32_swap(a1, b1, false, false); \
    u32x4 w = {r0[0], r1[0], r0[1], r1[1]}; OUT = *reinterpret_cast<bf16x8*>(&w); } while (0)
  PK4(p0, 0, pa0); PK4(p0, 8, pa1); PK4(p1, 0, pa2); PK4(p1, 8, pa3);
#undef PK4
}
__device__ __forceinline__ void qkt(f32x16& p0, f32x16& p1, const bf16* Ks, const char* Qs, int r32, int hi) {
  p0 = f32x16{}; p1 = f32x16{};
#pragma unroll
  for (int d0 = 0; d0 < 8; ++d0) { int cb = (d0 * 16 + hi * 8) * 2;
    bf16x8 b0 = *reinterpret_cast<const bf16x8*>((const char*)Ks + KSWZ(r32, cb));
    bf16x8 b1 = *reinterpret_cast<const bf16x8*>((const char*)Ks + KSWZ(32 + r32, cb));
    bf16x8 q = *reinterpret_cast<const bf16x8*>(Qs + KSWZ(r32, cb));
    p0 = __builtin_amdgcn_mfma_f32_32x32x16_bf16(b0, q, p0, 0, 0, 0);
    p1 = __builtin_amdgcn_mfma_f32_32x32x16_bf16(b1, q, p1, 0, 0, 0); }
}
__device__ __forceinline__ int v_st(int k, int c) { const int kk = (k & ~0xC) | ((k & 4) << 1) | ((k & 8) >> 1); return ((kk >> 3) * 4 + (c >> 5)) * 512 + ((kk & 7) * 32 + (c & 31)) * 2; }
__device__ __forceinline__ int v_rd_base(int lane) { return ((lane & 3) << 3) | (((lane >> 2) & 3) << 6) | (((lane >> 4) & 1) << 5) | (((lane >> 5) & 1) << 8); }
constexpr int v_rd_off(int d0, int ks, int half) { return d0 * 512 + ks * 4096 + half * 2048; }
template <int OFF> __device__ __forceinline__ s16x4 tr_read(int vb) {
  s16x4 r; asm volatile("ds_read_b64_tr_b16 %0, %1 offset:%2" : "=&v"(r) : "v"(vb), "i"(OFF) : "memory"); return r;
}
template <int D0> __device__ __forceinline__ void pv_one(f32x16& od, int vb, bf16x8 pa0, bf16x8 pa1, bf16x8 pa2, bf16x8 pa3) {
  const s16x4 l0 = tr_read<v_rd_off(D0, 0, 0)>(vb), h0 = tr_read<v_rd_off(D0, 0, 1)>(vb), l1 = tr_read<v_rd_off(D0, 1, 0)>(vb), h1 = tr_read<v_rd_off(D0, 1, 1)>(vb);
  const s16x4 l2 = tr_read<v_rd_off(D0, 2, 0)>(vb), h2 = tr_read<v_rd_off(D0, 2, 1)>(vb), l3 = tr_read<v_rd_off(D0, 3, 0)>(vb), h3 = tr_read<v_rd_off(D0, 3, 1)>(vb);
  asm volatile("s_waitcnt lgkmcnt(0)" ::: "memory"); SBAR();
#define PK(L, H) (bf16x8){L[0], L[1], L[2], L[3], H[0], H[1], H[2], H[3]}
  od = __builtin_amdgcn_mfma_f32_32x32x16_bf16(pa0, PK(l0, h0), od, 0, 0, 0);
  od = __builtin_amdgcn_mfma_f32_32x32x16_bf16(pa1, PK(l1, h1), od, 0, 0, 0);
  od = __builtin_amdgcn_mfma_f32_32x32x16_bf16(pa2, PK(l2, h2), od, 0, 0, 0);
  od = __builtin_amdgcn_mfma_f32_32x32x16_bf16(pa3, PK(l3, h3), od, 0, 0, 0);
#undef PK
}
__device__ __forceinline__ void pv_d0(f32x16* o, int vb, bf16x8 pa0, bf16x8 pa1, bf16x8 pa2, bf16x8 pa3) {
  pv_one<0>(o[0], vb, pa0, pa1, pa2, pa3); pv_one<1>(o[1], vb, pa0, pa1, pa2, pa3); pv_one<2>(o[2], vb, pa0, pa1, pa2, pa3); pv_one<3>(o[3], vb, pa0, pa1, pa2, pa3);
}
__device__ __forceinline__ void attn_unit(const bf16* __restrict__ QR, const bf16* __restrict__ KR, const bf16* __restrict__ PMAIN, const unsigned long long* __restrict__ MASK,
                                          bf16* __restrict__ MIX, int b, int c, char* lds) {
  const int tid = threadIdx.x, wid = tid >> 6, lane = tid & 63, r32 = lane & 31, hi = lane >> 5;
  bf16* V_lds = (bf16*)lds; bf16* K_lds = (bf16*)(lds + 2 * SHM_V);
  float* ws = (float*)(lds + 2 * SHM_V + 2 * SHM_K) + wid * 64; float* li_l = ws; float* al_l = ws + 32;
  float m_reg = -1e30f, l_reg = 0; f32x16 o[4] = {};
  const char* qr = lds + SHM_Q0 + wid * (QBLK * 256);
  const int tok0 = b * SEQ + c * 64, qloc = 8 * wid + (r32 >> 2);
  const bf16* Kh = KR + (size_t)b * SEQ * LDK; const bf16* Vh = PMAIN + (size_t)b * SEQ * LDV + PM_DV;
  const char* mb = (const char*)MASK + (size_t)tok0 * 512; const unsigned moff = (unsigned)qloc * 512u; const bool allsel = (c <= 3);
  const int NTR = c + 1, NT = (NTR + 1) & ~1;
#define GETMASK(kt, ML, MH) do { unsigned long long mm_ = allsel ? ~0ull : *(const unsigned long long*)(mb + (moff + 8u * (unsigned)(kt))); if ((kt) >= NTR) mm_ = 0ull; ML = (unsigned)mm_ >> (4 * hi); MH = (unsigned)(mm_ >> 32) >> (4 * hi); } while (0)
  const int sr = tid >> 4, sc = (tid & 15) * 8, vst0 = v_st(sr, sc), vst1 = v_st(32 + sr, sc);
  const int vb0 = (int)(uintptr_t)V_lds + v_rd_base(lane);
  struct { bf16x8 vs0, vs1, ks0, ks1; } sr_[1];
const unsigned offV0 = (unsigned)(sr * LDV + sc) * 2u, offV1 = offV0 + 32u * LDV * 2u, offK0 = (unsigned)(sr * LDK + sc) * 2u, offK1 = offK0 + 32u * LDK * 2u;
#define SLOAD(i, k0) do { const char* vb_ = (const char*)Vh + (size_t)(k0) * (LDV * 2); const char* kb_ = (const char*)Kh + (size_t)(k0) * (LDK * 2); \
    sr_[i].vs0 = *(const bf16x8*)(vb_ + offV0); sr_[i].vs1 = *(const bf16x8*)(vb_ + offV1); sr_[i].ks0 = *(const bf16x8*)(kb_ + offK0); sr_[i].ks1 = *(const bf16x8*)(kb_ + offK1); } while (0)
#define SWRITE(bb, i) do { *(bf16x8*)((char*)V_lds + (bb) * SHM_V + vst0) = sr_[i].vs0;          \
    *(bf16x8*)((char*)V_lds + (bb) * SHM_V + vst1) = sr_[i].vs1; int kc = sc * 2;               \
    *(bf16x8*)((char*)K_lds + (bb) * SHM_K + KSWZ(sr, kc)) = sr_[i].ks0;                       \
    *(bf16x8*)((char*)K_lds + (bb) * SHM_K + KSWZ(32 + sr, kc)) = sr_[i].ks1; } while (0)
#define SWAIT() asm volatile("s_waitcnt vmcnt(0)" ::: "memory")
#define RESC(a) do { if (__any((a) < 1.f)) { if (hi == 0) al_l[r32] = (a); asm volatile("s_waitcnt lgkmcnt(0)" ::: "memory"); \
    _Pragma("unroll") for (int d = 0; d < 4; ++d) _Pragma("unroll") for (int r = 0; r < 16; ++r) o[d][r] *= al_l[crow(r, hi)]; } } while (0)
  f32x16 pA0, pA1, pB0, pB1; float mnA, mnB, alA, alB; bf16x8 pa0, pa1, pa2, pa3; unsigned mlA, mhA, mlB, mhB;
  constexpr int SE = 0, SO = 0;
  __syncthreads();
  { const char* qb = (const char*)QR + (size_t)tok0 * 1024; const unsigned qoff = (unsigned)(qloc * 512 + (r32 & 3) * 128 + hi * 8) * 2u;
#pragma unroll
    for (int d0 = 0; d0 < 8; ++d0) { const bf16x8 t = *reinterpret_cast<const bf16x8*>(qb + (qoff + 32u * d0)); *(bf16x8*)(const_cast<char*>(qr) + KSWZ(r32, (d0 * 16 + hi * 8) * 2)) = t; }
    asm volatile("s_waitcnt lgkmcnt(0)" ::: "memory"); }
  SLOAD(SE, 0); asm volatile("s_waitcnt vmcnt(0)" ::: "memory"); SWRITE(0, SE); __syncthreads();
  GETMASK(0, mlA, mhA);
  qkt(pA0, pA1, K_lds, qr, r32, hi); partialSM(pA0, pA1, m_reg, mnA, alA, mlA);
  SLOAD(SO, KVBLK);
  SWAIT(); SWRITE(1, SO); __syncthreads();
  for (int j = 1; j + 1 < NT; j += 2) {
    GETMASK(j, mlB, mhB);
    SBAR(); qkt(pB0, pB1, (bf16*)((char*)K_lds + SHM_K), qr, r32, hi);
    finishSM(pA0, pA1, alA, l_reg, pa0, pa1, pa2, pa3, mhA); SBAR();
    SLOAD(SO, (j + 1) * KVBLK); SBAR();
    pv_d0(o, vb0, pa0, pa1, pa2, pa3); partialSM(pB0, pB1, m_reg, mnB, alB, mlB);
    __syncthreads(); SWAIT(); SWRITE(0, SE);
    RESC(alB); __syncthreads();
    GETMASK(j + 1, mlA, mhA);
    SBAR(); qkt(pA0, pA1, K_lds, qr, r32, hi);
    finishSM(pB0, pB1, alB, l_reg, pa0, pa1, pa2, pa3, mhB); SBAR();
    SLOAD(SE, (j + 2) * KVBLK); SBAR();
    pv_d0(o, vb0 + (int)SHM_V, pa0, pa1, pa2, pa3); partialSM(pA0, pA1, m_reg, mnA, alA, mlA);
    __syncthreads(); SWAIT(); SWRITE(1, SO);
    RESC(alA); __syncthreads();
  }
  GETMASK(NT - 1, mlB, mhB);
  SBAR(); qkt(pB0, pB1, (bf16*)((char*)K_lds + SHM_K), qr, r32, hi);
  finishSM(pA0, pA1, alA, l_reg, pa0, pa1, pa2, pa3, mhA); SBAR();
  pv_d0(o, vb0, pa0, pa1, pa2, pa3); partialSM(pB0, pB1, m_reg, mnB, alB, mlB);
  __syncthreads(); RESC(alB);
  finishSM(pB0, pB1, alB, l_reg, pa0, pa1, pa2, pa3, mhB); SBAR();
  pv_d0(o, vb0 + (int)SHM_V, pa0, pa1, pa2, pa3);
  if (hi == 0) li_l[r32] = l_reg; asm volatile("s_waitcnt lgkmcnt(0)" ::: "memory");
  float rli[16];
#pragma unroll
  for (int r = 0; r < 16; ++r) rli[r] = __builtin_amdgcn_rcpf(li_l[crow(r, hi)]);
  { char* ob = (char*)MIX + (size_t)tok0 * 2048; const unsigned ooff = (unsigned)((8 * wid + hi) * 1024 + 512 + r32) * 2u;
#pragma unroll
    for (int r = 0; r < 16; ++r)
#pragma unroll
      for (int d0 = 0; d0 < 4; ++d0) *(bf16*)(ob + (size_t)((2 * (r >> 2) * 1024 + (r & 3) * 128 + d0 * 32) * 2) + ooff) = (bf16)f2bf(o[d0][r] * rli[r]); }
#undef GETMASK
#undef SLOAD
#undef SWRITE
#undef SWAIT
#undef RESC
}
}
#ifndef MK_ONE_LAUNCH
#define MK_ONE_LAUNCH 1
#endif
constexpr int NPHASE = 10;
static_assert(att::SHM_ATTN <= MISC_OFF && pg8::STAGE_BYTES <= MISC_OFF, "LDS map");
struct Args { const float* in[14]; float* out; unsigned char* ws; int ph_lo, ph_hi, li, pad; };
__global__ void __launch_bounds__(NTHR, 2) fwd_kernel(Args args) {
    extern __shared__ __attribute__((aligned(16))) unsigned char lds[];
    const int tid = threadIdx.x, lane = tid & 63, wave = __builtin_amdgcn_readfirstlane(tid >> 6), bid = blockIdx.x, G = gridDim.x;
    typedef const __attribute__((address_space(4))) Args* KArgs;
    const KArgs ka = (KArgs)__builtin_amdgcn_kernarg_segment_ptr(); (void)args;
    unsigned char* ws = ka->ws; char* ldsg = (char*)lds; LAS unsigned char* ldsl = (LAS unsigned char*)lds;
    if (tid < 64) ((LAS unsigned*)(ldsl + MISC_OFF))[tid] = 0u;
    __syncthreads();
    volatile LAS unsigned* MISC = (volatile LAS unsigned*)(ldsl + MISC_OFF);
    unsigned* ctl = (unsigned*)(ws + WS_CTL);
    const int lo = ka->ph_lo, hi = ka->ph_hi;
    XcdBarrier bar; bar.bar = ctl + CW_BAR + ka->li * XCD_BAR_WORDS; bar.x = 0; bar.st = nullptr;
    if (hi - lo > 1) bar = xcd_barrier_post(ctl + CW_BAR + ka->li * XCD_BAR_WORDS, MISC + 8);
#ifndef PROBE_REPEAT
#define PROBE_REPEAT (-1)
#endif
#ifndef PROBE_SUB
#define PROBE_SUB 0
#endif
#ifndef PH_ENABLE
#define PH_ENABLE 0x3ff
#endif
#define IN(k) (((PH_ENABLE >> (k)) & 1) && lo <= (k) && (k) < hi)
#define SEAM(k) do { if (IN(k) && IN((k) + 1)) xcd_barrier(bar); } while (0)
#define hcat ((bf16*)(ws + WS_HCAT))
#define winm ((bf16*)(ws + WS_WINM))
#define wspl ((bf16*)(ws + WS_WSPL))
#define wo ((bf16*)(ws + WS_WO))
#define w1t ((bf16*)(ws + WS_W1))
#define w2t ((bf16*)(ws + WS_W2))
#define tab128 ((f32x2*)(ws + WS_TAB128))
#define tab64 ((f32x2*)(ws + WS_TAB64))
#define pmain ((bf16*)(ws + WS_PMAIN))
#define pspl ((float*)(ws + WS_PSPL))
#define mix ((bf16*)(ws + WS_MIX))
#define oraw ((bf16*)(ws + WS_ORAW))
#define hn ((bf16*)(ws + WS_HN))
#define hid ((bf16*)(ws + WS_HID))
#define ffraw ((bf16*)(ws + WS_FFRAW))
#define ss1 ((float*)(ctl + CW_SS1))
#define ss2 ((float*)(ctl + CW_SS2))
#define GLA_ARGS GlaArgs ga{pmain, pspl, ka->in[3], ka->in[4], ka->in[5], (bf16*)(ws + WS_UT), (float*)(ws + WS_DECAY), (bf16*)(ws + WS_SIN), mix, (bf16*)(ws + WS_GQD), (bf16*)(ws + WS_GKI)}
    const int gw = bid * NWAVES + wave, NGW = G * NWAVES;
    const int sub = (PROBE_SUB != 0 && ka->li == 1) ? PROBE_SUB : 0;

    if (IN(0)) {
        P0Args a{ka->in[0], ka->in[1], ka->in[2], ka->in[8], ka->in[11], ka->in[12], hcat, winm, wspl, wo, w1t, w2t, tab128, tab64};
        p0_prologue(a, ldsg, bid, G, tid);
        SEAM(0);
    }
    if (IN(1)) {
        { pg8::Gemm g{hcat, winm, M, NMAIN, 1024, 1024, 1024, 1 << 30}; pg8::StaticOrder S; S.init(M, NMAIN, G, bid);
          pg8::EpiBf16X<0, false> E{pmain, NMAIN, nullptr};
          pg8::gemm_phase<pg8::EpiBf16X<0, false>, pg8::StaticOrder, true, true, true>(ldsl, g, S, E); }
        __syncthreads();
        { pg8::Gemm g{hcat, wspl, M, NSPLIT, KSPLIT, 1024, KSPLIT, 1 << 30}; pg8::StaticOrder S; S.init(M, NSPLIT, G, bid);
          pg8::EpiF32 E{pspl, NSPLIT};
          pg8::gemm_phase<pg8::EpiF32, pg8::StaticOrder, true, true, true>(ldsl, g, S, E); }
        SEAM(1);
    }
    if (IN(2)) {
        GLA_ARGS;
        P2Args a{pmain, pspl, tab128, tab64, ka->in[6], ka->in[7], (bf16*)(ws + WS_QR), (bf16*)(ws + WS_KR), (bf16*)(ws + WS_IKH), (bf16*)(ws + WS_IKL), (bf16*)(ws + WS_IQH), (bf16*)(ws + WS_IQL), (float*)(ws + WS_IW), (float*)(ws + WS_QB)};
        if (sub != 2) p2_post_rows(a, gw, NGW, lane);
        if (sub != 1) gla_local_phase(ga, ldsg, bid, G, tid);
        SEAM(2);
    }
    if (IN(3)) {
        GLA_ARGS;
#ifndef PROBE_IDX
#define PROBE_IDX 0
#endif
        const int probe = (PROBE_IDX != 0 && ka->li == 1) ? PROBE_IDX : 0;
        if (probe == 0) gla_scan(ga, bid, G, tid);
        float kbound; { const float lw = fabsf(ka->in[6][lane]), lb = ka->in[7][lane]; float mw = lw;
#pragma unroll
          for (int o = 1; o < 64; o <<= 1) mw = fmaxf(mw, __shfl_xor(mw, o));
          kbound = 8.0f * mw + sqrtf(wave_sum(lb * lb)); }
        IdxArgs a{(const bf16*)(ws + WS_IQH), (const bf16*)(ws + WS_IQL), (const bf16*)(ws + WS_IKH), (const bf16*)(ws + WS_IKL), (const float*)(ws + WS_IW), (unsigned short*)(ws + WS_MASK), (const float*)(ws + WS_QB), kbound};
        if (G == 256) {
            const int b = bid >> 5, g = (bid & 31) >> 2, j = bid & 3;
            for (int k = 14; k >= 0; --k) { const int r = (k < 14) ? ((k >> 1) * 8 + ((k & 1) ? 7 - j : j)) : 56 + j;
                indexer_unit<0>(a, b, 4 + r, g, ldsg, tid, probe); }
        } else {
            for (int it = bid; it < BATCH * 30 * 8; it += G) {
                const int b = it / 240, rem = it % 240, p = rem >> 3, g = rem & 7;
                indexer_unit<0>(a, b, 4 + p, g, ldsg, tid, probe); indexer_unit<0>(a, b, 63 - p, g, ldsg, tid, probe); }
        }
        SEAM(3);
    }
    if (IN(4)) {
        GLA_ARGS;
        if (sub != 2) gla_out_phase(ga, ldsg, bid, G, tid);
        if (sub != 1) for (int it = bid; it < BATCH * 32; it += G) {
            const int b = it & 7, p = it >> 3;
            for (int half = 0; half < 2; ++half)
                att::attn_unit((const bf16*)(ws + WS_QR), (const bf16*)(ws + WS_KR), pmain, (const unsigned long long*)(ws + WS_MASK), mix, b, half ? p : 63 - p, ldsg);
        }
        SEAM(4);
    }
    if (IN(5)) {
        __syncthreads();
        pg8::Gemm g{mix, wo, M, DM, 1024, 1024, 1024, 1 << 30}; pg8::StaticOrder S; S.init(M, DM, G, bid);
        pg8::EpiBf16X<0, false> E{oraw, DM, nullptr};
        pg8::gemm_phase<pg8::EpiBf16X<0, false>, pg8::StaticOrder, true, true>(ldsl, g, S, E);
        SEAM(5);
    }
    if (IN(6)) {
        p6_rows(ka->in[0], oraw, ka->in[9], ka->in[10], hn, gw, NGW, lane);
        SEAM(6);
    }
    if (IN(7)) {
        pg8::Gemm g{hn, w1t, M, DFF, 1024, 1024, 1024, 1 << 30}; pg8::StaticOrder S; S.init(M, DFF, G, bid);
        pg8::EpiBf16X<2, false> E{hid, DFF, nullptr};
        pg8::gemm_phase<pg8::EpiBf16X<2, false>, pg8::StaticOrder, true, true>(ldsl, g, S, E);
        SEAM(7);
    }
    if (IN(8)) {
        pg8::Gemm g{hid, w2t, M, DM, DFF, DFF, DFF, 1 << 30}; pg8::StaticOrder S; S.init(M, DM, G, bid);
        pg8::EpiBf16X<0, false> E{ffraw, DM, nullptr};
        pg8::gemm_phase<pg8::EpiBf16X<0, false>, pg8::StaticOrder, true, true>(ldsl, g, S, E);
        SEAM(8);
    }
    if (IN(9)) {
        p9_rows(oraw, ffraw, ka->in[13], ka->out, gw, NGW, lane);
    }
#undef IN
#undef SEAM
#undef hcat
#undef winm
#undef wspl
#undef wo
#undef w1t
#undef w2t
#undef tab128
#undef tab64
#undef pmain
#undef pspl
#undef mix
#undef oraw
#undef hn
#undef hid
#undef ffraw
#undef ss1
#undef ss2
#undef GLA_ARGS
}

extern "C" void kernel_launch(void* const* d_in, const int* in_sizes, int n_in, void* d_out, int out_size, void* d_ws, size_t ws_size, hipStream_t stream) {
    static int grid = 0;
    if (grid == 0) {
        if (n_in != 14 || in_sizes[0] != M * DM || out_size != M * DM || ws_size < WS_END) { fprintf(stderr, "kernel_launch: shape/workspace mismatch (n_in %d, in0 %d, out %d, ws %zu < %zu); nothing launched\n", n_in, n_in > 0 ? in_sizes[0] : -1, out_size, ws_size, (size_t)WS_END); grid = -1; return; }
        int dev = 0, cus = 0, per_cu = 0;
        if (hipGetDevice(&dev) != hipSuccess || hipDeviceGetAttribute(&cus, hipDeviceAttributeMultiprocessorCount, dev) != hipSuccess) { fprintf(stderr, "kernel_launch: device query failed\n"); grid = -1; return; }
        if (hipFuncSetAttribute((const void*)fwd_kernel, hipFuncAttributeMaxDynamicSharedMemorySize, LDS_BYTES) != hipSuccess) { fprintf(stderr, "kernel_launch: hipFuncSetAttribute(%d B LDS) failed\n", LDS_BYTES); grid = -1; return; }
        if (hipOccupancyMaxActiveBlocksPerMultiprocessor(&per_cu, (const void*)fwd_kernel, NTHR, LDS_BYTES) != hipSuccess || per_cu < 1) fprintf(stderr, "kernel_launch: note: occupancy query reports %d workgroups per CU\n", per_cu);
        (void)hipGetLastError();
        grid = cus;
    }
    if (grid < 0) return;
    if (hipMemsetAsync((char*)d_ws + WS_CTL, 0, CTL_ZERO_BYTES, stream) != hipSuccess) { fprintf(stderr, "kernel_launch: memset failed\n"); return; }
    Args a{};
    for (int i = 0; i < 14; ++i) a.in[i] = (const float*)d_in[i];
    a.out = (float*)d_out; a.ws = (unsigned char*)d_ws;
#if MK_ONE_LAUNCH && PROBE_REPEAT >= 0
    { const int k = PROBE_REPEAT; const int lo3[3] = {0, k, k + 1}, hi3[3] = {k + 1, k + 1, NPHASE};
      for (int li = 0; li < 3; ++li) { if (lo3[li] >= hi3[li]) continue; a.ph_lo = lo3[li]; a.ph_hi = hi3[li]; a.li = li;
          hipLaunchKernelGGL(fwd_kernel, dim3(grid), dim3(NTHR), LDS_BYTES, stream, a); } }
#elif MK_ONE_LAUNCH
    a.ph_lo = 0; a.ph_hi = NPHASE; a.li = 0;
    hipLaunchKernelGGL(fwd_kernel, dim3(grid), dim3(NTHR), LDS_BYTES, stream, a);
#else
    for (int ph = 0; ph < NPHASE; ++ph) { a.ph_lo = ph; a.ph_hi = ph + 1; a.li = ph;
        hipLaunchKernelGGL(fwd_kernel, dim3(grid), dim3(NTHR), LDS_BYTES, stream, a); }
#endif
    const hipError_t le = hipPeekAtLastError();
    if (le != hipSuccess) fprintf(stderr, "kernel_launch: launch failed: %s\n", hipGetErrorName(le));
}
```

```cpp
#include <hip/hip_runtime.h>
#include <cstdio>
#include <cstdint>
#include <cmath>
namespace pg8 {
#define PG8_LAS __attribute__((address_space(3)))
typedef unsigned short bf16_t;
typedef short bf16x8 __attribute__((ext_vector_type(8)));
typedef _Float16 f16x8_t __attribute__((ext_vector_type(8)));
typedef float f32x4 __attribute__((ext_vector_type(4)));
typedef unsigned u32x4 __attribute__((ext_vector_type(4)));
constexpr int BM = 256, BK = 64, HALF = 128, HTB = HALF * BK * 2  , STAGE_BYTES = 8 * HTB, NXCD = 8, WGM = 8;

__host__ __device__ __forceinline__ int lds_byte(int r, int c) { const int st = (r >> 4) * 2 + (c >> 5), rr = r & 15, cc = c & 31, ob = rr * 64 + cc * 2; return st * 1024 + (ob ^ (((ob >> 9) & 1) << 5)); }
__host__ __device__ __forceinline__ void stage_rc(int b, int& R, int& C) { const int st = b / 1024, sb = b % 1024, swz = sb ^ (((sb >> 9) & 1) << 5); R = (st >> 1) * 16 + swz / 64; C = (st & 1) * 32 + (swz % 64) / 2; }
__host__ __device__ __forceinline__ int perm32(int rho) { const int n = rho >> 4, i = rho & 15; return 8 * (i >> 2) + 4 * n + (i & 3); }

struct Unit { int pm, pn; };
struct Gemm { const bf16_t* A; const bf16_t* Bt; int M, N, K, lda, ldb, awrap; };

struct StaticOrder {
    int nM, nN, nwg, G, c;
    __host__ __device__ void init(int M, int N, int G_, int c_) { nM = M / BM; nN = N / BM; nwg = nM * nN; G = G_; c = c_; }
    __host__ __device__ bool next(int i, Unit& u) const {
        const long L = (long)i * G + c; if (L >= nwg) return false;
        int wgid = (int)L; { const int q = nwg / NXCD, r = nwg % NXCD, xcd = wgid % NXCD, off = wgid / NXCD; wgid = (xcd < r ? xcd * (q + 1) : r * (q + 1) + (xcd - r) * q) + off; }
        const int nig = WGM * nN, gid = wgid / nig, fm = gid * WGM, gsz = (nM - fm) < WGM ? (nM - fm) : WGM;
        u.pm = fm + ((wgid % nig) % gsz); u.pn = (wgid % nig) / gsz; return true;
    }
    __device__ __forceinline__ void a_ready(const Unit&) const {}
    __device__ __forceinline__ void done(const Unit&) const {}
};

__device__ __forceinline__ unsigned cvt_pk_bf16(float lo, float hi) { unsigned r; asm volatile("v_cvt_pk_bf16_f32 %0, %1, %2" : "=v"(r) : "v"(lo), "v"(hi)); return r; }
template <int ACT  , bool SS> struct EpiBf16X {
    static constexpr bool PERM = true, AFTER_DRAIN = false;
    bf16_t* O; int ldc; float* ss;
    __device__ __forceinline__ void operator()(const f32x4 (&acc)[2][2][4][2], const Unit& u, int wr, int wc, int fr, int fq) const {
        const int row0 = u.pm * BM + wr * 64 + fr; const int col0 = u.pn * BM + wc * 32 + 8 * fq;
#pragma unroll
        for (int ai = 0; ai < 2; ++ai)
#pragma unroll
            for (int m = 0; m < 4; ++m) { const int row = row0 + ai * HALF + m * 16; bf16_t* rowp = O + (size_t)row * ldc + col0; float s = 0.f;
#pragma unroll
                for (int bj = 0; bj < 2; ++bj) { f32x4 v0 = acc[ai][bj][m][0], v1 = acc[ai][bj][m][1];
                    if (ACT == 2) {
#pragma unroll
                        for (int e = 0; e < 4; ++e) { const float a = fmaxf(v0[e], 0.f), b = fmaxf(v1[e], 0.f); v0[e] = a * a; v1[e] = b * b; } }
                    if (SS) s += (v0[0] * v0[0] + v0[1] * v0[1]) + (v0[2] * v0[2] + v0[3] * v0[3]) + (v1[0] * v1[0] + v1[1] * v1[1]) + (v1[2] * v1[2] + v1[3] * v1[3]);
                    u32x4 w; w.x = cvt_pk_bf16(v0[0], v0[1]); w.y = cvt_pk_bf16(v0[2], v0[3]); w.z = cvt_pk_bf16(v1[0], v1[1]); w.w = cvt_pk_bf16(v1[2], v1[3]);
                    *(u32x4*)(rowp + bj * HALF) = w; }
                if (SS) { s += __shfl_xor(s, 16); s += __shfl_xor(s, 32); if (fq == 0) atomicAdd(ss + row, s); } }
    }
};
struct EpiF32 {
    static constexpr bool PERM = false, AFTER_DRAIN = false;
    float* O; int ldc;
    __device__ __forceinline__ void operator()(const f32x4 (&acc)[2][2][4][2], const Unit& u, int wr, int wc, int fr, int fq) const {
        const int row0 = u.pm * BM + wr * 64 + fr; const int col0 = u.pn * BM + wc * 32 + 4 * fq;
#pragma unroll
        for (int ai = 0; ai < 2; ++ai)
#pragma unroll
            for (int m = 0; m < 4; ++m) { float* rowp = O + (size_t)(row0 + ai * HALF + m * 16) * ldc + col0;
#pragma unroll
                for (int bj = 0; bj < 2; ++bj)
#pragma unroll
                    for (int n = 0; n < 2; ++n) *(f32x4*)(rowp + bj * HALF + n * 16) = acc[ai][bj][m][n]; }
    }
};
template <class Epi, class Sched, bool ALIGN_EPI = false, bool SP2 = false, bool F16 = false>
__device__ __forceinline__ void gemm_phase(PG8_LAS unsigned char* lds, const Gemm g, const Sched& S, const Epi& E) {
    const int tid = threadIdx.x, wid = __builtin_amdgcn_readfirstlane(tid >> 6), lane = tid & 63, wr = wid >> 2, wc = wid & 3, fr = lane & 15, fq = lane >> 4;
    const int K = g.K, nt = K / BK;
    unsigned voffA[2], voffB[2];
#pragma unroll
    for (int i = 0; i < 2; ++i) { int R, C; stage_rc(tid * 16 + i * 8192, R, C); const int Rb = Epi::PERM ? ((R & ~31) + perm32(R & 31)) : R;
        voffA[i] = (unsigned)(R * g.lda + C) * 2u; voffB[i] = (unsigned)(Rb * g.ldb + C) * 2u; }
    const size_t kstep = (size_t)(BK * 2);
    const size_t hstepA = (size_t)HALF * g.lda * 2, hstepB = (size_t)HALF * g.ldb * 2;
    const size_t tstepA = 2 * hstepA, tstepB = 2 * hstepB; const int awrap = g.awrap;
    const unsigned ldsw = (unsigned)wid * 1024u;
    const int aoff = lds_byte(wr * 64 + fr, fq * 8), boff = lds_byte(wc * 32 + fr, fq * 8);
#define PG8_SA(b, h) (((b) * 2 + (h)) * HTB)
#define PG8_SB(b, h) ((4 + (b) * 2 + (h)) * HTB)
#define PG8_STAGE(bufoff, gbase, voff) do { _Pragma("unroll") for (int _i = 0; _i < 2; ++_i) \
        __builtin_amdgcn_global_load_lds((const unsigned*)((const char*)(gbase) + (voff)[_i]), (PG8_LAS unsigned*)(lds + (bufoff) + ldsw + _i * 8192), 16, 0, 0); } while (0)
#define PG8_LDA(dst, b, h) do { _Pragma("unroll") for (int m = 0; m < 4; ++m) _Pragma("unroll") for (int k = 0; k < 2; ++k) dst[m][k] = *(const PG8_LAS bf16x8*)(lds + PG8_SA(b, h) + aoff + m * 2048 + k * 1024); } while (0)
#define PG8_LDB(dst, b, h) do { _Pragma("unroll") for (int n = 0; n < 2; ++n) _Pragma("unroll") for (int k = 0; k < 2; ++k) dst[n][k] = *(const PG8_LAS bf16x8*)(lds + PG8_SB(b, h) + boff + n * 2048 + k * 1024); } while (0)
#define PG8_MMA(ai, bj, At, Bt) do { __builtin_amdgcn_s_setprio(1); _Pragma("unroll") for (int m = 0; m < 4; ++m) _Pragma("unroll") for (int n = 0; n < 2; ++n) _Pragma("unroll") for (int k = 0; k < 2; ++k) \
        acc[ai][bj][m][n] = F16 ? __builtin_amdgcn_mfma_f32_16x16x32_f16(__builtin_bit_cast(f16x8_t, Bt[n][k]), __builtin_bit_cast(f16x8_t, At[m][k]), acc[ai][bj][m][n], 0, 0, 0) \
                                : __builtin_amdgcn_mfma_f32_16x16x32_bf16(Bt[n][k], At[m][k], acc[ai][bj][m][n], 0, 0, 0); __builtin_amdgcn_s_setprio(0); } while (0)
#define PG8_WAIT_V(n) asm volatile("s_waitcnt vmcnt(" #n ")" ::: "memory")
#define PG8_WAIT_L(n) asm volatile("s_waitcnt lgkmcnt(" #n ")" ::: "memory")
#define PG8_BAR __builtin_amdgcn_s_barrier()
#define PG8_SCHED __builtin_amdgcn_sched_barrier(0)
    Unit cur, nxt; int ui = 0;
    if (!S.next(0, cur)) return;
    f32x4 acc[2][2][4][2];
#pragma unroll
    for (int a = 0; a < 2; ++a)
#pragma unroll
        for (int b = 0; b < 2; ++b)
#pragma unroll
            for (int m = 0; m < 4; ++m)
#pragma unroll
                for (int n = 0; n < 2; ++n) acc[a][b][m][n] = (f32x4){0.f, 0.f, 0.f, 0.f};
    bf16x8 At[4][2], B0[2][2], B1[2][2];
    const char* cA = (const char*)g.A + (size_t)cur.pm * tstepA; const char* cB = (const char*)g.Bt + (size_t)cur.pn * tstepB;
    S.a_ready(cur);
    if constexpr (SP2) {
        PG8_STAGE(PG8_SB(0, 0), cB, voffB); PG8_STAGE(PG8_SB(0, 1), cB + hstepB, voffB); PG8_STAGE(PG8_SA(0, 0), cA, voffA); PG8_STAGE(PG8_SA(0, 1), cA + hstepA, voffA);
        if (wr == 1) PG8_BAR;
        PG8_WAIT_V(2); PG8_BAR;
        PG8_STAGE(PG8_SB(1, 0), cB + kstep, voffB); PG8_STAGE(PG8_SA(1, 0), cA + kstep, voffA); PG8_STAGE(PG8_SB(1, 1), cB + hstepB + kstep, voffB);
        PG8_WAIT_V(6); PG8_BAR;
    } else {
        PG8_STAGE(PG8_SB(0, 0), cB, voffB); PG8_STAGE(PG8_SA(0, 0), cA, voffA); PG8_STAGE(PG8_SB(0, 1), cB + hstepB, voffB); PG8_STAGE(PG8_SA(0, 1), cA + hstepA, voffA);
        if (wr == 1) PG8_BAR;
        PG8_WAIT_V(4); PG8_BAR;
        PG8_STAGE(PG8_SB(1, 0), cB + kstep, voffB); PG8_STAGE(PG8_SA(1, 0), cA + kstep, voffA); PG8_STAGE(PG8_SB(1, 1), cB + hstepB + kstep, voffB);
        PG8_WAIT_V(6); PG8_BAR;
    }
    for (;;) {
        const bool has_next = S.next(ui + 1, nxt);
        const char* nA = has_next ? (const char*)g.A + (size_t)nxt.pm * tstepA : cA; const char* nB = has_next ? (const char*)g.Bt + (size_t)nxt.pn * tstepB : cB;
        for (int t = 0; t < nt; t += 2) {
            const bool last = (t == nt - 2);
            const int t1 = t + 1, t2 = t + 2; const char* a1 = cA + (size_t)(t1 >= awrap ? t1 - awrap : t1) * kstep;
            const char* a2 = last ? nA : cA + (size_t)(t2 >= awrap ? t2 - awrap : t2) * kstep; const char* b2 = last ? nB : cB + (size_t)(t + 2) * kstep;
            const char* a3 = a2 + kstep; const char* b3 = b2 + kstep;
            if (last && has_next) S.a_ready(nxt);
            if constexpr (SP2) {
            PG8_LDB(B0, 0, 0); PG8_LDB(B1, 0, 1); PG8_SCHED; PG8_LDA(At, 0, 0); PG8_STAGE(PG8_SA(1, 1), a1 + hstepA, voffA);
            PG8_WAIT_V(8); PG8_WAIT_L(0); PG8_BAR; PG8_MMA(0, 0, At, B0); PG8_MMA(0, 1, At, B1); PG8_BAR; PG8_SCHED;
            PG8_LDA(At, 0, 1); PG8_STAGE(PG8_SB(0, 0), b2, voffB); PG8_STAGE(PG8_SB(0, 1), b2 + hstepB, voffB); PG8_STAGE(PG8_SA(0, 0), a2, voffA);
            PG8_WAIT_V(8); PG8_WAIT_L(0); PG8_BAR; PG8_MMA(1, 0, At, B0); PG8_MMA(1, 1, At, B1); PG8_BAR; PG8_SCHED;
            PG8_LDB(B0, 1, 0); PG8_LDB(B1, 1, 1); PG8_SCHED; PG8_LDA(At, 1, 0); PG8_STAGE(PG8_SA(0, 1), a2 + hstepA, voffA);
            PG8_WAIT_V(8); PG8_WAIT_L(0); PG8_BAR; PG8_MMA(0, 0, At, B0); PG8_MMA(0, 1, At, B1); PG8_BAR; PG8_SCHED;
            PG8_LDA(At, 1, 1); PG8_STAGE(PG8_SB(1, 0), b3, voffB); PG8_STAGE(PG8_SB(1, 1), b3 + hstepB, voffB); PG8_STAGE(PG8_SA(1, 0), a3, voffA);
            PG8_WAIT_V(8); PG8_WAIT_L(0); PG8_BAR; PG8_MMA(1, 0, At, B0); PG8_MMA(1, 1, At, B1); PG8_BAR; PG8_SCHED;
            } else {
            PG8_LDB(B0, 0, 0); PG8_SCHED; PG8_LDA(At, 0, 0); PG8_STAGE(PG8_SA(1, 1), a1 + hstepA, voffA);
            PG8_WAIT_L(8); PG8_BAR; PG8_WAIT_L(0); PG8_MMA(0, 0, At, B0); PG8_BAR; PG8_SCHED;
            PG8_LDB(B1, 0, 1); PG8_STAGE(PG8_SB(0, 0), b2, voffB);
            PG8_BAR; PG8_WAIT_L(0); PG8_MMA(0, 1, At, B1); PG8_BAR;
            PG8_LDA(At, 0, 1); PG8_STAGE(PG8_SA(0, 0), a2, voffA);
            PG8_BAR; PG8_WAIT_L(0); PG8_MMA(1, 0, At, B0); PG8_BAR; PG8_SCHED;
            PG8_STAGE(PG8_SB(0, 1), b2 + hstepB, voffB);
            PG8_WAIT_V(6); PG8_BAR; PG8_MMA(1, 1, At, B1); PG8_BAR;
            PG8_LDB(B0, 1, 0); PG8_SCHED; PG8_LDA(At, 1, 0); PG8_STAGE(PG8_SA(0, 1), a2 + hstepA, voffA);
            PG8_WAIT_L(8); PG8_BAR; PG8_WAIT_L(0); PG8_MMA(0, 0, At, B0); PG8_BAR; PG8_SCHED;
            PG8_LDB(B1, 1, 1); PG8_STAGE(PG8_SB(1, 0), b3, voffB);
            PG8_BAR; PG8_WAIT_L(0); PG8_MMA(0, 1, At, B1); PG8_BAR;
            PG8_LDA(At, 1, 1); PG8_STAGE(PG8_SA(1, 0), a3, voffA);
            PG8_BAR; PG8_WAIT_L(0); PG8_MMA(1, 0, At, B0); PG8_BAR; PG8_SCHED;
            PG8_STAGE(PG8_SB(1, 1), b3 + hstepB, voffB);
            PG8_WAIT_V(6); PG8_BAR; PG8_MMA(1, 1, At, B1); PG8_BAR;
            }
        }
        if constexpr (ALIGN_EPI) { if (wr == 0) PG8_BAR; }
        if constexpr (!Epi::AFTER_DRAIN) { E(acc, cur, wr, wc, fr, fq); S.done(cur); }
        if (!has_next) break;
#pragma unroll
        for (int a = 0; a < 2; ++a)
#pragma unroll
            for (int b = 0; b < 2; ++b)
#pragma unroll
                for (int m = 0; m < 4; ++m)
#pragma unroll
                    for (int n = 0; n < 2; ++n) acc[a][b][m][n] = (f32x4){0.f, 0.f, 0.f, 0.f};
        cur = nxt; cA = nA; cB = nB; ++ui;
        if constexpr (ALIGN_EPI) { if (wr == 1) PG8_BAR; }
    }
    PG8_WAIT_V(0);
    if constexpr (!ALIGN_EPI) { if (wr == 0) PG8_BAR; }
    PG8_BAR;
    if constexpr (Epi::AFTER_DRAIN) { E.fused(acc, cur, wr, wc, fr, fq, lds, wid, lane); S.done(cur); }
#undef PG8_SA
#undef PG8_SB
#undef PG8_STAGE
#undef PG8_LDA
#undef PG8_LDB
#undef PG8_MMA
#undef PG8_WAIT_V
#undef PG8_WAIT_L
#undef PG8_BAR
#undef PG8_SCHED
}
}
constexpr int BATCH = 8, SEQ = 4096, DM = 1024, M = BATCH * SEQ;
constexpr int D_IN = 2644, NMAIN = 2304, NSPLIT = 512, KSPLIT = 1024, DFF = 4096;
constexpr int PM_GQ = 0, PM_GK = 256, PM_GV = 512, PM_GR = 1024, PM_DQ = 1536, PM_DK = 2048, PM_DV = 2176;
constexpr int PS_IQ = 0, PS_IK = 256, PS_IW = 320, PS_GLR = 324;
constexpr float EPS = 1e-6f;
constexpr int NWAVES = 8, NTHR = 512;
constexpr int NUNIT_GLA = BATCH * 4 * 64;
constexpr int TOPK = 256;

constexpr size_t MiB = 1u << 20;
constexpr size_t WS_CTL = 0, CTL_ZERO_BYTES = 1 * MiB;
constexpr int CW_BAR = 4096, CW_SS1 = 65536, CW_SS2 = 98304;
constexpr size_t WS_IW = 1 * MiB, WS_DECAY = 1 * MiB + 512 * 1024;
constexpr size_t WS_WINM = 2 * MiB, WS_WSPL = 7 * MiB, WS_WO = 10 * MiB, WS_W1 = 12 * MiB, WS_W2 = 20 * MiB;
constexpr size_t WS_TAB128 = 28 * MiB, WS_TAB64 = 30 * MiB, WS_QB = 31 * MiB;
constexpr size_t WS_HCAT = 32 * MiB;
constexpr size_t WS_QR = 32 * MiB, WS_KR = 64 * MiB, WS_IKH = 72 * MiB, WS_IKL = 76 * MiB, WS_IQH = 80 * MiB, WS_IQL = 96 * MiB, WS_MASK = 112 * MiB, WS_SIN = 128 * MiB;
constexpr size_t WS_PMAIN = 160 * MiB, WS_PSPL = 304 * MiB, WS_UT = 368 * MiB, WS_GQD = 400 * MiB, WS_GKI = 416 * MiB, WS_MIX = 432 * MiB;
constexpr size_t WS_ORAW = 160 * MiB, WS_HN = 32 * MiB, WS_HID = 256 * MiB, WS_FFRAW = 96 * MiB;
constexpr size_t WS_END = 512 * MiB;
constexpr int RING_BYTES = 131072, LDS_BYTES = 147456, MISC_OFF = LDS_BYTES - 256;

#define LAS __attribute__((address_space(3)))
typedef unsigned short bf16;
typedef unsigned v4u __attribute__((ext_vector_type(4)));
typedef unsigned v2u __attribute__((ext_vector_type(2)));
typedef float f32x4 __attribute__((ext_vector_type(4)));
typedef float f32x2 __attribute__((ext_vector_type(2)));
typedef short bf16x8 __attribute__((ext_vector_type(8)));
#define LDS_WAIT() asm volatile("s_waitcnt lgkmcnt(0)" ::: "memory")
__device__ __forceinline__ unsigned f2bf(float f) { unsigned u = __float_as_uint(f); return (u + 0x7fffu + ((u >> 16) & 1u)) >> 16; }
__device__ __forceinline__ float bf2f(unsigned h) { return __uint_as_float(h << 16); }
__device__ __forceinline__ unsigned pk2(float lo, float hi) { return f2bf(lo) | (f2bf(hi) << 16); }
__device__ __forceinline__ float wave_sum(float v) {
#pragma unroll
    for (int o = 1; o < 64; o <<= 1) v += __shfl_xor(v, o);
    return v;
}
__device__ __forceinline__ f32x4 mfma16(bf16x8 a, bf16x8 b, f32x4 c) { return __builtin_amdgcn_mfma_f32_16x16x32_bf16(a, b, c, 0, 0, 0); }
#define XB_TMO      128
#define XB_XCNT(j)  (256  + 64 * (j))
#define XB_XSUB(j)  (1280 + 64 * (j))
#define XB_XGEN(j)  (2304 + 64 * (j))
#define XB_TOP      3328
#define XB_TOPGEN   3392
#define XCD_BAR_WORDS 3456
#define XB_SPIN_CAP (1u << 18)

__device__ __forceinline__ unsigned xb_ld(unsigned* p)              { return __hip_atomic_load(p, __ATOMIC_RELAXED, __HIP_MEMORY_SCOPE_AGENT); }
__device__ __forceinline__ unsigned xb_add(unsigned* p, unsigned v) { return __hip_atomic_fetch_add(p, v, __ATOMIC_RELAXED, __HIP_MEMORY_SCOPE_AGENT); }
__device__ __forceinline__ unsigned xb_xcc_id() { return (unsigned)__builtin_amdgcn_s_getreg((3 << 11) | 20) & 0xFu; }
#define XB_SPIN(cond, bar) do { unsigned _sp = 0; while (cond) { __builtin_amdgcn_s_sleep(1); \
    if ((++_sp & 255u) == 0u) { if (xb_ld(&(bar)[XB_TMO])) break; if (_sp > XB_SPIN_CAP) { atomicAdd(&(bar)[XB_TMO], 1u); break; } } } } while (0)

struct XcdBarrier {
    unsigned* bar; unsigned x;
    volatile LAS unsigned* st;
};

__device__ __forceinline__ XcdBarrier xcd_barrier_post(unsigned* bar, volatile LAS unsigned* st) {
    XcdBarrier b; b.bar = bar; b.x = xb_xcc_id(); b.st = st;
    if (threadIdx.x == 0) (void)xb_add(&bar[XB_XCNT(b.x)], 1u);
    return b;
}
__device__ __forceinline__ void xcd_barrier_complete(unsigned* bar, unsigned x, unsigned& nloc, unsigned& nx) {
    const unsigned G = gridDim.x * gridDim.y * gridDim.z;
    unsigned sum, cnt, mine, sp = 0u;
    for (;;) {
        sum = 0u; cnt = 0u; mine = 0u;
#pragma unroll
        for (unsigned j = 0; j < 16; ++j) { const unsigned c = xb_ld(&bar[XB_XCNT(j)]); sum += c; cnt += (c > 0u) ? 1u : 0u; mine = (j == x) ? c : mine; }
        if (sum == G) break;
        __builtin_amdgcn_s_sleep(1);
        if ((++sp & 255u) == 0u) { if (xb_ld(&bar[XB_TMO])) break; if (sp > XB_SPIN_CAP) { atomicAdd(&bar[XB_TMO], 1u); break; } }
    }
    nloc = mine > 0u ? mine : 1u; nx = cnt > 0u ? cnt : 1u;
}

__device__ __forceinline__ void xcd_barrier(const XcdBarrier& b) {
    asm volatile("s_waitcnt vmcnt(0)" ::: "memory");
    __syncthreads();
    if (threadIdx.x == 0) {
        unsigned* bar = b.bar;
        __builtin_amdgcn_s_waitcnt(0);
        unsigned nloc = b.st[0], nx = b.st[1];
        if (nloc == 0u) { xcd_barrier_complete(bar, b.x, nloc, nx); b.st[0] = nloc; b.st[1] = nx; }
        const unsigned old = xb_add(&bar[XB_XSUB(b.x)], 1u);
        const unsigned gen = old / nloc;
        if (old + 1u == (gen + 1u) * nloc) {
            __builtin_amdgcn_fence(__ATOMIC_RELEASE, "agent");
            asm volatile("s_waitcnt vmcnt(0)" ::: "memory");
            const unsigned og = xb_add(&bar[XB_TOP], 1u);
            const unsigned tg = og / nx;
            if (og + 1u == (tg + 1u) * nx) xb_add(&bar[XB_TOPGEN], 1u);
            else XB_SPIN(xb_ld(&bar[XB_TOPGEN]) == tg, bar);
            __builtin_amdgcn_fence(__ATOMIC_ACQUIRE, "agent");
            xb_add(&bar[XB_XGEN(b.x)], 1u);
            asm volatile("s_waitcnt vmcnt(0)" ::: "memory");
        } else {
            XB_SPIN(xb_ld(&bar[XB_XGEN(b.x)]) == gen, bar);
            __builtin_amdgcn_fence(__ATOMIC_ACQUIRE, "agent");
            asm volatile("s_waitcnt vmcnt(0)" ::: "memory");
        }
    }
    __syncthreads();
}

__device__ __forceinline__ unsigned short f16bits(_Float16 h) { return __builtin_bit_cast(unsigned short, h); }
__device__ __forceinline__ unsigned pkh2(float lo, float hi) { return (unsigned)f16bits((_Float16)lo) | ((unsigned)f16bits((_Float16)hi) << 16); }
__device__ __forceinline__ float h2f(unsigned bits16) { return (float)__builtin_bit_cast(_Float16, (unsigned short)bits16); }
__device__ __forceinline__ int win_src_main(int j) { return j < 1024 ? j : j + 16; }
__device__ __forceinline__ int win_src_split(int j) { return j < 256 ? 2320 + j : (j < 320 ? 2576 + (j - 256) : (j < 324 ? 2640 + (j - 320) : (j < 340 ? 1024 + (j - 324) : -1))); }
template <int MODE>
__device__ __forceinline__ void p0_transpose_item(const float* W, int ldw, bf16* WT, int ldo, float* scr, int item, int nblk, int lane) {
    const int kb = item / nblk, nb = item % nblk, k0 = 64 * kb, n0 = 32 * nb;
    const int n = n0 + (lane & 31);
    const int sc = MODE == 0 ? n : (MODE == 1 ? win_src_main(n) : win_src_split(n));
    float wv[32];
#pragma unroll
    for (int i = 0; i < 32; ++i) { const int kk = 2 * i + (lane >> 5); wv[i] = sc >= 0 ? W[(size_t)(k0 + kk) * ldw + sc] : 0.f; }
#pragma unroll
    for (int i = 0; i < 32; ++i) { const int kk = 2 * i + (lane >> 5); scr[kk * 33 + (lane & 31)] = wv[i]; }
    LDS_WAIT();
    const int c = lane & 7;
#pragma unroll
    for (int j = 0; j < 4; ++j) { const int nn = (lane >> 3) + 8 * j; const float* s = scr + (8 * c) * 33 + nn;
        const float v0 = s[0 * 33], v1 = s[1 * 33], v2 = s[2 * 33], v3 = s[3 * 33], v4 = s[4 * 33], v5 = s[5 * 33], v6 = s[6 * 33], v7 = s[7 * 33];
        v4u o; if (MODE == 0) { o.x = pk2(v0, v1); o.y = pk2(v2, v3); o.z = pk2(v4, v5); o.w = pk2(v6, v7); } else { o.x = pkh2(v0, v1); o.y = pkh2(v2, v3); o.z = pkh2(v4, v5); o.w = pkh2(v6, v7); }
        bf16* dst = WT + (size_t)(n0 + nn) * ldo + k0 + 8 * c;
        *(v4u*)dst = o;
        }
    LDS_WAIT();
}
__device__ __forceinline__ void p0_rms_finish(const f32x4 (&v)[4], const float* w, bf16* orow, int lane) {
    const f32x4* wr = (const f32x4*)w + lane; float s = 0.f;
#pragma unroll
    for (int j = 0; j < 4; ++j) s += (v[j].x * v[j].x + v[j].y * v[j].y) + (v[j].z * v[j].z + v[j].w * v[j].w);
    const float r = 1.0f / sqrtf(wave_sum(s) * (1.f / DM) + EPS);
    unsigned long long* oh = (unsigned long long*)orow + lane;
#pragma unroll
    for (int j = 0; j < 4; ++j) { const f32x4 y = (v[j] * r) * wr[64 * j];
        const unsigned h0 = pkh2(y.x, y.y), h1 = pkh2(y.z, y.w);
        oh[64 * j] = (unsigned long long)h0 | ((unsigned long long)h1 << 32); }
}
__device__ __forceinline__ void p0_rms_rows(const float* x, const float* w, bf16* hcat, int gw, int NGW, int lane) {
    if (gw >= M) return;
    f32x4 cur[4], nxt[4];
#pragma unroll
    for (int j = 0; j < 4; ++j) cur[j] = __builtin_nontemporal_load((const f32x4*)(x + (size_t)gw * DM) + lane + 64 * j);
    for (int m = gw; m < M; m += NGW) { const int mn = (m + NGW < M) ? m + NGW : m;
#pragma unroll
        for (int j = 0; j < 4; ++j) nxt[j] = __builtin_nontemporal_load((const f32x4*)(x + (size_t)mn * DM) + lane + 64 * j);
        p0_rms_finish(cur, w, hcat + (size_t)m * 1024, lane);
#pragma unroll
        for (int j = 0; j < 4; ++j) cur[j] = nxt[j]; }
}
__device__ __forceinline__ void sincos_f64(double a, double& sn, double& cs) {
    const double kd = rint(a * 0.63661977236758134308);
    const double r = (a - kd * 1.57079632673412561417e+00) - kd * 6.07710050650619224932e-11;
    const double z = r * r;
    const double ps = 8.33333333332248946124e-03 + z * (-1.98412698298579493134e-04 + z * (2.75573137070700676789e-06 + z * (-2.50507602534068634195e-08 + z * 1.58969099521155010221e-10)));
    const double s = r + (z * r) * (-1.66666666666666324348e-01 + z * ps);
    const double pc = z * (4.16666666666666019037e-02 + z * (-1.38888888888741095749e-03 + z * (2.48015872894767294178e-05 + z * (-2.75573143513906633035e-07 + z * (2.08757232129817482790e-09 + z * -1.13596475577881948265e-11)))));
    const double c = 1.0 - (0.5 * z - z * pc);
    const int q = ((int)kd) & 3;
    sn = (q == 0) ? s : (q == 1) ? c : (q == 2) ? -s : -c;
    cs = (q == 0) ? c : (q == 1) ? -s : (q == 2) ? -c : s;
}
struct P0Args { const float *x, *nw, *w_in, *w_out, *w1, *w2; bf16 *hcat, *winm, *wspl, *wo, *w1t, *w2t; f32x2 *tab128, *tab64; };
__device__ __forceinline__ void p0_prologue(const P0Args& a, char* ldsg, int bid, int G, int tid) {
    const int lane = tid & 63, wave = tid >> 6;
    float* scr = (float*)(ldsg + wave * 16384);
    const int gw = bid * NWAVES + wave, NGW = G * NWAVES;
    constexpr int I_M = 16 * (NMAIN / 32), I_S = 16 * (NSPLIT / 32), I_O = 16 * (DM / 32), I_1 = 16 * (DFF / 32), I_2 = 64 * (DM / 32);
    for (int it = gw; it < I_M + I_S + I_O + I_1 + I_2; it += NGW) {
        int r = it;
        if (r < I_M) { p0_transpose_item<1>(a.w_in, D_IN, a.winm, 1024, scr, r, NMAIN / 32, lane); continue; } r -= I_M;
        if (r < I_S) { p0_transpose_item<2>(a.w_in, D_IN, a.wspl, KSPLIT, scr, r, NSPLIT / 32, lane); continue; } r -= I_S;
        if (r < I_O) { p0_transpose_item<0>(a.w_out, DM, a.wo, 1024, scr, r, DM / 32, lane); continue; } r -= I_O;
        if (r < I_1) { p0_transpose_item<0>(a.w1, DFF, a.w1t, 1024, scr, r, DFF / 32, lane); continue; } r -= I_1;
        p0_transpose_item<0>(a.w2, DM, a.w2t, DFF, scr, r, DM / 32, lane);
    }
    p0_rms_rows(a.x, a.nw, a.hcat, gw, NGW, lane);
    for (int e = bid * NTHR + tid; e < SEQ * 96; e += G * NTHR) {
        const int s = e / 96, j = e % 96; const bool big = j < 64; const int i = big ? j : j - 64;
        const double base = big ? 0.8659643233600653 : 0.7498942093324558;
        double p = 1.0; for (int k = 0; k < i; ++k) p *= base;
        const double ang = (double)s * (double)(float)p; double sn, cs; sincos_f64(ang, sn, cs);
        const f32x2 o = {(float)cs, (float)sn};
        if (big) a.tab128[s * 64 + i] = o; else a.tab64[s * 32 + i] = o;
    }
}

struct P2Args { const bf16* pmain; const float* pspl; const f32x2 *tab128, *tab64; const float *lnw, *lnb; bf16 *qr, *kr, *ikh, *ikl, *iqh, *iql; float* iw; float* qb; };
struct P2In { unsigned short k1, k2, q1[4], q2[4]; float iq1[2], iq2[2], iwr[2], ik, iw4; f32x2 cs, c2; };
__device__ __forceinline__ void p2_load(P2In& r, const P2Args& a, int m, int lane) {
    const int s = m & (SEQ - 1);
    const bf16* pm = a.pmain + (size_t)m * NMAIN; const float* ps = a.pspl + (size_t)m * NSPLIT;
    r.cs = a.tab128[s * 64 + lane]; r.c2 = a.tab64[s * 32 + (lane & 31)];
    r.k1 = pm[PM_DK + lane]; r.k2 = pm[PM_DK + 64 + lane];
#pragma unroll
    for (int h = 0; h < 4; ++h) { r.q1[h] = pm[PM_DQ + h * 128 + lane]; r.q2[h] = pm[PM_DQ + h * 128 + 64 + lane]; }
#pragma unroll
    for (int e = 0; e < 2; ++e) { const int h = 2 * e + (lane >> 5), i = lane & 31; r.iq1[e] = ps[PS_IQ + h * 64 + i]; r.iq2[e] = ps[PS_IQ + h * 64 + 32 + i]; r.iwr[e] = ps[PS_IW + h]; }
    r.ik = ps[PS_IK + lane]; r.iw4 = ps[PS_IW + (lane & 3)];
}
__device__ __forceinline__ void p2_post_row(const P2In& r, const P2Args& a, int m, int lane) {
    const int s = m & (SEQ - 1);
    const f32x2 cs = r.cs;
    { const float x1 = bf2f(r.k1), x2 = bf2f(r.k2);
      a.kr[(size_t)m * 128 + lane] = (bf16)f2bf(x1 * cs.x - x2 * cs.y); a.kr[(size_t)m * 128 + 64 + lane] = (bf16)f2bf(x2 * cs.x + x1 * cs.y); }
#pragma unroll
    for (int h = 0; h < 4; ++h) { const float x1 = bf2f(r.q1[h]), x2 = bf2f(r.q2[h]);
      a.qr[(size_t)m * 512 + h * 128 + lane] = (bf16)f2bf(x1 * cs.x - x2 * cs.y); a.qr[(size_t)m * 512 + h * 128 + 64 + lane] = (bf16)f2bf(x2 * cs.x + x1 * cs.y); }
    const f32x2 c2 = r.c2;
    float qn = 0.f;
#pragma unroll
    for (int e = 0; e < 2; ++e) { const int h = 2 * e + (lane >> 5), i = lane & 31;
      const float x1 = r.iq1[e], x2 = r.iq2[e];
      const float wr = r.iwr[e];
      const float o1 = (x1 * c2.x - x2 * c2.y) * wr, o2 = (x2 * c2.x + x1 * c2.y) * wr;
      float sq = o1 * o1 + o2 * o2;
#pragma unroll
      for (int o = 1; o < 32; o <<= 1) sq += __shfl_xor(sq, o);
      qn += sqrtf(sq);
      const _Float16 h1 = (_Float16)o1, h2 = (_Float16)o2; const size_t p = ((size_t)m * 4 + h) * 64 + i;
      a.iqh[p] = f16bits(h1); a.iqh[p + 32] = f16bits(h2); a.iql[p] = f16bits((_Float16)(o1 - (float)h1)); a.iql[p + 32] = f16bits((_Float16)(o2 - (float)h2)); }
    qn += __shfl_xor(qn, 32);
    if (lane == 0) a.qb[m] = qn;
    { const float v = r.ik; const float mu = wave_sum(v) * (1.f / 64.f); const float d = v - mu; const float var = wave_sum(d * d) * (1.f / 64.f);
      const float y = d * (1.0f / sqrtf(var + EPS)) * a.lnw[lane] + a.lnb[lane];
      const float other = __shfl_xor(y, 32);
      const float o = lane < 32 ? (y * c2.x - other * c2.y) : (y * c2.x + other * c2.y);
      const size_t p = (size_t)(m >> 12) * (SEQ * 64) + (size_t)(s >> 4) * 1024 + (lane >> 5) * 512 + ((((lane & 31) >> 3) * 16 + (s & 15)) * 8) + (lane & 7);
      a.ikh[p] = f16bits((_Float16)o); }
    if (lane < 4) a.iw[(size_t)m * 4 + lane] = (r.iw4 < 0.f) ? -__builtin_inff() : __builtin_inff();
}
__device__ __forceinline__ void p2_post_rows(const P2Args& a, int gw, int NGW, int lane) {
    if (gw >= M) return;
    P2In cur, nxt; p2_load(cur, a, gw, lane);
    for (int m = gw; m < M; m += NGW) { const int mn = (m + NGW < M) ? m + NGW : m;
        p2_load(nxt, a, mn, lane); p2_post_row(cur, a, m, lane); cur = nxt; }
}

constexpr int GLA_LD = 72;
struct GlaArgs { const bf16* pmain; const float* pspl; const float *gw2, *gb, *gnw; bf16* ut; float* decay; bf16* sin_; bf16* mix; bf16* gqd; bf16* gki; };
struct GlaPre { f32x2 glr, w2; float gbv; v4u k, q, v0, v1; };
template <bool WITH_Q>
__device__ __forceinline__ void gla_prefetch(GlaPre& p, const GlaArgs& a, int u, int tid) {
    const int b = u >> 8, h = (u >> 6) & 3, n = u & 63, m0 = b * SEQ + n * 64;
    { const int i = 2 * tid, t = i >> 4, j = i & 15; p.glr = *(const f32x2*)(a.pspl + (size_t)(m0 + t) * NSPLIT + PS_GLR + j); }
    { const int i = 2 * tid, j = i >> 6, d = i & 63; p.w2 = *(const f32x2*)(a.gw2 + j * 256 + h * 64 + d); }
    p.gbv = a.gb[h * 64 + (tid & 63)];
    const bf16* row = a.pmain + (size_t)(m0 + (tid >> 3)) * NMAIN;
    p.k = *(const v4u*)(row + PM_GK + h * 64 + 8 * (tid & 7));
    if (WITH_Q) p.q = *(const v4u*)(row + PM_GQ + h * 64 + 8 * (tid & 7));
    p.v0 = *(const v4u*)(row + PM_GV + h * 128 + 8 * (tid & 7)); p.v1 = *(const v4u*)(row + PM_GV + h * 128 + 64 + 8 * (tid & 7));
}
constexpr int GS_LD = 65;
__device__ __forceinline__ void gla_bcum(const GlaPre& p, float* Gs, float* glr, float* w2s, float* gbs, int tid) {
    *(f32x2*)(glr + 2 * tid) = p.glr; *(f32x2*)(w2s + 2 * tid) = p.w2; if (tid < 64) gbs[tid] = p.gbv;
    __syncthreads();
    { const int d = tid & 63; float wc[16];
#pragma unroll
      for (int j = 0; j < 16; ++j) wc[j] = w2s[j * 64 + d];
      const float bias = gbs[d];
#pragma unroll
      for (int e = 0; e < 8; ++e) { const int t = (tid >> 6) + 8 * e; const f32x4* g4 = (const f32x4*)(glr + t * 16); float z = 0.f;
#pragma unroll
          for (int j4 = 0; j4 < 4; ++j4) { const f32x4 gv = g4[j4]; z += gv.x * wc[4 * j4]; z += gv.y * wc[4 * j4 + 1]; z += gv.z * wc[4 * j4 + 2]; z += gv.w * wc[4 * j4 + 3]; }
          z += bias;
          Gs[t * GS_LD + d] = (fminf(z, 0.f) - __logf(1.f + __expf(-fabsf(z)))) * (1.f / 16.f); } }
    __syncthreads();
    if (tid < 64) { float c[64];
#pragma unroll
        for (int t = 0; t < 64; ++t) c[t] = Gs[t * GS_LD + tid];
#pragma unroll
        for (int t = 1; t < 64; ++t) c[t] += c[t - 1];
#pragma unroll
        for (int t = 0; t < 64; ++t) Gs[t * GS_LD + tid] = c[t]; }
    __syncthreads();
}
__device__ __forceinline__ float bfl(unsigned w) { return __uint_as_float(w << 16); }
__device__ __forceinline__ float bfh(unsigned w) { return __uint_as_float(w & 0xffff0000u); }
__device__ __forceinline__ void gla_local_phase(const GlaArgs& a, char* ldsg, int bid, int G, int tid) {
    const int lane = tid & 63, w = tid >> 6, quad = lane >> 4, l15 = lane & 15;
    float* Gs = (float*)ldsg; float* glr = Gs + 64 * GS_LD + 32; float* w2s = glr + 1024; float* gbs = w2s + 1024; bf16* kT = (bf16*)(gbs + 64); bf16* vT = kT + 64 * GLA_LD;
    if (bid >= NUNIT_GLA) return;
    GlaPre cur, nxt; gla_prefetch<true>(cur, a, bid, tid);
    for (int u = bid; u < NUNIT_GLA; u += G) {
        const int un = (u + G < NUNIT_GLA) ? u + G : u; gla_prefetch<true>(nxt, a, un, tid);
        __syncthreads();
        gla_bcum(cur, Gs, glr, w2s, gbs, tid);
        { const int t = tid >> 3, d0 = 8 * (tid & 7); const unsigned kw[4] = {cur.k.x, cur.k.y, cur.k.z, cur.k.w}, qw[4] = {cur.q.x, cur.q.y, cur.q.z, cur.q.w}; unsigned qo[4], ko[4]; const unsigned v0w[4] = {cur.v0.x, cur.v0.y, cur.v0.z, cur.v0.w}, v1w[4] = {cur.v1.x, cur.v1.y, cur.v1.z, cur.v1.w};
#pragma unroll
          for (int e = 0; e < 4; ++e) { const int d = d0 + 2 * e; const float g0 = Gs[t * GS_LD + d], g1 = Gs[t * GS_LD + d + 1];
              qo[e] = pk2(bfl(qw[e]) * 0.125f * __expf(g0), bfh(qw[e]) * 0.125f * __expf(g1)); ko[e] = pk2(bfl(kw[e]) * __expf(-g0), bfh(kw[e]) * __expf(-g1));
              kT[d * GLA_LD + t] = (bf16)f2bf(bfl(kw[e]) * __expf(Gs[63 * GS_LD + d] - Gs[t * GS_LD + d])); kT[(d + 1) * GLA_LD + t] = (bf16)f2bf(bfh(kw[e]) * __expf(Gs[63 * GS_LD + d + 1] - Gs[t * GS_LD + d + 1]));
              vT[d * GLA_LD + t] = (bf16)(v0w[e] & 0xffffu); vT[(d + 1) * GLA_LD + t] = (bf16)(v0w[e] >> 16);
              vT[(64 + d) * GLA_LD + t] = (bf16)(v1w[e] & 0xffffu); vT[(64 + d + 1) * GLA_LD + t] = (bf16)(v1w[e] >> 16); }
          *(v4u*)(a.gqd + (size_t)u * 4096 + t * 64 + d0) = (v4u){qo[0], qo[1], qo[2], qo[3]}; *(v4u*)(a.gki + (size_t)u * 4096 + t * 64 + d0) = (v4u){ko[0], ko[1], ko[2], ko[3]}; }
        if (tid < 64) a.decay[(size_t)u * 64 + tid] = __expf(Gs[63 * GS_LD + tid]);
        __syncthreads();
        f32x4 acc[4];
#pragma unroll
        for (int dt = 0; dt < 4; ++dt) acc[dt] = (f32x4){0.f, 0.f, 0.f, 0.f};
#pragma unroll
        for (int ks = 0; ks < 2; ++ks) { const bf16x8 af = *(const bf16x8*)(vT + (16 * w + l15) * GLA_LD + ks * 32 + 8 * quad);
#pragma unroll
            for (int dt = 0; dt < 4; ++dt) { const bf16x8 bfr = *(const bf16x8*)(kT + (16 * dt + l15) * GLA_LD + ks * 32 + 8 * quad); acc[dt] = mfma16(af, bfr, acc[dt]); } }
        bf16* uo = a.ut + (size_t)u * 8192;
#pragma unroll
        for (int dt = 0; dt < 4; ++dt)
#pragma unroll
            for (int r = 0; r < 4; ++r) uo[(16 * w + 4 * quad + r) * 64 + 16 * dt + l15] = (bf16)f2bf(acc[dt][r]);
        cur = nxt;
    }
}
__device__ __forceinline__ void gla_scan(const GlaArgs& a, int bid, int G, int tid) {
    for (int idx = bid * NTHR + tid; idx < 32 * 4096; idx += G * NTHR) {
        const int bh = idx >> 12, e = idx & 4095, d = e & 63; float s0 = 0.f, s1 = 0.f;
        const bf16* up = a.ut + (size_t)bh * 64 * 8192 + e; const float* dp = a.decay + (size_t)bh * 64 * 64 + d; bf16* sp = a.sin_ + (size_t)bh * 64 * 8192 + e;
#pragma nounroll
        for (int n0 = 0; n0 < 64; n0 += 8) {
            float u0[8], u1[8], dc[8];
#pragma unroll
            for (int k = 0; k < 8; ++k) { u0[k] = bf2f(up[(size_t)(n0 + k) * 8192]); u1[k] = bf2f(up[(size_t)(n0 + k) * 8192 + 4096]); dc[k] = dp[(n0 + k) * 64]; }
#pragma unroll
            for (int k = 0; k < 8; ++k) { sp[(size_t)(n0 + k) * 8192] = (bf16)f2bf(s0); sp[(size_t)(n0 + k) * 8192 + 4096] = (bf16)f2bf(s1); s0 = dc[k] * s0 + u0[k]; s1 = dc[k] * s1 + u1[k]; }
        }
    }
}
struct GlaPreO { v4u qd, ki, v0, v1; bf16x8 sfr[2][4]; };
__device__ __forceinline__ void gla_prefetch_o(GlaPreO& p, const GlaArgs& a, int u, int tid) {
    const int b = u >> 8, h = (u >> 6) & 3, n = u & 63, m0 = b * SEQ + n * 64, t = tid >> 3, d0 = 8 * (tid & 7);
    p.qd = *(const v4u*)(a.gqd + (size_t)u * 4096 + t * 64 + d0); p.ki = *(const v4u*)(a.gki + (size_t)u * 4096 + t * 64 + d0);
    const bf16* row = a.pmain + (size_t)(m0 + t) * NMAIN + PM_GV + h * 128;
    p.v0 = *(const v4u*)(row + d0); p.v1 = *(const v4u*)(row + 64 + d0);
    { const int lane = tid & 63, ch = tid >> 8, quad = lane >> 4, l15 = lane & 15; const bf16* Sg = a.sin_ + (size_t)u * 8192;
#pragma unroll
      for (int ks = 0; ks < 2; ++ks)
#pragma unroll
        for (int vt = 0; vt < 4; ++vt) p.sfr[ks][vt] = *(const bf16x8*)(Sg + (16 * (4 * ch + vt) + l15) * 64 + ks * 32 + 8 * quad); }
}
__device__ __forceinline__ void gla_out_phase(const GlaArgs& a, char* ldsg, int bid, int G, int tid) {
    const int lane = tid & 63, w = tid >> 6, quad = lane >> 4, l15 = lane & 15;
    bf16* Qd = (bf16*)ldsg; bf16* Ki = Qd + 64 * GLA_LD; bf16* vT = Ki + 64 * GLA_LD; bf16* At = vT + 128 * GLA_LD;
    float* part = (float*)(At + 64 * GLA_LD);
    if (bid >= NUNIT_GLA) return;
    const int rt = w & 3, ch = w >> 2;
    GlaPreO cur, nxt; gla_prefetch_o(cur, a, bid, tid);
    for (int u = bid; u < NUNIT_GLA; u += G) {
        const int b = u >> 8, h = (u >> 6) & 3, n = u & 63, m0 = b * SEQ + n * 64;
        const int un = (u + G < NUNIT_GLA) ? u + G : u; gla_prefetch_o(nxt, a, un, tid);
        unsigned short rg[4][4];
        {
#pragma unroll
          for (int r = 0; r < 4; ++r)
#pragma unroll
            for (int vt = 0; vt < 4; ++vt) rg[r][vt] = a.pmain[(size_t)(m0 + 16 * rt + 4 * quad + r) * NMAIN + PM_GR + h * 128 + 16 * (4 * ch + vt) + l15]; }
        __syncthreads();
        { const int t = tid >> 3, d0 = 8 * (tid & 7);
          const unsigned v0w[4] = {cur.v0.x, cur.v0.y, cur.v0.z, cur.v0.w}, v1w[4] = {cur.v1.x, cur.v1.y, cur.v1.z, cur.v1.w};
#pragma unroll
          for (int e = 0; e < 4; ++e) { const int d = d0 + 2 * e;
              vT[d * GLA_LD + t] = (bf16)(v0w[e] & 0xffffu); vT[(d + 1) * GLA_LD + t] = (bf16)(v0w[e] >> 16);
              vT[(64 + d) * GLA_LD + t] = (bf16)(v1w[e] & 0xffffu); vT[(64 + d + 1) * GLA_LD + t] = (bf16)(v1w[e] >> 16); }
          *(v4u*)(Qd + t * GLA_LD + d0) = cur.qd; *(v4u*)(Ki + t * GLA_LD + d0) = cur.ki; }
        __syncthreads();
        {
            f32x4 s2[2] = {(f32x4){0.f, 0.f, 0.f, 0.f}, (f32x4){0.f, 0.f, 0.f, 0.f}};
#pragma unroll
            for (int ks = 0; ks < 2; ++ks) { const bf16x8 af = *(const bf16x8*)(Qd + (16 * rt + l15) * GLA_LD + ks * 32 + 8 * quad);
#pragma unroll
                for (int j2 = 0; j2 < 2; ++j2) { const bf16x8 bfr = *(const bf16x8*)(Ki + (16 * (2 * ch + j2) + l15) * GLA_LD + ks * 32 + 8 * quad); s2[j2] = mfma16(af, bfr, s2[j2]); } }
#pragma unroll
            for (int j2 = 0; j2 < 2; ++j2)
#pragma unroll
                for (int r = 0; r < 4; ++r) { const int i = 16 * rt + 4 * quad + r, j = 16 * (2 * ch + j2) + l15; At[i * GLA_LD + j] = (bf16)f2bf(j <= i ? s2[j2][r] : 0.f); }
        }
        __syncthreads();
        f32x4 o[4];
#pragma unroll
        for (int vt = 0; vt < 4; ++vt) o[vt] = (f32x4){0.f, 0.f, 0.f, 0.f};
#pragma unroll
        for (int ks = 0; ks < 2; ++ks) {
            const bf16x8 a1 = *(const bf16x8*)(At + (16 * rt + l15) * GLA_LD + ks * 32 + 8 * quad);
            const bf16x8 a2 = *(const bf16x8*)(Qd + (16 * rt + l15) * GLA_LD + ks * 32 + 8 * quad);
#pragma unroll
            for (int vt = 0; vt < 4; ++vt) { const bf16x8 b1 = *(const bf16x8*)(vT + (16 * (4 * ch + vt) + l15) * GLA_LD + ks * 32 + 8 * quad);
                o[vt] = mfma16(a1, b1, o[vt]); o[vt] = mfma16(a2, cur.sfr[ks][vt], o[vt]); } }
#pragma unroll
        for (int r = 0; r < 4; ++r) { float sq = 0.f;
#pragma unroll
            for (int vt = 0; vt < 4; ++vt) sq += o[vt][r] * o[vt][r];
            sq += __shfl_xor(sq, 1); sq += __shfl_xor(sq, 2); sq += __shfl_xor(sq, 4); sq += __shfl_xor(sq, 8);
            if (l15 == 0) part[ch * 64 + 16 * rt + 4 * quad + r] = sq; }
        __syncthreads();
#pragma unroll
        for (int r = 0; r < 4; ++r) { const int i = 16 * rt + 4 * quad + r; const float rstd = 1.0f / sqrtf((part[i] + part[64 + i]) * (1.f / 128.f) + EPS);
#pragma unroll
            for (int vt = 0; vt < 4; ++vt) { const int v = 16 * (4 * ch + vt) + l15; const float rgf = bf2f(rg[r][vt]);
                a.mix[(size_t)(m0 + i) * 1024 + h * 128 + v] = (bf16)f2bf(o[vt][r] * rstd * a.gnw[v] * (rgf / (1.f + __expf(-rgf)))); } }
        cur = nxt;
    }
}

template <class T> __device__ __forceinline__ T ntl(const T* p) { return __builtin_nontemporal_load(p); }
template <class T> __device__ __forceinline__ void nts(T* p, T v) { __builtin_nontemporal_store(v, p); }
struct RowBuf { f32x4 x[4]; v2u r[4]; };
__device__ __forceinline__ void row_load(RowBuf& b, const float* xrow, const bf16* raw, int lane) {
#pragma unroll
    for (int j = 0; j < 4; ++j) { b.x[j] = ntl((const f32x4*)xrow + lane + 64 * j); b.r[j] = ntl((const v2u*)raw + lane + 64 * j); }
}
__device__ __forceinline__ f32x4 bf4(v2u rw);
__device__ __forceinline__ float row_ss(const v2u (&r)[4]);
__device__ __forceinline__ f32x4 bf4(v2u rw) { return (f32x4){bf2f(rw.x & 0xffffu), bf2f(rw.x >> 16), bf2f(rw.y & 0xffffu), bf2f(rw.y >> 16)}; }
__device__ __forceinline__ void p6_finish(const RowBuf& b, const float* wpost, const float* wpre, bf16* x1b, bf16* hn, int lane) {
    const float r1 = 1.0f / sqrtf(row_ss(b.r) * (1.f / DM) + EPS);
    f32x4 v[4]; float s = 0.f;
#pragma unroll
    for (int j = 0; j < 4; ++j) { v[j] = b.x[j] + (bf4(b.r[j]) * r1) * ((const f32x4*)wpost)[lane + 64 * j];
        s += (v[j].x * v[j].x + v[j].y * v[j].y) + (v[j].z * v[j].z + v[j].w * v[j].w);
        v2u o; o.x = pk2(v[j].x, v[j].y); o.y = pk2(v[j].z, v[j].w); ((v2u*)x1b)[lane + 64 * j] = o; }
    const float r2 = 1.0f / sqrtf(wave_sum(s) * (1.f / DM) + EPS);
#pragma unroll
    for (int j = 0; j < 4; ++j) { const f32x4 wv = ((const f32x4*)wpre)[lane + 64 * j]; const f32x4 y = (v[j] * r2) * wv;
        v2u o; o.x = pk2(y.x, y.y); o.y = pk2(y.z, y.w); ((v2u*)hn)[lane + 64 * j] = o; }
}
__device__ __forceinline__ float row_ss(const v2u (&r)[4]) { float s = 0.f;
#pragma unroll
    for (int j = 0; j < 4; ++j) { const f32x4 o = bf4(r[j]); s += (o.x * o.x + o.y * o.y) + (o.z * o.z + o.w * o.w); }
    return wave_sum(s); }
__device__ __forceinline__ void p6_rows(const float* x, bf16* raw, const float* wpost, const float* wpre, bf16* hn, int gw, int NGW, int lane) {
    if (gw >= M) return;
    RowBuf cur, nxt; row_load(cur, x + (size_t)gw * DM, raw + (size_t)gw * DM, lane);
    for (int m = gw; m < M; m += NGW) { const int mn = (m + NGW < M) ? m + NGW : m;
        if (mn != m) row_load(nxt, x + (size_t)mn * DM, raw + (size_t)mn * DM, lane);
        p6_finish(cur, wpost, wpre, raw + (size_t)m * DM, hn + (size_t)m * DM, lane); cur = nxt; }
}
__device__ __forceinline__ void p9_rows(const bf16* x1b, const bf16* raw2, const float* wpost2, float* out, int gw, int NGW, int lane) {
    if (gw >= M) return;
    v2u cx[4], c2[4], nx[4], n2[4];
#pragma unroll
    for (int j = 0; j < 4; ++j) { cx[j] = ntl((const v2u*)(x1b + (size_t)gw * DM) + lane + 64 * j); c2[j] = ntl((const v2u*)(raw2 + (size_t)gw * DM) + lane + 64 * j); }
    for (int m = gw; m < M; m += NGW) { const int mn = (m + NGW < M) ? m + NGW : m;
#pragma unroll
        for (int j = 0; j < 4; ++j) { nx[j] = ntl((const v2u*)(x1b + (size_t)mn * DM) + lane + 64 * j); n2[j] = ntl((const v2u*)(raw2 + (size_t)mn * DM) + lane + 64 * j); }
        const float r2 = 1.0f / sqrtf(row_ss(c2) * (1.f / DM) + EPS);
#pragma unroll
        for (int j = 0; j < 4; ++j) nts((f32x4*)(out + (size_t)m * DM) + lane + 64 * j, bf4(cx[j]) + (bf4(c2[j]) * r2) * ((const f32x4*)wpost2)[lane + 64 * j]);
#pragma unroll
        for (int j = 0; j < 4; ++j) { cx[j] = nx[j]; c2[j] = n2[j]; } }
}
__device__ __forceinline__ unsigned okey_of(float s) { const unsigned u = __float_as_uint(s); return (u & 0x80000000u) ? ~u : (u | 0x80000000u); }
__device__ __forceinline__ void cnt_ge(unsigned& n, unsigned k, unsigned c) { asm volatile("v_cmp_ge_u32 vcc, %1, %2\n\tv_addc_co_u32 %0, vcc, 0, %0, vcc" : "+v"(n) : "v"(k), "v"(c) : "vcc"); }
__device__ __forceinline__ void cnt_gt(unsigned& n, unsigned k, unsigned c) { asm volatile("v_cmp_gt_u32 vcc, %1, %2\n\tv_addc_co_u32 %0, vcc, 0, %0, vcc" : "+v"(n) : "v"(k), "v"(c) : "vcc"); }
__device__ __forceinline__ void cnt_tie(unsigned& n, unsigned k, unsigned T, unsigned lo, unsigned c) { unsigned tmp;
    asm volatile("v_cmp_eq_u32 vcc, %2, %3\n\tv_cndmask_b32 %1, 0, %4, vcc\n\tv_cmp_ge_u32 vcc, %1, %5\n\tv_addc_co_u32 %0, vcc, 0, %0, vcc" : "+v"(n), "=&v"(tmp) : "v"(k), "v"(T), "v"(lo), "v"(c) : "vcc"); }
#ifndef PROBE_IDX
#define PROBE_IDX 0
#endif
typedef _Float16 f16x8 __attribute__((ext_vector_type(8)));
__device__ __forceinline__ f32x4 mfma16h(f16x8 a, f16x8 b, f32x4 c) { return __builtin_amdgcn_mfma_f32_16x16x32_f16(a, b, c, 0, 0, 0); }
struct IdxArgs { const bf16 *iqh, *iql, *ikh, *ikl; const float* iw; unsigned short* mask16; const float* qb; float kbound; };
constexpr int IDX_ROUNDS = 45;
constexpr int IDX_NB = 2048, IDX_CAP = 512;
constexpr int IDX_HIST = 0, IDX_CAND = 8 * IDX_NB * 4, IDX_SMALL = IDX_CAND + 8 * IDX_CAP * 8;
__device__ __forceinline__ float okey_to_f(unsigned k) { return __uint_as_float((k & 0x80000000u) ? (k & 0x7fffffffu) : ~k); }
__device__ __forceinline__ unsigned idx_bin(float s, float inv) { return min((unsigned)__builtin_fmaf(s, inv, 0.5f * IDX_NB), (unsigned)(IDX_NB - 1)); }
template <int NI, int PV>
__device__ __forceinline__ void indexer_unit_t(const IdxArgs& a, int b, int c, int g, char* ldsg, int tid, int probe) {
    int lane_ = tid & 63; asm volatile("" : "+v"(lane_));
    const int lane = lane_, w = __builtin_amdgcn_readfirstlane(tid >> 6), quad = lane >> 4, l15 = lane & 15;
    const int q0 = b * SEQ + c * 64 + g * 8, ntile = 4 * (c + 1), nloc = (ntile - w + 7) >> 3;
    unsigned* hist = (unsigned*)(ldsg + IDX_HIST); unsigned long long* cand = (unsigned long long*)(ldsg + IDX_CAND); unsigned* sm = (unsigned*)(ldsg + IDX_SMALL);
    unsigned* qmin = sm; unsigned* qmax = sm + 8; unsigned* bstar = sm + 16; unsigned* above = sm + 24; unsigned* candn = sm + 32; unsigned* Tq = sm + 40; unsigned* Lq = sm + 48; unsigned* ovf = sm + 56; unsigned* dump = sm + 60; unsigned* cnt = sm + 64;
    __syncthreads();
    { v4u z = {0u, 0u, 0u, 0u}; v4u* h4 = (v4u*)hist;
#pragma unroll
      for (int k = 0; k < 8; ++k) h4[tid + k * NTHR] = z;
      if (tid < 8) candn[tid] = 0u;
      if (tid == 8) ovf[0] = 0u; }
    f16x8 aqh[2][2], aql[2][2]; f32x4 wq[2];
#pragma unroll
    for (int rt = 0; rt < 2; ++rt) {
#pragma unroll
        for (int ks = 0; ks < 2; ++ks) { const size_t p = ((size_t)(q0 + rt * 4 + (l15 >> 2)) * 4 + (l15 & 3)) * 64 + ks * 32 + 8 * quad;
            aqh[rt][ks] = *(const f16x8*)(a.iqh + p); aql[rt][ks] = *(const f16x8*)(a.iql + p); }
        wq[rt] = *(const f32x4*)(a.iw + (size_t)(q0 + rt * 4 + quad) * 4); }
    float sc[NI][2];
    const float kmx = a.kbound * 0.1666667f; const float inv0 = (0.5f * IDX_NB) / (a.qb[q0 + quad] * kmx), inv1 = (0.5f * IDX_NB) / (a.qb[q0 + 4 + quad] * kmx);
    __syncthreads();
    const char* khb = (const char*)a.ikh + (size_t)b * SEQ * 128;
    const unsigned koff = (unsigned)lane * 16u;
    constexpr int RING = 8;
    f16x8 kb[RING][2];
#define IDX_LOAD(i) do { const int tc_ = (probe >= 4) ? 0 : min(w + 8 * (i), ntile - 1); const unsigned o_ = koff + (unsigned)tc_ * 2048u; kb[(i) % RING][0] = *(const f16x8*)(khb + o_); kb[(i) % RING][1] = *(const f16x8*)(khb + (o_ + 1024u)); } while (0)
#pragma unroll
    for (int i = 0; i < RING - 1; ++i) IDX_LOAD(i);
#pragma unroll
    for (int i = 0; i < NI; ++i) {
        if (i + RING - 1 < NI) IDX_LOAD(i + RING - 1);
        const f16x8 bh0 = kb[i % RING][0], bh1 = kb[i % RING][1];
#pragma unroll
        for (int rt = 0; rt < 2; ++rt) { f32x4 acc = {0.f, 0.f, 0.f, 0.f};
            acc = mfma16h(aqh[rt][0], bh0, acc); acc = mfma16h(aqh[rt][1], bh1, acc); acc = mfma16h(aql[rt][0], bh0, acc); acc = mfma16h(aql[rt][1], bh1, acc);
            if constexpr (PV == 5) sc[i][rt] = acc[0] + acc[1] + acc[2] + acc[3]; else
            sc[i][rt] = ((__builtin_amdgcn_fmed3f(acc[0], 0.f, wq[rt][0]) + __builtin_amdgcn_fmed3f(acc[1], 0.f, wq[rt][1])) + __builtin_amdgcn_fmed3f(acc[2], 0.f, wq[rt][2])) + __builtin_amdgcn_fmed3f(acc[3], 0.f, wq[rt][3]); }
        { const unsigned one = (i < nloc) ? 1u : 0u;
          atomicAdd(&hist[quad * IDX_NB + idx_bin(sc[i][0], inv0)], one); atomicAdd(&hist[(4 + quad) * IDX_NB + idx_bin(sc[i][1], inv1)], one); }
        __builtin_amdgcn_sched_barrier(0);
    }
#undef IDX_LOAD
    if (probe == 1 || probe >= 4) return;
    __syncthreads();
    { const v4u* hq = (const v4u*)(hist + w * IDX_NB) + lane * 8; unsigned cntv[32]; unsigned tot = 0u;
#pragma unroll
      for (int k = 0; k < 8; ++k) { const v4u v = hq[k]; cntv[4 * k] = v.x; cntv[4 * k + 1] = v.y; cntv[4 * k + 2] = v.z; cntv[4 * k + 3] = v.w; tot += (v.x + v.y) + (v.z + v.w); }
      unsigned suf = tot;
#pragma unroll
      for (int o = 1; o < 64; o <<= 1) { const unsigned t = __shfl_down(suf, o); if (lane + o < 64) suf += t; }
      unsigned run = suf - tot;
      int bj = -1; unsigned ab = 0u;
#pragma unroll
      for (int j = 31; j >= 0; --j) { const unsigned cj = cntv[j]; const bool hit = (run < (unsigned)TOPK) && (run + cj >= (unsigned)TOPK); bj = hit ? j : bj; ab = hit ? run : ab; run += cj; }
      if (bj >= 0) { bstar[w] = (unsigned)(lane * 32 + bj); above[w] = ab; } }
    __syncthreads();
    if (probe == 2) return;
    const unsigned lo_base = 4095u - (unsigned)(16 * w + l15);
    { const unsigned bs0 = bstar[quad], bs1 = bstar[4 + quad];
#pragma unroll
      for (int i = 0; i < NI; ++i) { const unsigned lo = lo_base - 128u * (unsigned)i; const bool act = (i < nloc);
          if (act && idx_bin(sc[i][0], inv0) == bs0) { const unsigned slot = atomicAdd(&candn[quad], 1u); if (slot < (unsigned)IDX_CAP) cand[quad * IDX_CAP + slot] = ((unsigned long long)okey_of(sc[i][0]) << 12) | lo; }
          if (act && idx_bin(sc[i][1], inv1) == bs1) { const unsigned slot = atomicAdd(&candn[4 + quad], 1u); if (slot < (unsigned)IDX_CAP) cand[(4 + quad) * IDX_CAP + slot] = ((unsigned long long)okey_of(sc[i][1]) << 12) | lo; } } }
    __syncthreads();
    if (probe == 7) return;
    { const unsigned L = candn[w], need = (unsigned)TOPK - above[w];
      if (L > (unsigned)IDX_CAP) { if (lane == 0) ovf[0] = 1u; }
      else if (L <= 64u) {
        const unsigned long long mine = ((unsigned)lane < L) ? cand[w * IDX_CAP + lane] : 0ull; const unsigned mlo = (unsigned)mine, mhi = (unsigned)(mine >> 32); unsigned rank = 0u;
        for (unsigned i = 0; i < L; ++i) { const unsigned long long o = ((unsigned long long)(unsigned)__builtin_amdgcn_readlane((int)mhi, (int)i) << 32) | (unsigned)__builtin_amdgcn_readlane((int)mlo, (int)i); rank += (o > mine) ? 1u : 0u; }
        const unsigned long long bal = __ballot((unsigned)lane < L && rank + 1u == need); const int src = (int)__ffsll((long long)bal) - 1;
        const unsigned klo = (unsigned)__builtin_amdgcn_readlane((int)mlo, src), khi = (unsigned)__builtin_amdgcn_readlane((int)mhi, src);
        if (lane == 0) { Tq[w] = (khi << 20) | (klo >> 12); Lq[w] = klo & 0xfffu; } }
      else { unsigned long long ck[8];
#pragma unroll
        for (int j = 0; j < 8; ++j) ck[j] = ((unsigned)(j * 64 + lane) < L) ? cand[w * IDX_CAP + j * 64 + lane] : 0ull;
        unsigned long long Kth = 0ull;
#pragma nounroll
        for (int bit = 43; bit >= 0; --bit) { const unsigned long long cv = Kth | (1ull << bit); unsigned n = 0u;
#pragma unroll
            for (int j = 0; j < 8; ++j) if ((unsigned)(j * 64) < L) n += (unsigned)__popcll(__ballot(ck[j] >= cv));
            if (n >= need) Kth = cv; }
        if (lane == 0) { Tq[w] = (unsigned)(Kth >> 12); Lq[w] = (unsigned)Kth & 0xfffu; } } }
    __syncthreads();
    if (probe == 3) return;
    unsigned T0, T1, L0, L1; float Tf0, Tf1;
    if (ovf[0] == 0u) { Tf0 = okey_to_f(Tq[quad]); Tf1 = okey_to_f(Tq[4 + quad]); L0 = Lq[quad]; L1 = Lq[4 + quad];
    } else {
#pragma unroll
        for (int i = 0; i < NI; ++i) { sc[i][0] = (i < nloc) ? __uint_as_float(okey_of(sc[i][0])) : 0.f; sc[i][1] = (i < nloc) ? __uint_as_float(okey_of(sc[i][1])) : 0.f; }
        for (int i = tid; i < IDX_ROUNDS * 8; i += NTHR) cnt[i] = 0u;
        __syncthreads();
        T0 = 0u; T1 = 0u;
#pragma nounroll
        for (int rd = 0; rd < 32; ++rd) {
            const unsigned c0v = T0 | (0x80000000u >> rd), c1v = T1 | (0x80000000u >> rd); unsigned n0 = 0u, n1 = 0u;
#pragma unroll
            for (int i = 0; i < NI; ++i) { cnt_ge(n0, __float_as_uint(sc[i][0]), c0v); cnt_ge(n1, __float_as_uint(sc[i][1]), c1v); }
#pragma unroll
            for (int o = 1; o < 16; o <<= 1) { n0 += __shfl_xor(n0, o); n1 += __shfl_xor(n1, o); }
            if (l15 == 0) { atomicAdd(&cnt[rd * 8 + quad], n0); atomicAdd(&cnt[rd * 8 + 4 + quad], n1); }
            __syncthreads();
            if (cnt[rd * 8 + quad] >= (unsigned)TOPK) T0 = c0v;
            if (cnt[rd * 8 + 4 + quad] >= (unsigned)TOPK) T1 = c1v;
        }
        { unsigned n0 = 0u, n1 = 0u;
#pragma unroll
          for (int i = 0; i < NI; ++i) { cnt_gt(n0, __float_as_uint(sc[i][0]), T0); cnt_gt(n1, __float_as_uint(sc[i][1]), T1); }
#pragma unroll
          for (int o = 1; o < 16; o <<= 1) { n0 += __shfl_xor(n0, o); n1 += __shfl_xor(n1, o); }
          if (l15 == 0) { atomicAdd(&cnt[32 * 8 + quad], n0); atomicAdd(&cnt[32 * 8 + 4 + quad], n1); }
          __syncthreads(); }
        const unsigned need0 = (unsigned)TOPK - cnt[32 * 8 + quad], need1 = (unsigned)TOPK - cnt[32 * 8 + 4 + quad];
        L0 = 0u; L1 = 0u;
#pragma nounroll
        for (int rd = 0; rd < 12; ++rd) {
            const unsigned c0v = L0 | (0x800u >> rd), c1v = L1 | (0x800u >> rd); unsigned n0 = 0u, n1 = 0u;
#pragma unroll
            for (int i = 0; i < NI; ++i) { const unsigned lo = lo_base - 128u * (unsigned)i; cnt_tie(n0, __float_as_uint(sc[i][0]), T0, lo, c0v); cnt_tie(n1, __float_as_uint(sc[i][1]), T1, lo, c1v); }
#pragma unroll
            for (int o = 1; o < 16; o <<= 1) { n0 += __shfl_xor(n0, o); n1 += __shfl_xor(n1, o); }
            if (l15 == 0) { atomicAdd(&cnt[(33 + rd) * 8 + quad], n0); atomicAdd(&cnt[(33 + rd) * 8 + 4 + quad], n1); }
            __syncthreads();
            if (cnt[(33 + rd) * 8 + quad] >= need0) L0 = c0v;
            if (cnt[(33 + rd) * 8 + 4 + quad] >= need1) L1 = c1v;
        }
        Tf0 = okey_to_f(T0); Tf1 = okey_to_f(T1);
#pragma unroll
        for (int i = 0; i < NI; ++i) { sc[i][0] = okey_to_f(__float_as_uint(sc[i][0])); sc[i][1] = okey_to_f(__float_as_uint(sc[i][1])); }
    }
#pragma unroll
    for (int i = 0; i < NI; ++i) {
        const int t = w + 8 * i; const unsigned lo = lo_base - 128u * (unsigned)i; const bool act = (i < nloc);
#pragma unroll
        for (int rt = 0; rt < 2; ++rt) { const float k = sc[i][rt], T = rt ? Tf1 : Tf0; const unsigned L = rt ? L1 : L0;
            const bool sel = (k > T) || (k == T && lo >= L);
            const unsigned long long bal = __ballot(sel);
            if (lane < 4 && act) a.mask16[(size_t)(q0 + rt * 4 + lane) * 256 + t] = (unsigned short)((bal >> (16 * lane)) & 0xffffull); }
        __builtin_amdgcn_sched_barrier(0);
    }
}
template <int PV>
__device__ __forceinline__ void indexer_unit(const IdxArgs& a, int b, int c, int g, char* ldsg, int tid, int probe) {
    if (c < 8) indexer_unit_t<4, PV>(a, b, c, g, ldsg, tid, probe); else if (c < 16) indexer_unit_t<8, PV>(a, b, c, g, ldsg, tid, probe); else if (c < 24) indexer_unit_t<12, PV>(a, b, c, g, ldsg, tid, probe); else if (c < 32) indexer_unit_t<16, PV>(a, b, c, g, ldsg, tid, probe);
    else if (c < 40) indexer_unit_t<20, PV>(a, b, c, g, ldsg, tid, probe); else if (c < 48) indexer_unit_t<24, PV>(a, b, c, g, ldsg, tid, probe); else if (c < 56) indexer_unit_t<28, PV>(a, b, c, g, ldsg, tid, probe); else indexer_unit_t<32, PV>(a, b, c, g, ldsg, tid, probe);
}

namespace att {
using s16x4  = __attribute__((ext_vector_type(4))) short;
using f32x16 = __attribute__((ext_vector_type(16))) float;
using u32x4  = __attribute__((ext_vector_type(4))) unsigned;
constexpr int D = 128, NW = 8, QBLK = 32, KVBLK = 64;
constexpr float SCALE = 0.088388347648318440f, THR = 8.f;
constexpr int SHM_V = KVBLK * D * 2, SHM_K = KVBLK * D * 2, SHM_Q0 = 2 * SHM_V + 2 * SHM_K + NW * 64 * 4, SHM_ATTN = SHM_Q0 + 256 * D * 2;
constexpr int LDK = 128, LDV = NMAIN;
#define KSWZ(row, colB) ((row) * 256 + ((colB) ^ (((row) & 7) << 4)))
#define SBAR() __builtin_amdgcn_sched_barrier(0)
__device__ __forceinline__ int crow(int r, int hi) { return (r & 3) + 8 * (r >> 2) + 4 * hi; }
__device__ __forceinline__ unsigned cvtpk(float lo, float hi) { unsigned r; asm volatile("v_cvt_pk_bf16_f32 %0, %1, %2" : "=v"(r) : "v"(lo), "v"(hi)); return r; }
__device__ __forceinline__ float mask_and(float e, unsigned m, int pos) { float r; asm("v_bfe_i32 %0, %1, %2, 1\n\tv_and_b32 %0, %0, %3" : "=&v"(r) : "v"(m), "n"(pos), "v"(e)); return r; }
__device__ __forceinline__ void partialSM(f32x16& p0, f32x16& p1, float& m_reg, float& mn, float& alpha, unsigned ml) {
  constexpr float C = SCALE * 1.4426950408889634f;
  float pmax = p0[0];
#pragma unroll
  for (int r = 1; r < 16; ++r) pmax = fmaxf(pmax, p0[r]);
#pragma unroll
  for (int r = 0; r < 16; ++r) pmax = fmaxf(pmax, p1[r]);
  { auto rr = __builtin_amdgcn_permlane32_swap(__float_as_uint(pmax), __float_as_uint(pmax), false, false);
    pmax = fmaxf(__uint_as_float(rr[0]), __uint_as_float(rr[1])); }
  if (__builtin_expect(__all(pmax - m_reg <= THR / SCALE), 1)) { mn = m_reg; alpha = 1.f; }
  else { mn = fmaxf(m_reg, pmax); alpha = __builtin_amdgcn_exp2f((m_reg - mn) * C); m_reg = mn; }
  const float mnC = -mn * C;
#pragma unroll
  for (int r = 0; r < 16; ++r) p0[r] = fmaf(p0[r], C, mnC);
#pragma unroll
  for (int r = 0; r < 16; ++r) p1[r] = fmaf(p1[r], C, mnC);
#pragma unroll
  for (int r = 0; r < 16; ++r) p0[r] = mask_and(__builtin_amdgcn_exp2f(p0[r]), ml, (r & 3) + 8 * (r >> 2));
}
__device__ __forceinline__ void finishSM(f32x16& p0, f32x16& p1, float alpha, float& l_reg, bf16x8& pa0, bf16x8& pa1, bf16x8& pa2, bf16x8& pa3, unsigned mh) {
#pragma unroll
  for (int r = 0; r < 16; ++r) p1[r] = mask_and(__builtin_amdgcn_exp2f(p1[r]), mh, (r & 3) + 8 * (r >> 2));
  float ps = 0;
#pragma unroll
  for (int r = 0; r < 16; ++r) ps += p0[r];
#pragma unroll
  for (int r = 0; r < 16; ++r) ps += p1[r];
  { auto rr = __builtin_amdgcn_permlane32_swap(__float_as_uint(ps), __float_as_uint(ps), false, false);
    ps = __uint_as_float(rr[0]) + __uint_as_float(rr[1]); }
  l_reg = l_reg * alpha + ps;
#define PK4(P, BASE, OUT) do { unsigned a0 = cvtpk(P[BASE + 0], P[BASE + 1]), a1 = cvtpk(P[BASE + 2], P[BASE + 3]);   \
    unsigned b0 = cvtpk(P[BASE + 4], P[BASE + 5]), b1 = cvtpk(P[BASE + 6], P[BASE + 7]);                              \
    auto r0 = __builtin_amdgcn_permlane32_swap(a0, b0, false, false); auto r1 = __builtin_amdgcn_permlane32_swap(a1, b1, false, false); \
    u32x4 w = {r0[0], r1[0], r0[1], r1[1]}; OUT = *reinterpret_cast<bf16x8*>(&w); } while (0)
  PK4(p0, 0, pa0); PK4(p0, 8, pa1); PK4(p1, 0, pa2); PK4(p1, 8, pa3);
#undef PK4
}
__device__ __forceinline__ void qkt(f32x16& p0, f32x16& p1, const bf16* Ks, const char* Qs, int r32, int hi) {
  p0 = f32x16{}; p1 = f32x16{};
#pragma unroll
  for (int d0 = 0; d0 < 8; ++d0) { int cb = (d0 * 16 + hi * 8) * 2;
    bf16x8 b0 = *reinterpret_cast<const bf16x8*>((const char*)Ks + KSWZ(r32, cb));
    bf16x8 b1 = *reinterpret_cast<const bf16x8*>((const char*)Ks + KSWZ(32 + r32, cb));
    bf16x8 q = *reinterpret_cast<const bf16x8*>(Qs + KSWZ(r32, cb));
    p0 = __builtin_amdgcn_mfma_f32_32x32x16_bf16(b0, q, p0, 0, 0, 0);
    p1 = __builtin_amdgcn_mfma_f32_32x32x16_bf16(b1, q, p1, 0, 0, 0); }
}
__device__ __forceinline__ int v_st(int k, int c) { const int kk = (k & ~0xC) | ((k & 4) << 1) | ((k & 8) >> 1); return ((kk >> 3) * 4 + (c >> 5)) * 512 + ((kk & 7) * 32 + (c & 31)) * 2; }
__device__ __forceinline__ int v_rd_base(int lane) { return ((lane & 3) << 3) | (((lane >> 2) & 3) << 6) | (((lane >> 4) & 1) << 5) | (((lane >> 5) & 1) << 8); }
constexpr int v_rd_off(int d0, int ks, int half) { return d0 * 512 + ks * 4096 + half * 2048; }
template <int OFF> __device__ __forceinline__ s16x4 tr_read(int vb) {
  s16x4 r; asm volatile("ds_read_b64_tr_b16 %0, %1 offset:%2" : "=&v"(r) : "v"(vb), "i"(OFF) : "memory"); return r;
}
template <int D0> __device__ __forceinline__ void pv_one(f32x16& od, int vb, bf16x8 pa0, bf16x8 pa1, bf16x8 pa2, bf16x8 pa3) {
  const s16x4 l0 = tr_read<v_rd_off(D0, 0, 0)>(vb), h0 = tr_read<v_rd_off(D0, 0, 1)>(vb), l1 = tr_read<v_rd_off(D0, 1, 0)>(vb), h1 = tr_read<v_rd_off(D0, 1, 1)>(vb);
  const s16x4 l2 = tr_read<v_rd_off(D0, 2, 0)>(vb), h2 = tr_read<v_rd_off(D0, 2, 1)>(vb), l3 = tr_read<v_rd_off(D0, 3, 0)>(vb), h3 = tr_read<v_rd_off(D0, 3, 1)>(vb);
  asm volatile("s_waitcnt lgkmcnt(0)" ::: "memory"); SBAR();
#define PK(L, H) (bf16x8){L[0], L[1], L[2], L[3], H[0], H[1], H[2], H[3]}
  od = __builtin_amdgcn_mfma_f32_32x32x16_bf16(pa0, PK(l0, h0), od, 0, 0, 0);
  od = __builtin_amdgcn_mfma_f32_32x32x16_bf16(pa1, PK(l1, h1), od, 0, 0, 0);
  od = __builtin_amdgcn_mfma_f32_32x32x16_bf16(pa2, PK(l2, h2), od, 0, 0, 0);
  od = __builtin_amdgcn_mfma_f32_32x32x16_bf16(pa3, PK(l3, h3), od, 0, 0, 0);
#undef PK
}
__device__ __forceinline__ void pv_d0(f32x16* o, int vb, bf16x8 pa0, bf16x8 pa1, bf16x8 pa2, bf16x8 pa3) {
  pv_one<0>(o[0], vb, pa0, pa1, pa2, pa3); pv_one<1>(o[1], vb, pa0, pa1, pa2, pa3); pv_one<2>(o[2], vb, pa0, pa1, pa2, pa3); pv_one<3>(o[3], vb, pa0, pa1, pa2, pa3);
}
__device__ __forceinline__ void attn_unit(const bf16* __restrict__ QR, const bf16* __restrict__ KR, const bf16* __restrict__ PMAIN, const unsigned long long* __restrict__ MASK,
                                          bf16* __restrict__ MIX, int b, int c, char* lds) {
  const int tid = threadIdx.x, wid = tid >> 6, lane = tid & 63, r32 = lane & 31, hi = lane >> 5;
  bf16* V_lds = (bf16*)lds; bf16* K_lds = (bf16*)(lds + 2 * SHM_V);
  float* ws = (float*)(lds + 2 * SHM_V + 2 * SHM_K) + wid * 64; float* li_l = ws; float* al_l = ws + 32;
  float m_reg = -1e30f, l_reg = 0; f32x16 o[4] = {};
  const char* qr = lds + SHM_Q0 + wid * (QBLK * 256);
  const int tok0 = b * SEQ + c * 64, qloc = 8 * wid + (r32 >> 2);
  const bf16* Kh = KR + (size_t)b * SEQ * LDK; const bf16* Vh = PMAIN + (size_t)b * SEQ * LDV + PM_DV;
  const char* mb = (const char*)MASK + (size_t)tok0 * 512; const unsigned moff = (unsigned)qloc * 512u; const bool allsel = (c <= 3);
  const int NTR = c + 1, NT = (NTR + 1) & ~1;
#define GETMASK(kt, ML, MH) do { unsigned long long mm_ = allsel ? ~0ull : *(const unsigned long long*)(mb + (moff + 8u * (unsigned)(kt))); if ((kt) >= NTR) mm_ = 0ull; ML = (unsigned)mm_ >> (4 * hi); MH = (unsigned)(mm_ >> 32) >> (4 * hi); } while (0)
  const int sr = tid >> 4, sc = (tid & 15) * 8, vst0 = v_st(sr, sc), vst1 = v_st(32 + sr, sc);
  const int vb0 = (int)(uintptr_t)V_lds + v_rd_base(lane);
  struct { bf16x8 vs0, vs1, ks0, ks1; } sr_[1];
const unsigned offV0 = (unsigned)(sr * LDV + sc) * 2u, offV1 = offV0 + 32u * LDV * 2u, offK0 = (unsigned)(sr * LDK + sc) * 2u, offK1 = offK0 + 32u * LDK * 2u;
#define SLOAD(i, k0) do { const char* vb_ = (const char*)Vh + (size_t)(k0) * (LDV * 2); const char* kb_ = (const char*)Kh + (size_t)(k0) * (LDK * 2); \
    sr_[i].vs0 = *(const bf16x8*)(vb_ + offV0); sr_[i].vs1 = *(const bf16x8*)(vb_ + offV1); sr_[i].ks0 = *(const bf16x8*)(kb_ + offK0); sr_[i].ks1 = *(const bf16x8*)(kb_ + offK1); } while (0)
#define SWRITE(bb, i) do { *(bf16x8*)((char*)V_lds + (bb) * SHM_V + vst0) = sr_[i].vs0;          \
    *(bf16x8*)((char*)V_lds + (bb) * SHM_V + vst1) = sr_[i].vs1; int kc = sc * 2;               \
    *(bf16x8*)((char*)K_lds + (bb) * SHM_K + KSWZ(sr, kc)) = sr_[i].ks0;                       \
    *(bf16x8*)((char*)K_lds + (bb) * SHM_K + KSWZ(32 + sr, kc)) = sr_[i].ks1; } while (0)
#define SWAIT() asm volatile("s_waitcnt vmcnt(0)" ::: "memory")
#define RESC(a) do { if (__any((a) < 1.f)) { if (hi == 0) al_l[r32] = (a); asm volatile("s_waitcnt lgkmcnt(0)" ::: "memory"); \
    _Pragma("unroll") for (int d = 0; d < 4; ++d) _Pragma("unroll") for (int r = 0; r < 16; ++r) o[d][r] *= al_l[crow(r, hi)]; } } while (0)
  f32x16 pA0, pA1, pB0, pB1; float mnA, mnB, alA, alB; bf16x8 pa0, pa1, pa2, pa3; unsigned mlA, mhA, mlB, mhB;
  constexpr int SE = 0, SO = 0;
  __syncthreads();
  { const char* qb = (const char*)QR + (size_t)tok0 * 1024; const unsigned qoff = (unsigned)(qloc * 512 + (r32 & 3) * 128 + hi * 8) * 2u;
#pragma unroll
    for (int d0 = 0; d0 < 8; ++d0) { const bf16x8 t = *reinterpret_cast<const bf16x8*>(qb + (qoff + 32u * d0)); *(bf16x8*)(const_cast<char*>(qr) + KSWZ(r32, (d0 * 16 + hi * 8) * 2)) = t; }
    asm volatile("s_waitcnt lgkmcnt(0)" ::: "memory"); }
  SLOAD(SE, 0); asm volatile("s_waitcnt vmcnt(0)" ::: "memory"); SWRITE(0, SE); __syncthreads();
  GETMASK(0, mlA, mhA);
  qkt(pA0, pA1, K_lds, qr, r32, hi); partialSM(pA0, pA1, m_reg, mnA, alA, mlA);
  SLOAD(SO, KVBLK);
  SWAIT(); SWRITE(1, SO); __syncthreads();
  for (int j = 1; j + 1 < NT; j += 2) {
    GETMASK(j, mlB, mhB);
    SBAR(); qkt(pB0, pB1, (bf16*)((char*)K_lds + SHM_K), qr, r32, hi);
    finishSM(pA0, pA1, alA, l_reg, pa0, pa1, pa2, pa3, mhA); SBAR();
    SLOAD(SO, (j + 1) * KVBLK); SBAR();
    pv_d0(o, vb0, pa0, pa1, pa2, pa3); partialSM(pB0, pB1, m_reg, mnB, alB, mlB);
    __syncthreads(); SWAIT(); SWRITE(0, SE);
    RESC(alB); __syncthreads();
    GETMASK(j + 1, mlA, mhA);
    SBAR(); qkt(pA0, pA1, K_lds, qr, r32, hi);
    finishSM(pB0, pB1, alB, l_reg, pa0, pa1, pa2, pa3, mhB); SBAR();
    SLOAD(SE, (j + 2) * KVBLK); SBAR();
    pv_d0(o, vb0 + (int)SHM_V, pa0, pa1, pa2, pa3); partialSM(pA0, pA1, m_reg, mnA, alA, mlA);
    __syncthreads(); SWAIT(); SWRITE(1, SO);
    RESC(alA); __syncthreads();
  }
  GETMASK(NT - 1, mlB, mhB);
  SBAR(); qkt(pB0, pB1, (bf16*)((char*)K_lds + SHM_K), qr, r32, hi);
  finishSM(pA0, pA1, alA, l_reg, pa0, pa1, pa2, pa3, mhA); SBAR();
  pv_d0(o, vb0, pa0, pa1, pa2, pa3); partialSM(pB0, pB1, m_reg, mnB, alB, mlB);
  __syncthreads(); RESC(alB);
  finishSM(pB0, pB1, alB, l_reg, pa0, pa1, pa2, pa3, mhB); SBAR();
  pv_d0(o, vb0 + (int)SHM_V, pa0, pa1, pa2, pa3);
  if (hi == 0) li_l[r32] = l_reg; asm volatile("s_waitcnt lgkmcnt(0)" ::: "memory");
  float rli[16];
#pragma unroll
  for (int r = 0; r < 16; ++r) rli[r] = __builtin_amdgcn_rcpf(li_l[crow(r, hi)]);
  { char* ob = (char*)MIX + (size_t)tok0 * 2048; const unsigned ooff = (unsigned)((8 * wid + hi) * 1024 + 512 + r32) * 2u;
#pragma unroll
    for (int r = 0; r < 16; ++r)
#pragma unroll
      for (int d0 = 0; d0 < 4; ++d0) *(bf16*)(ob + (size_t)((2 * (r >> 2) * 1024 + (r & 3) * 128 + d0 * 32) * 2) + ooff) = (bf16)f2bf(o[d0][r] * rli[r]); }
#undef GETMASK
#undef SLOAD
#undef SWRITE
#undef SWAIT
#undef RESC
}
}
#ifndef MK_ONE_LAUNCH
#define MK_ONE_LAUNCH 1
#endif
constexpr int NPHASE = 10;
static_assert(att::SHM_ATTN <= MISC_OFF && pg8::STAGE_BYTES <= MISC_OFF, "LDS map");
struct Args { const float* in[14]; float* out; unsigned char* ws; int ph_lo, ph_hi, li, pad; };
__global__ void __launch_bounds__(NTHR, 2) fwd_kernel(Args args) {
    extern __shared__ __attribute__((aligned(16))) unsigned char lds[];
    const int tid = threadIdx.x, lane = tid & 63, wave = __builtin_amdgcn_readfirstlane(tid >> 6), bid = blockIdx.x, G = gridDim.x;
    typedef const __attribute__((address_space(4))) Args* KArgs;
    const KArgs ka = (KArgs)__builtin_amdgcn_kernarg_segment_ptr(); (void)args;
    unsigned char* ws = ka->ws; char* ldsg = (char*)lds; LAS unsigned char* ldsl = (LAS unsigned char*)lds;
    if (tid < 64) ((LAS unsigned*)(ldsl + MISC_OFF))[tid] = 0u;
    __syncthreads();
    volatile LAS unsigned* MISC = (volatile LAS unsigned*)(ldsl + MISC_OFF);
    unsigned* ctl = (unsigned*)(ws + WS_CTL);
    const int lo = ka->ph_lo, hi = ka->ph_hi;
    XcdBarrier bar; bar.bar = ctl + CW_BAR + ka->li * XCD_BAR_WORDS; bar.x = 0; bar.st = nullptr;
    if (hi - lo > 1) bar = xcd_barrier_post(ctl + CW_BAR + ka->li * XCD_BAR_WORDS, MISC + 8);
#ifndef PROBE_REPEAT
#define PROBE_REPEAT (-1)
#endif
#ifndef PROBE_SUB
#define PROBE_SUB 0
#endif
#ifndef PH_ENABLE
#define PH_ENABLE 0x3ff
#endif
#define IN(k) (((PH_ENABLE >> (k)) & 1) && lo <= (k) && (k) < hi)
#define SEAM(k) do { if (IN(k) && IN((k) + 1)) xcd_barrier(bar); } while (0)
#define hcat ((bf16*)(ws + WS_HCAT))
#define winm ((bf16*)(ws + WS_WINM))
#define wspl ((bf16*)(ws + WS_WSPL))
#define wo ((bf16*)(ws + WS_WO))
#define w1t ((bf16*)(ws + WS_W1))
#define w2t ((bf16*)(ws + WS_W2))
#define tab128 ((f32x2*)(ws + WS_TAB128))
#define tab64 ((f32x2*)(ws + WS_TAB64))
#define pmain ((bf16*)(ws + WS_PMAIN))
#define pspl ((float*)(ws + WS_PSPL))
#define mix ((bf16*)(ws + WS_MIX))
#define oraw ((bf16*)(ws + WS_ORAW))
#define hn ((bf16*)(ws + WS_HN))
#define hid ((bf16*)(ws + WS_HID))
#define ffraw ((bf16*)(ws + WS_FFRAW))
#define ss1 ((float*)(ctl + CW_SS1))
#define ss2 ((float*)(ctl + CW_SS2))
#define GLA_ARGS GlaArgs ga{pmain, pspl, ka->in[3], ka->in[4], ka->in[5], (bf16*)(ws + WS_UT), (float*)(ws + WS_DECAY), (bf16*)(ws + WS_SIN), mix, (bf16*)(ws + WS_GQD), (bf16*)(ws + WS_GKI)}
    const int gw = bid * NWAVES + wave, NGW = G * NWAVES;
    const int sub = (PROBE_SUB != 0 && ka->li == 1) ? PROBE_SUB : 0;

    if (IN(0)) {
        P0Args a{ka->in[0], ka->in[1], ka->in[2], ka->in[8], ka->in[11], ka->in[12], hcat, winm, wspl, wo, w1t, w2t, tab128, tab64};
        p0_prologue(a, ldsg, bid, G, tid);
        SEAM(0);
    }
    if (IN(1)) {
        { pg8::Gemm g{hcat, winm, M, NMAIN, 1024, 1024, 1024, 1 << 30}; pg8::StaticOrder S; S.init(M, NMAIN, G, bid);
          pg8::EpiBf16X<0, false> E{pmain, NMAIN, nullptr};
          pg8::gemm_phase<pg8::EpiBf16X<0, false>, pg8::StaticOrder, true, true, true>(ldsl, g, S, E); }
        __syncthreads();
        { pg8::Gemm g{hcat, wspl, M, NSPLIT, KSPLIT, 1024, KSPLIT, 1 << 30}; pg8::StaticOrder S; S.init(M, NSPLIT, G, bid);
          pg8::EpiF32 E{pspl, NSPLIT};
          pg8::gemm_phase<pg8::EpiF32, pg8::StaticOrder, true, true, true>(ldsl, g, S, E); }
        SEAM(1);
    }
    if (IN(2)) {
        GLA_ARGS;
        P2Args a{pmain, pspl, tab128, tab64, ka->in[6], ka->in[7], (bf16*)(ws + WS_QR), (bf16*)(ws + WS_KR), (bf16*)(ws + WS_IKH), (bf16*)(ws + WS_IKL), (bf16*)(ws + WS_IQH), (bf16*)(ws + WS_IQL), (float*)(ws + WS_IW), (float*)(ws + WS_QB)};
        if (sub != 2) p2_post_rows(a, gw, NGW, lane);
        if (sub != 1) gla_local_phase(ga, ldsg, bid, G, tid);
        SEAM(2);
    }
    if (IN(3)) {
        GLA_ARGS;
#ifndef PROBE_IDX
#define PROBE_IDX 0
#endif
        const int probe = (PROBE_IDX != 0 && ka->li == 1) ? PROBE_IDX : 0;
        if (probe == 0) gla_scan(ga, bid, G, tid);
        float kbound; { const float lw = fabsf(ka->in[6][lane]), lb = ka->in[7][lane]; float mw = lw;
#pragma unroll
          for (int o = 1; o < 64; o <<= 1) mw = fmaxf(mw, __shfl_xor(mw, o));
          kbound = 8.0f * mw + sqrtf(wave_sum(lb * lb)); }
        IdxArgs a{(const bf16*)(ws + WS_IQH), (const bf16*)(ws + WS_IQL), (const bf16*)(ws + WS_IKH), (const bf16*)(ws + WS_IKL), (const float*)(ws + WS_IW), (unsigned short*)(ws + WS_MASK), (const float*)(ws + WS_QB), kbound};
        if (G == 256) {
            const int b = bid >> 5, g = (bid & 31) >> 2, j = bid & 3;
            for (int k = 14; k >= 0; --k) { const int r = (k < 14) ? ((k >> 1) * 8 + ((k & 1) ? 7 - j : j)) : 56 + j;
                indexer_unit<0>(a, b, 4 + r, g, ldsg, tid, probe); }
        } else {
            for (int it = bid; it < BATCH * 30 * 8; it += G) {
                const int b = it / 240, rem = it % 240, p = rem >> 3, g = rem & 7;
                indexer_unit<0>(a, b, 4 + p, g, ldsg, tid, probe); indexer_unit<0>(a, b, 63 - p, g, ldsg, tid, probe); }
        }
        SEAM(3);
    }
    if (IN(4)) {
        GLA_ARGS;
        if (sub != 2) gla_out_phase(ga, ldsg, bid, G, tid);
        if (sub != 1) for (int it = bid; it < BATCH * 32; it += G) {
            const int b = it & 7, p = it >> 3;
            for (int half = 0; half < 2; ++half)
                att::attn_unit((const bf16*)(ws + WS_QR), (const bf16*)(ws + WS_KR), pmain, (const unsigned long long*)(ws + WS_MASK), mix, b, half ? p : 63 - p, ldsg);
        }
        SEAM(4);
    }
    if (IN(5)) {
        __syncthreads();
        pg8::Gemm g{mix, wo, M, DM, 1024, 1024, 1024, 1 << 30}; pg8::StaticOrder S; S.init(M, DM, G, bid);
        pg8::EpiBf16X<0, false> E{oraw, DM, nullptr};
        pg8::gemm_phase<pg8::EpiBf16X<0, false>, pg8::StaticOrder, true, true>(ldsl, g, S, E);
        SEAM(5);
    }
    if (IN(6)) {
        p6_rows(ka->in[0], oraw, ka->in[9], ka->in[10], hn, gw, NGW, lane);
        SEAM(6);
    }
    if (IN(7)) {
        pg8::Gemm g{hn, w1t, M, DFF, 1024, 1024, 1024, 1 << 30}; pg8::StaticOrder S; S.init(M, DFF, G, bid);
        pg8::EpiBf16X<2, false> E{hid, DFF, nullptr};
        pg8::gemm_phase<pg8::EpiBf16X<2, false>, pg8::StaticOrder, true, true>(ldsl, g, S, E);
        SEAM(7);
    }
    if (IN(8)) {
        pg8::Gemm g{hid, w2t, M, DM, DFF, DFF, DFF, 1 << 30}; pg8::StaticOrder S; S.init(M, DM, G, bid);
        pg8::EpiBf16X<0, false> E{ffraw, DM, nullptr};
        pg8::gemm_phase<pg8::EpiBf16X<0, false>, pg8::StaticOrder, true, true>(ldsl, g, S, E);
        SEAM(8);
    }
    if (IN(9)) {
        p9_rows(oraw, ffraw, ka->in[13], ka->out, gw, NGW, lane);
    }
#undef IN
#undef SEAM
#undef hcat
#undef winm
#undef wspl
#undef wo
#undef w1t
#undef w2t
#undef tab128
#undef tab64
#undef pmain
#undef pspl
#undef mix
#undef oraw
#undef hn
#undef hid
#undef ffraw
#undef ss1
#undef ss2
#undef GLA_ARGS
}

extern "C" void kernel_launch(void* const* d_in, const int* in_sizes, int n_in, void* d_out, int out_size, void* d_ws, size_t ws_size, hipStream_t stream) {
    static int grid = 0;
    if (grid == 0) {
        if (n_in != 14 || in_sizes[0] != M * DM || out_size != M * DM || ws_size < WS_END) { fprintf(stderr, "kernel_launch: shape/workspace mismatch (n_in %d, in0 %d, out %d, ws %zu < %zu); nothing launched\n", n_in, n_in > 0 ? in_sizes[0] : -1, out_size, ws_size, (size_t)WS_END); grid = -1; return; }
        int dev = 0, cus = 0, per_cu = 0;
        if (hipGetDevice(&dev) != hipSuccess || hipDeviceGetAttribute(&cus, hipDeviceAttributeMultiprocessorCount, dev) != hipSuccess) { fprintf(stderr, "kernel_launch: device query failed\n"); grid = -1; return; }
        if (hipFuncSetAttribute((const void*)fwd_kernel, hipFuncAttributeMaxDynamicSharedMemorySize, LDS_BYTES) != hipSuccess) { fprintf(stderr, "kernel_launch: hipFuncSetAttribute(%d B LDS) failed\n", LDS_BYTES); grid = -1; return; }
        if (hipOccupancyMaxActiveBlocksPerMultiprocessor(&per_cu, (const void*)fwd_kernel, NTHR, LDS_BYTES) != hipSuccess || per_cu < 1) fprintf(stderr, "kernel_launch: note: occupancy query reports %d workgroups per CU\n", per_cu);
        (void)hipGetLastError();
        grid = cus;
    }
    if (grid < 0) return;
    if (hipMemsetAsync((char*)d_ws + WS_CTL, 0, CTL_ZERO_BYTES, stream) != hipSuccess) { fprintf(stderr, "kernel_launch: memset failed\n"); return; }
    Args a{};
    for (int i = 0; i < 14; ++i) a.in[i] = (const float*)d_in[i];
    a.out = (float*)d_out; a.ws = (unsigned char*)d_ws;
#if MK_ONE_LAUNCH && PROBE_REPEAT >= 0
    { const int k = PROBE_REPEAT; const int lo3[3] = {0, k, k + 1}, hi3[3] = {k + 1, k + 1, NPHASE};
      for (int li = 0; li < 3; ++li) { if (lo3[li] >= hi3[li]) continue; a.ph_lo = lo3[li]; a.ph_hi = hi3[li]; a.li = li;
          hipLaunchKernelGGL(fwd_kernel, dim3(grid), dim3(NTHR), LDS_BYTES, stream, a); } }
#elif MK_ONE_LAUNCH
    a.ph_lo = 0; a.ph_hi = NPHASE; a.li = 0;
    hipLaunchKernelGGL(fwd_kernel, dim3(grid), dim3(NTHR), LDS_BYTES, stream, a);
#else
    for (int ph = 0; ph < NPHASE; ++ph) { a.ph_lo = ph; a.ph_hi = ph + 1; a.li = ph;
        hipLaunchKernelGGL(fwd_kernel, dim3(grid), dim3(NTHR), LDS_BYTES, stream, a); }
#endif
    const hipError_t le = hipPeekAtLastError();
    if (le != hipSuccess) fprintf(stderr, "kernel_launch: launch failed: %s\n", hipGetErrorName(le));
}
```

```cpp
#include <hip/hip_runtime.h>
#include <cstdio>
#include <cstdint>
#include <cmath>
namespace pg8 {
#define PG8_LAS __attribute__((address_space(3)))
typedef unsigned short bf16_t;
typedef short bf16x8 __attribute__((ext_vector_type(8)));
typedef _Float16 f16x8_t __attribute__((ext_vector_type(8)));
typedef float f32x4 __attribute__((ext_vector_type(4)));
typedef unsigned u32x4 __attribute__((ext_vector_type(4)));
constexpr int BM = 256, BK = 64, HALF = 128, HTB = HALF * BK * 2  , STAGE_BYTES = 8 * HTB, NXCD = 8, WGM = 8;

__host__ __device__ __forceinline__ int lds_byte(int r, int c) { const int st = (r >> 4) * 2 + (c >> 5), rr = r & 15, cc = c & 31, ob = rr * 64 + cc * 2; return st * 1024 + (ob ^ (((ob >> 9) & 1) << 5)); }
__host__ __device__ __forceinline__ void stage_rc(int b, int& R, int& C) { const int st = b / 1024, sb = b % 1024, swz = sb ^ (((sb >> 9) & 1) << 5); R = (st >> 1) * 16 + swz / 64; C = (st & 1) * 32 + (swz % 64) / 2; }
__host__ __device__ __forceinline__ int perm32(int rho) { const int n = rho >> 4, i = rho & 15; return 8 * (i >> 2) + 4 * n + (i & 3); }

struct Unit { int pm, pn; };
struct Gemm { const bf16_t* A; const bf16_t* Bt; int M, N, K, lda, ldb, awrap; };

struct StaticOrder {
    int nM, nN, nwg, G, c;
    __host__ __device__ void init(int M, int N, int G_, int c_) { nM = M / BM; nN = N / BM; nwg = nM * nN; G = G_; c = c_; }
    __host__ __device__ bool next(int i, Unit& u) const {
        const long L = (long)i * G + c; if (L >= nwg) return false;
        int wgid = (int)L; { const int q = nwg / NXCD, r = nwg % NXCD, xcd = wgid % NXCD, off = wgid / NXCD; wgid = (xcd < r ? xcd * (q + 1) : r * (q + 1) + (xcd - r) * q) + off; }
        const int nig = WGM * nN, gid = wgid / nig, fm = gid * WGM, gsz = (nM - fm) < WGM ? (nM - fm) : WGM;
        u.pm = fm + ((wgid % nig) % gsz); u.pn = (wgid % nig) / gsz; return true;
    }
    __device__ __forceinline__ void a_ready(const Unit&) const {}
    __device__ __forceinline__ void done(const Unit&) const {}
};

__device__ __forceinline__ unsigned cvt_pk_bf16(float lo, float hi) { unsigned r; asm volatile("v_cvt_pk_bf16_f32 %0, %1, %2" : "=v"(r) : "v"(lo), "v"(hi)); return r; }
template <int ACT  , bool SS> struct EpiBf16X {
    static constexpr bool PERM = true, AFTER_DRAIN = false;
    bf16_t* O; int ldc; float* ss;
    __device__ __forceinline__ void operator()(const f32x4 (&acc)[2][2][4][2], const Unit& u, int wr, int wc, int fr, int fq) const {
        const int row0 = u.pm * BM + wr * 64 + fr; const int col0 = u.pn * BM + wc * 32 + 8 * fq;
#pragma unroll
        for (int ai = 0; ai < 2; ++ai)
#pragma unroll
            for (int m = 0; m < 4; ++m) { const int row = row0 + ai * HALF + m * 16; bf16_t* rowp = O + (size_t)row * ldc + col0; float s = 0.f;
#pragma unroll
                for (int bj = 0; bj < 2; ++bj) { f32x4 v0 = acc[ai][bj][m][0], v1 = acc[ai][bj][m][1];
                    if (ACT == 2) {
#pragma unroll
                        for (int e = 0; e < 4; ++e) { const float a = fmaxf(v0[e], 0.f), b = fmaxf(v1[e], 0.f); v0[e] = a * a; v1[e] = b * b; } }
                    if (SS) s += (v0[0] * v0[0] + v0[1] * v0[1]) + (v0[2] * v0[2] + v0[3] * v0[3]) + (v1[0] * v1[0] + v1[1] * v1[1]) + (v1[2] * v1[2] + v1[3] * v1[3]);
                    u32x4 w; w.x = cvt_pk_bf16(v0[0], v0[1]); w.y = cvt_pk_bf16(v0[2], v0[3]); w.z = cvt_pk_bf16(v1[0], v1[1]); w.w = cvt_pk_bf16(v1[2], v1[3]);
                    *(u32x4*)(rowp + bj * HALF) = w; }
                if (SS) { s += __shfl_xor(s, 16); s += __shfl_xor(s, 32); if (fq == 0) atomicAdd(ss + row, s); } }
    }
};
struct EpiF32 {
    static constexpr bool PERM = false, AFTER_DRAIN = false;
    float* O; int ldc;
    __device__ __forceinline__ void operator()(const f32x4 (&acc)[2][2][4][2], const Unit& u, int wr, int wc, int fr, int fq) const {
        const int row0 = u.pm * BM + wr * 64 + fr; const int col0 = u.pn * BM + wc * 32 + 4 * fq;
#pragma unroll
        for (int ai = 0; ai < 2; ++ai)
#pragma unroll
            for (int m = 0; m < 4; ++m) { float* rowp = O + (size_t)(row0 + ai * HALF + m * 16) * ldc + col0;
#pragma unroll
                for (int bj = 0; bj < 2; ++bj)
#pragma unroll
                    for (int n = 0; n < 2; ++n) *(f32x4*)(rowp + bj * HALF + n * 16) = acc[ai][bj][m][n]; }
    }
};
template <class Epi, class Sched, bool ALIGN_EPI = false, bool SP2 = false, bool F16 = false>
__device__ __forceinline__ void gemm_phase(PG8_LAS unsigned char* lds, const Gemm g, const Sched& S, const Epi& E) {
    const int tid = threadIdx.x, wid = __builtin_amdgcn_readfirstlane(tid >> 6), lane = tid & 63, wr = wid >> 2, wc = wid & 3, fr = lane & 15, fq = lane >> 4;
    const int K = g.K, nt = K / BK;
    unsigned voffA[2], voffB[2];
#pragma unroll
    for (int i = 0; i < 2; ++i) { int R, C; stage_rc(tid * 16 + i * 8192, R, C); const int Rb = Epi::PERM ? ((R & ~31) + perm32(R & 31)) : R;
        voffA[i] = (unsigned)(R * g.lda + C) * 2u; voffB[i] = (unsigned)(Rb * g.ldb + C) * 2u; }
    const size_t kstep = (size_t)(BK * 2);
    const size_t hstepA = (size_t)HALF * g.lda * 2, hstepB = (size_t)HALF * g.ldb * 2;
    const size_t tstepA = 2 * hstepA, tstepB = 2 * hstepB; const int awrap = g.awrap;
    const unsigned ldsw = (unsigned)wid * 1024u;
    const int aoff = lds_byte(wr * 64 + fr, fq * 8), boff = lds_byte(wc * 32 + fr, fq * 8);
#define PG8_SA(b, h) (((b) * 2 + (h)) * HTB)
#define PG8_SB(b, h) ((4 + (b) * 2 + (h)) * HTB)
#define PG8_STAGE(bufoff, gbase, voff) do { _Pragma("unroll") for (int _i = 0; _i < 2; ++_i) \
        __builtin_amdgcn_global_load_lds((const unsigned*)((const char*)(gbase) + (voff)[_i]), (PG8_LAS unsigned*)(lds + (bufoff) + ldsw + _i * 8192), 16, 0, 0); } while (0)
#define PG8_LDA(dst, b, h) do { _Pragma("unroll") for (int m = 0; m < 4; ++m) _Pragma("unroll") for (int k = 0; k < 2; ++k) dst[m][k] = *(const PG8_LAS bf16x8*)(lds + PG8_SA(b, h) + aoff + m * 2048 + k * 1024); } while (0)
#define PG8_LDB(dst, b, h) do { _Pragma("unroll") for (int n = 0; n < 2; ++n) _Pragma("unroll") for (int k = 0; k < 2; ++k) dst[n][k] = *(const PG8_LAS bf16x8*)(lds + PG8_SB(b, h) + boff + n * 2048 + k * 1024); } while (0)
#define PG8_MMA(ai, bj, At, Bt) do { __builtin_amdgcn_s_setprio(1); _Pragma("unroll") for (int m = 0; m < 4; ++m) _Pragma("unroll") for (int n = 0; n < 2; ++n) _Pragma("unroll") for (int k = 0; k < 2; ++k) \
        acc[ai][bj][m][n] = F16 ? __builtin_amdgcn_mfma_f32_16x16x32_f16(__builtin_bit_cast(f16x8_t, Bt[n][k]), __builtin_bit_cast(f16x8_t, At[m][k]), acc[ai][bj][m][n], 0, 0, 0) \
                                : __builtin_amdgcn_mfma_f32_16x16x32_bf16(Bt[n][k], At[m][k], acc[ai][bj][m][n], 0, 0, 0); __builtin_amdgcn_s_setprio(0); } while (0)
#define PG8_WAIT_V(n) asm volatile("s_waitcnt vmcnt(" #n ")" ::: "memory")
#define PG8_WAIT_L(n) asm volatile("s_waitcnt lgkmcnt(" #n ")" ::: "memory")
#define PG8_BAR __builtin_amdgcn_s_barrier()
#define PG8_SCHED __builtin_amdgcn_sched_barrier(0)
    Unit cur, nxt; int ui = 0;
    if (!S.next(0, cur)) return;
    f32x4 acc[2][2][4][2];
#pragma unroll
    for (int a = 0; a < 2; ++a)
#pragma unroll
        for (int b = 0; b < 2; ++b)
#pragma unroll
            for (int m = 0; m < 4; ++m)
#pragma unroll
                for (int n = 0; n < 2; ++n) acc[a][b][m][n] = (f32x4){0.f, 0.f, 0.f, 0.f};
    bf16x8 At[4][2], B0[2][2], B1[2][2];
    const char* cA = (const char*)g.A + (size_t)cur.pm * tstepA; const char* cB = (const char*)g.Bt + (size_t)cur.pn * tstepB;
    S.a_ready(cur);
    if constexpr (SP2) {
        PG8_STAGE(PG8_SB(0, 0), cB, voffB); PG8_STAGE(PG8_SB(0, 1), cB + hstepB, voffB); PG8_STAGE(PG8_SA(0, 0), cA, voffA); PG8_STAGE(PG8_SA(0, 1), cA + hstepA, voffA);
        if (wr == 1) PG8_BAR;
        PG8_WAIT_V(2); PG8_BAR;
        PG8_STAGE(PG8_SB(1, 0), cB + kstep, voffB); PG8_STAGE(PG8_SA(1, 0), cA + kstep, voffA); PG8_STAGE(PG8_SB(1, 1), cB + hstepB + kstep, voffB);
        PG8_WAIT_V(6); PG8_BAR;
    } else {
        PG8_STAGE(PG8_SB(0, 0), cB, voffB); PG8_STAGE(PG8_SA(0, 0), cA, voffA); PG8_STAGE(PG8_SB(0, 1), cB + hstepB, voffB); PG8_STAGE(PG8_SA(0, 1), cA + hstepA, voffA);
        if (wr == 1) PG8_BAR;
        PG8_WAIT_V(4); PG8_BAR;
        PG8_STAGE(PG8_SB(1, 0), cB + kstep, voffB); PG8_STAGE(PG8_SA(1, 0), cA + kstep, voffA); PG8_STAGE(PG8_SB(1, 1), cB + hstepB + kstep, voffB);
        PG8_WAIT_V(6); PG8_BAR;
    }
    for (;;) {
        const bool has_next = S.next(ui + 1, nxt);
        const char* nA = has_next ? (const char*)g.A + (size_t)nxt.pm * tstepA : cA; const char* nB = has_next ? (const char*)g.Bt + (size_t)nxt.pn * tstepB : cB;
        for (int t = 0; t < nt; t += 2) {
            const bool last = (t == nt - 2);
            const int t1 = t + 1, t2 = t + 2; const char* a1 = cA + (size_t)(t1 >= awrap ? t1 - awrap : t1) * kstep;
            const char* a2 = last ? nA : cA + (size_t)(t2 >= awrap ? t2 - awrap : t2) * kstep; const char* b2 = last ? nB : cB + (size_t)(t + 2) * kstep;
            const char* a3 = a2 + kstep; const char* b3 = b2 + kstep;
            if (last && has_next) S.a_ready(nxt);
            if constexpr (SP2) {
            PG8_LDB(B0, 0, 0); PG8_LDB(B1, 0, 1); PG8_SCHED; PG8_LDA(At, 0, 0); PG8_STAGE(PG8_SA(1, 1), a1 + hstepA, voffA);
            PG8_WAIT_V(8); PG8_WAIT_L(0); PG8_BAR; PG8_MMA(0, 0, At, B0); PG8_MMA(0, 1, At, B1); PG8_BAR; PG8_SCHED;
            PG8_LDA(At, 0, 1); PG8_STAGE(PG8_SB(0, 0), b2, voffB); PG8_STAGE(PG8_SB(0, 1), b2 + hstepB, voffB); PG8_STAGE(PG8_SA(0, 0), a2, voffA);
            PG8_WAIT_V(8); PG8_WAIT_L(0); PG8_BAR; PG8_MMA(1, 0, At, B0); PG8_MMA(1, 1, At, B1); PG8_BAR; PG8_SCHED;
            PG8_LDB(B0, 1, 0); PG8_LDB(B1, 1, 1); PG8_SCHED; PG8_LDA(At, 1, 0); PG8_STAGE(PG8_SA(0, 1), a2 + hstepA, voffA);
            PG8_WAIT_V(8); PG8_WAIT_L(0); PG8_BAR; PG8_MMA(0, 0, At, B0); PG8_MMA(0, 1, At, B1); PG8_BAR; PG8_SCHED;
            PG8_LDA(At, 1, 1); PG8_STAGE(PG8_SB(1, 0), b3, voffB); PG8_STAGE(PG8_SB(1, 1), b3 + hstepB, voffB); PG8_STAGE(PG8_SA(1, 0), a3, voffA);
            PG8_WAIT_V(8); PG8_WAIT_L(0); PG8_BAR; PG8_MMA(1, 0, At, B0); PG8_MMA(1, 1, At, B1); PG8_BAR; PG8_SCHED;
            } else {
            PG8_LDB(B0, 0, 0); PG8_SCHED; PG8_LDA(At, 0, 0); PG8_STAGE(PG8_SA(1, 1), a1 + hstepA, voffA);
            PG8_WAIT_L(8); PG8_BAR; PG8_WAIT_L(0); PG8_MMA(0, 0, At, B0); PG8_BAR; PG8_SCHED;
            PG8_LDB(B1, 0, 1); PG8_STAGE(PG8_SB(0, 0), b2, voffB);
            PG8_BAR; PG8_WAIT_L(0); PG8_MMA(0, 1, At, B1); PG8_BAR;
            PG8_LDA(At, 0, 1); PG8_STAGE(PG8_SA(0, 0), a2, voffA);
            PG8_BAR; PG8_WAIT_L(0); PG8_MMA(1, 0, At, B0); PG8_BAR; PG8_SCHED;
            PG8_STAGE(PG8_SB(0, 1), b2 + hstepB, voffB);
            PG8_WAIT_V(6); PG8_BAR; PG8_MMA(1, 1, At, B1); PG8_BAR;
            PG8_LDB(B0, 1, 0); PG8_SCHED; PG8_LDA(At, 1, 0); PG8_STAGE(PG8_SA(0, 1), a2 + hstepA, voffA);
            PG8_WAIT_L(8); PG8_BAR; PG8_WAIT_L(0); PG8_MMA(0, 0, At, B0); PG8_BAR; PG8_SCHED;
            PG8_LDB(B1, 1, 1); PG8_STAGE(PG8_SB(1, 0), b3, voffB);
            PG8_BAR; PG8_WAIT_L(0); PG8_MMA(0, 1, At, B1); PG8_BAR;
            PG8_LDA(At, 1, 1); PG8_STAGE(PG8_SA(1, 0), a3, voffA);
            PG8_BAR; PG8_WAIT_L(0); PG8_MMA(1, 0, At, B0); PG8_BAR; PG8_SCHED;
            PG8_STAGE(PG8_SB(1, 1), b3 + hstepB, voffB);
            PG8_WAIT_V(6); PG8_BAR; PG8_MMA(1, 1, At, B1); PG8_BAR;
            }
        }
        if constexpr (ALIGN_EPI) { if (wr == 0) PG8_BAR; }
        if constexpr (!Epi::AFTER_DRAIN) { E(acc, cur, wr, wc, fr, fq); S.done(cur); }
        if (!has_next) break;
#pragma unroll
        for (int a = 0; a < 2; ++a)
#pragma unroll
            for (int b = 0; b < 2; ++b)
#pragma unroll
                for (int m = 0; m < 4; ++m)
#pragma unroll
                    for (int n = 0; n < 2; ++n) acc[a][b][m][n] = (f32x4){0.f, 0.f, 0.f, 0.f};
        cur = nxt; cA = nA; cB = nB; ++ui;
        if constexpr (ALIGN_EPI) { if (wr == 1) PG8_BAR; }
    }
    PG8_WAIT_V(0);
    if constexpr (!ALIGN_EPI) { if (wr == 0) PG8_BAR; }
    PG8_BAR;
    if constexpr (Epi::AFTER_DRAIN) { E.fused(acc, cur, wr, wc, fr, fq, lds, wid, lane); S.done(cur); }
#undef PG8_SA
#undef PG8_SB
#undef PG8_STAGE
#undef PG8_LDA
#undef PG8_LDB
#undef PG8_MMA
#undef PG8_WAIT_V
#undef PG8_WAIT_L
#undef PG8_BAR
#undef PG8_SCHED
}
}
constexpr int BATCH = 8, SEQ = 4096, DM = 1024, M = BATCH * SEQ;
constexpr int D_IN = 2644, NMAIN = 2304, NSPLIT = 512, KSPLIT = 1024, DFF = 4096;
constexpr int PM_GQ = 0, PM_GK = 256, PM_GV = 512, PM_GR = 1024, PM_DQ = 1536, PM_DK = 2048, PM_DV = 2176;
constexpr int PS_IQ = 0, PS_IK = 256, PS_IW = 320, PS_GLR = 324;
constexpr float EPS = 1e-6f;
constexpr int NWAVES = 8, NTHR = 512;
constexpr int NUNIT_GLA = BATCH * 4 * 64;
constexpr int TOPK = 256;

constexpr size_t MiB = 1u << 20;
constexpr size_t WS_CTL = 0, CTL_ZERO_BYTES = 1 * MiB;
constexpr int CW_BAR = 4096, CW_SS1 = 65536, CW_SS2 = 98304;
constexpr size_t WS_IW = 1 * MiB, WS_DECAY = 1 * MiB + 512 * 1024;
constexpr size_t WS_WINM = 2 * MiB, WS_WSPL = 7 * MiB, WS_WO = 10 * MiB, WS_W1 = 12 * MiB, WS_W2 = 20 * MiB;
constexpr size_t WS_TAB128 = 28 * MiB, WS_TAB64 = 30 * MiB, WS_QB = 31 * MiB;
constexpr size_t WS_HCAT = 32 * MiB;
constexpr size_t WS_QR = 32 * MiB, WS_KR = 64 * MiB, WS_IKH = 72 * MiB, WS_IKL = 76 * MiB, WS_IQH = 80 * MiB, WS_IQL = 96 * MiB, WS_MASK = 112 * MiB, WS_SIN = 128 * MiB;
constexpr size_t WS_PMAIN = 160 * MiB, WS_PSPL = 304 * MiB, WS_UT = 368 * MiB, WS_GQD = 400 * MiB, WS_GKI = 416 * MiB, WS_MIX = 432 * MiB;
constexpr size_t WS_ORAW = 160 * MiB, WS_HN = 32 * MiB, WS_HID = 256 * MiB, WS_FFRAW = 96 * MiB;
constexpr size_t WS_END = 512 * MiB;
constexpr int RING_BYTES = 131072, LDS_BYTES = 147456, MISC_OFF = LDS_BYTES - 256;

#define LAS __attribute__((address_space(3)))
typedef unsigned short bf16;
typedef unsigned v4u __attribute__((ext_vector_type(4)));
typedef unsigned v2u __attribute__((ext_vector_type(2)));
typedef float f32x4 __attribute__((ext_vector_type(4)));
typedef float f32x2 __attribute__((ext_vector_type(2)));
typedef short bf16x8 __attribute__((ext_vector_type(8)));
#define LDS_WAIT() asm volatile("s_waitcnt lgkmcnt(0)" ::: "memory")
__device__ __forceinline__ unsigned f2bf(float f) { unsigned u = __float_as_uint(f); return (u + 0x7fffu + ((u >> 16) & 1u)) >> 16; }
__device__ __forceinline__ float bf2f(unsigned h) { return __uint_as_float(h << 16); }
__device__ __forceinline__ unsigned pk2(float lo, float hi) { return f2bf(lo) | (f2bf(hi) << 16); }
__device__ __forceinline__ float wave_sum(float v) {
#pragma unroll
    for (int o = 1; o < 64; o <<= 1) v += __shfl_xor(v, o);
    return v;
}
__device__ __forceinline__ f32x4 mfma16(bf16x8 a, bf16x8 b, f32x4 c) { return __builtin_amdgcn_mfma_f32_16x16x32_bf16(a, b, c, 0, 0, 0); }
#define XB_TMO      128
#define XB_XCNT(j)  (256  + 64 * (j))
#define XB_XSUB(j)  (1280 + 64 * (j))
#define XB_XGEN(j)  (2304 + 64 * (j))
#define XB_TOP      3328
#define XB_TOPGEN   3392
#define XCD_BAR_WORDS 3456
#define XB_SPIN_CAP (1u << 18)

__device__ __forceinline__ unsigned xb_ld(unsigned* p)              { return __hip_atomic_load(p, __ATOMIC_RELAXED, __HIP_MEMORY_SCOPE_AGENT); }
__device__ __forceinline__ unsigned xb_add(unsigned* p, unsigned v) { return __hip_atomic_fetch_add(p, v, __ATOMIC_RELAXED, __HIP_MEMORY_SCOPE_AGENT); }
__device__ __forceinline__ unsigned xb_xcc_id() { return (unsigned)__builtin_amdgcn_s_getreg((3 << 11) | 20) & 0xFu; }
#define XB_SPIN(cond, bar) do { unsigned _sp = 0; while (cond) { __builtin_amdgcn_s_sleep(1); \
    if ((++_sp & 255u) == 0u) { if (xb_ld(&(bar)[XB_TMO])) break; if (_sp > XB_SPIN_CAP) { atomicAdd(&(bar)[XB_TMO], 1u); break; } } } } while (0)

struct XcdBarrier {
    unsigned* bar; unsigned x;
    volatile LAS unsigned* st;
};

__device__ __forceinline__ XcdBarrier xcd_barrier_post(unsigned* bar, volatile LAS unsigned* st) {
    XcdBarrier b; b.bar = bar; b.x = xb_xcc_id(); b.st = st;
    if (threadIdx.x == 0) (void)xb_add(&bar[XB_XCNT(b.x)], 1u);
    return b;
}
__device__ __forceinline__ void xcd_barrier_complete(unsigned* bar, unsigned x, unsigned& nloc, unsigned& nx) {
    const unsigned G = gridDim.x * gridDim.y * gridDim.z;
    unsigned sum, cnt, mine, sp = 0u;
    for (;;) {
        sum = 0u; cnt = 0u; mine = 0u;
#pragma unroll
        for (unsigned j = 0; j < 16; ++j) { const unsigned c = xb_ld(&bar[XB_XCNT(j)]); sum += c; cnt += (c > 0u) ? 1u : 0u; mine = (j == x) ? c : mine; }
        if (sum == G) break;
        __builtin_amdgcn_s_sleep(1);
        if ((++sp & 255u) == 0u) { if (xb_ld(&bar[XB_TMO])) break; if (sp > XB_SPIN_CAP) { atomicAdd(&bar[XB_TMO], 1u); break; } }
    }
    nloc = mine > 0u ? mine : 1u; nx = cnt > 0u ? cnt : 1u;
}

__device__ __forceinline__ void xcd_barrier(const XcdBarrier& b) {
    asm volatile("s_waitcnt vmcnt(0)" ::: "memory");
    __syncthreads();
    if (threadIdx.x == 0) {
        unsigned* bar = b.bar;
        __builtin_amdgcn_s_waitcnt(0);
        unsigned nloc = b.st[0], nx = b.st[1];
        if (nloc == 0u) { xcd_barrier_complete(bar, b.x, nloc, nx); b.st[0] = nloc; b.st[1] = nx; }
        const unsigned old = xb_add(&bar[XB_XSUB(b.x)], 1u);
        const unsigned gen = old / nloc;
        if (old + 1u == (gen + 1u) * nloc) {
            __builtin_amdgcn_fence(__ATOMIC_RELEASE, "agent");
            asm volatile("s_waitcnt vmcnt(0)" ::: "memory");
            const unsigned og = xb_add(&bar[XB_TOP], 1u);
            const unsigned tg = og / nx;
            if (og + 1u == (tg + 1u) * nx) xb_add(&bar[XB_TOPGEN], 1u);
            else XB_SPIN(xb_ld(&bar[XB_TOPGEN]) == tg, bar);
            __builtin_amdgcn_fence(__ATOMIC_ACQUIRE, "agent");
            xb_add(&bar[XB_XGEN(b.x)], 1u);
            asm volatile("s_waitcnt vmcnt(0)" ::: "memory");
        } else {
            XB_SPIN(xb_ld(&bar[XB_XGEN(b.x)]) == gen, bar);
            __builtin_amdgcn_fence(__ATOMIC_ACQUIRE, "agent");
            asm volatile("s_waitcnt vmcnt(0)" ::: "memory");
        }
    }
    __syncthreads();
}

__device__ __forceinline__ unsigned short f16bits(_Float16 h) { return __builtin_bit_cast(unsigned short, h); }
__device__ __forceinline__ unsigned pkh2(float lo, float hi) { return (unsigned)f16bits((_Float16)lo) | ((unsigned)f16bits((_Float16)hi) << 16); }
__device__ __forceinline__ float h2f(unsigned bits16) { return (float)__builtin_bit_cast(_Float16, (unsigned short)bits16); }
__device__ __forceinline__ int win_src_main(int j) { return j < 1024 ? j : j + 16; }
__device__ __forceinline__ int win_src_split(int j) { return j < 256 ? 2320 + j : (j < 320 ? 2576 + (j - 256) : (j < 324 ? 2640 + (j - 320) : (j < 340 ? 1024 + (j - 324) : -1))); }
template <int MODE>
__device__ __forceinline__ void p0_transpose_item(const float* W, int ldw, bf16* WT, int ldo, float* scr, int item, int nblk, int lane) {
    const int kb = item / nblk, nb = item % nblk, k0 = 64 * kb, n0 = 32 * nb;
    const int n = n0 + (lane & 31);
    const int sc = MODE == 0 ? n : (MODE == 1 ? win_src_main(n) : win_src_split(n));
    float wv[32];
#pragma unroll
    for (int i = 0; i < 32; ++i) { const int kk = 2 * i + (lane >> 5); wv[i] = sc >= 0 ? W[(size_t)(k0 + kk) * ldw + sc] : 0.f; }
#pragma unroll
    for (int i = 0; i < 32; ++i) { const int kk = 2 * i + (lane >> 5); scr[kk * 33 + (lane & 31)] = wv[i]; }
    LDS_WAIT();
    const int c = lane & 7;
#pragma unroll
    for (int j = 0; j < 4; ++j) { const int nn = (lane >> 3) + 8 * j; const float* s = scr + (8 * c) * 33 + nn;
        const float v0 = s[0 * 33], v1 = s[1 * 33], v2 = s[2 * 33], v3 = s[3 * 33], v4 = s[4 * 33], v5 = s[5 * 33], v6 = s[6 * 33], v7 = s[7 * 33];
        v4u o; if (MODE == 0) { o.x = pk2(v0, v1); o.y = pk2(v2, v3); o.z = pk2(v4, v5); o.w = pk2(v6, v7); } else { o.x = pkh2(v0, v1); o.y = pkh2(v2, v3); o.z = pkh2(v4, v5); o.w = pkh2(v6, v7); }
        bf16* dst = WT + (size_t)(n0 + nn) * ldo + k0 + 8 * c;
        *(v4u*)dst = o;
        }
    LDS_WAIT();
}
__device__ __forceinline__ void p0_rms_finish(const f32x4 (&v)[4], const float* w, bf16* orow, int lane) {
    const f32x4* wr = (const f32x4*)w + lane; float s = 0.f;
#pragma unroll
    for (int j = 0; j < 4; ++j) s += (v[j].x * v[j].x + v[j].y * v[j].y) + (v[j].z * v[j].z + v[j].w * v[j].w);
    const float r = 1.0f / sqrtf(wave_sum(s) * (1.f / DM) + EPS);
    unsigned long long* oh = (unsigned long long*)orow + lane;
#pragma unroll
    for (int j = 0; j < 4; ++j) { const f32x4 y = (v[j] * r) * wr[64 * j];
        const unsigned h0 = pkh2(y.x, y.y), h1 = pkh2(y.z, y.w);
        oh[64 * j] = (unsigned long long)h0 | ((unsigned long long)h1 << 32); }
}
__device__ __forceinline__ void p0_rms_rows(const float* x, const float* w, bf16* hcat, int gw, int NGW, int lane) {
    if (gw >= M) return;
    f32x4 cur[4], nxt[4];
#pragma unroll
    for (int j = 0; j < 4; ++j) cur[j] = __builtin_nontemporal_load((const f32x4*)(x + (size_t)gw * DM) + lane + 64 * j);
    for (int m = gw; m < M; m += NGW) { const int mn = (m + NGW < M) ? m + NGW : m;
#pragma unroll
        for (int j = 0; j < 4; ++j) nxt[j] = __builtin_nontemporal_load((const f32x4*)(x + (size_t)mn * DM) + lane + 64 * j);
        p0_rms_finish(cur, w, hcat + (size_t)m * 1024, lane);
#pragma unroll
        for (int j = 0; j < 4; ++j) cur[j] = nxt[j]; }
}
__device__ __forceinline__ void sincos_f64(double a, double& sn, double& cs) {
    const double kd = rint(a * 0.63661977236758134308);
    const double r = (a - kd * 1.57079632673412561417e+00) - kd * 6.07710050650619224932e-11;
    const double z = r * r;
    const double ps = 8.33333333332248946124e-03 + z * (-1.98412698298579493134e-04 + z * (2.75573137070700676789e-06 + z * (-2.50507602534068634195e-08 + z * 1.58969099521155010221e-10)));
    const double s = r + (z * r) * (-1.66666666666666324348e-01 + z * ps);
    const double pc = z * (4.16666666666666019037e-02 + z * (-1.38888888888741095749e-03 + z * (2.48015872894767294178e-05 + z * (-2.75573143513906633035e-07 + z * (2.08757232129817482790e-09 + z * -1.13596475577881948265e-11)))));
    const double c = 1.0 - (0.5 * z - z * pc);
    const int q = ((int)kd) & 3;
    sn = (q == 0) ? s : (q == 1) ? c : (q == 2) ? -s : -c;
    cs = (q == 0) ? c : (q == 1) ? -s : (q == 2) ? -c : s;
}
struct P0Args { const float *x, *nw, *w_in, *w_out, *w1, *w2; bf16 *hcat, *winm, *wspl, *wo, *w1t, *w2t; f32x2 *tab128, *tab64; };
__device__ __forceinline__ void p0_prologue(const P0Args& a, char* ldsg, int bid, int G, int tid) {
    const int lane = tid & 63, wave = tid >> 6;
    float* scr = (float*)(ldsg + wave * 16384);
    const int gw = bid * NWAVES + wave, NGW = G * NWAVES;
    constexpr int I_M = 16 * (NMAIN / 32), I_S = 16 * (NSPLIT / 32), I_O = 16 * (DM / 32), I_1 = 16 * (DFF / 32), I_2 = 64 * (DM / 32);
    for (int it = gw; it < I_M + I_S + I_O + I_1 + I_2; it += NGW) {
        int r = it;
        if (r < I_M) { p0_transpose_item<1>(a.w_in, D_IN, a.winm, 1024, scr, r, NMAIN / 32, lane); continue; } r -= I_M;
        if (r < I_S) { p0_transpose_item<2>(a.w_in, D_IN, a.wspl, KSPLIT, scr, r, NSPLIT / 32, lane); continue; } r -= I_S;
        if (r < I_O) { p0_transpose_item<0>(a.w_out, DM, a.wo, 1024, scr, r, DM / 32, lane); continue; } r -= I_O;
        if (r < I_1) { p0_transpose_item<0>(a.w1, DFF, a.w1t, 1024, scr, r, DFF / 32, lane); continue; } r -= I_1;
        p0_transpose_item<0>(a.w2, DM, a.w2t, DFF, scr, r, DM / 32, lane);
    }
    p0_rms_rows(a.x, a.nw, a.hcat, gw, NGW, lane);
    for (int e = bid * NTHR + tid; e < SEQ * 96; e += G * NTHR) {
        const int s = e / 96, j = e % 96; const bool big = j < 64; const int i = big ? j : j - 64;
        const double base = big ? 0.8659643233600653 : 0.7498942093324558;
        double p = 1.0; for (int k = 0; k < i; ++k) p *= base;
        const double ang = (double)s * (double)(float)p; double sn, cs; sincos_f64(ang, sn, cs);
        const f32x2 o = {(float)cs, (float)sn};
        if (big) a.tab128[s * 64 + i] = o; else a.tab64[s * 32 + i] = o;
    }
}

struct P2Args { const bf16* pmain; const float* pspl; const f32x2 *tab128, *tab64; const float *lnw, *lnb; bf16 *qr, *kr, *ikh, *ikl, *iqh, *iql; float* iw; float* qb; };
struct P2In { unsigned short k1, k2; float iq1[2], iq2[2], iwr[2], ik, iw4; f32x2 cs, c2; };
__device__ __forceinline__ void p2_load(P2In& r, const P2Args& a, int m, int lane) {
    const int s = m & (SEQ - 1);
    const bf16* pm = a.pmain + (size_t)m * NMAIN; const float* ps = a.pspl + (size_t)m * NSPLIT;
    r.cs = a.tab128[s * 64 + lane]; r.c2 = a.tab64[s * 32 + (lane & 31)];
    r.k1 = pm[PM_DK + lane]; r.k2 = pm[PM_DK + 64 + lane];
#pragma unroll
    for (int e = 0; e < 2; ++e) { const int h = 2 * e + (lane >> 5), i = lane & 31; r.iq1[e] = ps[PS_IQ + h * 64 + i]; r.iq2[e] = ps[PS_IQ + h * 64 + 32 + i]; r.iwr[e] = ps[PS_IW + h]; }
    r.ik = ps[PS_IK + lane]; r.iw4 = ps[PS_IW + (lane & 3)];
}
__device__ __forceinline__ void p2_post_row(const P2In& r, const P2Args& a, int m, int lane) {
    const int s = m & (SEQ - 1);
    const f32x2 cs = r.cs;
    { const float x1 = bf2f(r.k1), x2 = bf2f(r.k2);
      a.kr[(size_t)m * 128 + lane] = (bf16)f2bf(x1 * cs.x - x2 * cs.y); a.kr[(size_t)m * 128 + 64 + lane] = (bf16)f2bf(x2 * cs.x + x1 * cs.y); }
    const f32x2 c2 = r.c2;
    float qn = 0.f;
#pragma unroll
    for (int e = 0; e < 2; ++e) { const int h = 2 * e + (lane >> 5), i = lane & 31;
      const float x1 = r.iq1[e], x2 = r.iq2[e];
      const float wr = r.iwr[e];
      const float o1 = (x1 * c2.x - x2 * c2.y) * wr, o2 = (x2 * c2.x + x1 * c2.y) * wr;
      float sq = o1 * o1 + o2 * o2;
#pragma unroll
      for (int o = 1; o < 32; o <<= 1) sq += __shfl_xor(sq, o);
      qn += sqrtf(sq);
      const _Float16 h1 = (_Float16)o1, h2 = (_Float16)o2; const size_t p = ((size_t)m * 4 + h) * 64 + i;
      a.iqh[p] = f16bits(h1); a.iqh[p + 32] = f16bits(h2); a.iql[p] = f16bits((_Float16)(o1 - (float)h1)); a.iql[p + 32] = f16bits((_Float16)(o2 - (float)h2)); }
    qn += __shfl_xor(qn, 32);
    if (lane == 0) a.qb[m] = qn;
    { const float v = r.ik; const float mu = wave_sum(v) * (1.f / 64.f); const float d = v - mu; const float var = wave_sum(d * d) * (1.f / 64.f);
      const float y = d * (1.0f / sqrtf(var + EPS)) * a.lnw[lane] + a.lnb[lane];
      const float other = __shfl_xor(y, 32);
      const float o = lane < 32 ? (y * c2.x - other * c2.y) : (y * c2.x + other * c2.y);
      const size_t p = (size_t)(m >> 12) * (SEQ * 64) + (size_t)(s >> 4) * 1024 + (lane >> 5) * 512 + ((((lane & 31) >> 3) * 16 + (s & 15)) * 8) + (lane & 7);
      a.ikh[p] = f16bits((_Float16)o); }
    if (lane < 4) a.iw[(size_t)m * 4 + lane] = (r.iw4 < 0.f) ? -__builtin_inff() : __builtin_inff();
}
__device__ __forceinline__ void p2_post_rows(const P2Args& a, int gw, int NGW, int lane) {
    if (gw >= M) return;
    P2In cur, nxt; p2_load(cur, a, gw, lane);
    for (int m = gw; m < M; m += NGW) { const int mn = (m + NGW < M) ? m + NGW : m;
        p2_load(nxt, a, mn, lane); p2_post_row(cur, a, m, lane); cur = nxt; }
}

constexpr int GLA_LD = 72;
struct GlaArgs { const bf16* pmain; const float* pspl; const float *gw2, *gb, *gnw; bf16* ut; float* decay; bf16* sin_; bf16* mix; bf16* gqd; bf16* gki; };
struct GlaPre { f32x2 glr, w2; float gbv; v4u k, q, v0, v1; };
template <bool WITH_Q>
__device__ __forceinline__ void gla_prefetch(GlaPre& p, const GlaArgs& a, int u, int tid) {
    const int b = u >> 8, h = (u >> 6) & 3, n = u & 63, m0 = b * SEQ + n * 64;
    { const int i = 2 * tid, t = i >> 4, j = i & 15; p.glr = *(const f32x2*)(a.pspl + (size_t)(m0 + t) * NSPLIT + PS_GLR + j); }
    { const int i = 2 * tid, j = i >> 6, d = i & 63; p.w2 = *(const f32x2*)(a.gw2 + j * 256 + h * 64 + d); }
    p.gbv = a.gb[h * 64 + (tid & 63)];
    const bf16* row = a.pmain + (size_t)(m0 + (tid >> 3)) * NMAIN;
    p.k = *(const v4u*)(row + PM_GK + h * 64 + 8 * (tid & 7));
    if (WITH_Q) p.q = *(const v4u*)(row + PM_GQ + h * 64 + 8 * (tid & 7));
    p.v0 = *(const v4u*)(row + PM_GV + h * 128 + 8 * (tid & 7)); p.v1 = *(const v4u*)(row + PM_GV + h * 128 + 64 + 8 * (tid & 7));
}
constexpr int GS_LD = 65;
__device__ __forceinline__ void gla_bcum(const GlaPre& p, float* Gs, float* glr, float* w2s, float* gbs, int tid) {
    *(f32x2*)(glr + 2 * tid) = p.glr; *(f32x2*)(w2s + 2 * tid) = p.w2; if (tid < 64) gbs[tid] = p.gbv;
    __syncthreads();
    { const int d = tid & 63; float wc[16];
#pragma unroll
      for (int j = 0; j < 16; ++j) wc[j] = w2s[j * 64 + d];
      const float bias = gbs[d];
#pragma unroll
      for (int e = 0; e < 8; ++e) { const int t = (tid >> 6) + 8 * e; const f32x4* g4 = (const f32x4*)(glr + t * 16); float z = 0.f;
#pragma unroll
          for (int j4 = 0; j4 < 4; ++j4) { const f32x4 gv = g4[j4]; z += gv.x * wc[4 * j4]; z += gv.y * wc[4 * j4 + 1]; z += gv.z * wc[4 * j4 + 2]; z += gv.w * wc[4 * j4 + 3]; }
          z += bias;
          Gs[t * GS_LD + d] = (fminf(z, 0.f) - __logf(1.f + __expf(-fabsf(z)))) * (1.f / 16.f); } }
    __syncthreads();
    if (tid < 64) { float c[64];
#pragma unroll
        for (int t = 0; t < 64; ++t) c[t] = Gs[t * GS_LD + tid];
#pragma unroll
        for (int t = 1; t < 64; ++t) c[t] += c[t - 1];
#pragma unroll
        for (int t = 0; t < 64; ++t) Gs[t * GS_LD + tid] = c[t]; }
    __syncthreads();
}
__device__ __forceinline__ float bfl(unsigned w) { return __uint_as_float(w << 16); }
__device__ __forceinline__ float bfh(unsigned w) { return __uint_as_float(w & 0xffff0000u); }
__device__ __forceinline__ void gla_local_phase(const GlaArgs& a, char* ldsg, int bid, int G, int tid) {
    const int lane = tid & 63, w = tid >> 6, quad = lane >> 4, l15 = lane & 15;
    float* Gs = (float*)ldsg; float* glr = Gs + 64 * GS_LD + 32; float* w2s = glr + 1024; float* gbs = w2s + 1024; bf16* kT = (bf16*)(gbs + 64); bf16* vT = kT + 64 * GLA_LD;
    if (bid >= NUNIT_GLA) return;
    GlaPre cur, nxt; gla_prefetch<true>(cur, a, bid, tid);
    for (int u = bid; u < NUNIT_GLA; u += G) {
        const int un = (u + G < NUNIT_GLA) ? u + G : u; gla_prefetch<true>(nxt, a, un, tid);
        __syncthreads();
        gla_bcum(cur, Gs, glr, w2s, gbs, tid);
        { const int t = tid >> 3, d0 = 8 * (tid & 7); const unsigned kw[4] = {cur.k.x, cur.k.y, cur.k.z, cur.k.w}, qw[4] = {cur.q.x, cur.q.y, cur.q.z, cur.q.w}; unsigned qo[4], ko[4]; const unsigned v0w[4] = {cur.v0.x, cur.v0.y, cur.v0.z, cur.v0.w}, v1w[4] = {cur.v1.x, cur.v1.y, cur.v1.z, cur.v1.w};
#pragma unroll
          for (int e = 0; e < 4; ++e) { const int d = d0 + 2 * e; const float g0 = Gs[t * GS_LD + d], g1 = Gs[t * GS_LD + d + 1];
              qo[e] = pk2(bfl(qw[e]) * 0.125f * __expf(g0), bfh(qw[e]) * 0.125f * __expf(g1)); ko[e] = pk2(bfl(kw[e]) * __expf(-g0), bfh(kw[e]) * __expf(-g1));
              kT[d * GLA_LD + t] = (bf16)f2bf(bfl(kw[e]) * __expf(Gs[63 * GS_LD + d] - Gs[t * GS_LD + d])); kT[(d + 1) * GLA_LD + t] = (bf16)f2bf(bfh(kw[e]) * __expf(Gs[63 * GS_LD + d + 1] - Gs[t * GS_LD + d + 1]));
              vT[d * GLA_LD + t] = (bf16)(v0w[e] & 0xffffu); vT[(d + 1) * GLA_LD + t] = (bf16)(v0w[e] >> 16);
              vT[(64 + d) * GLA_LD + t] = (bf16)(v1w[e] & 0xffffu); vT[(64 + d + 1) * GLA_LD + t] = (bf16)(v1w[e] >> 16); }
          *(v4u*)(a.gqd + (size_t)u * 4096 + t * 64 + d0) = (v4u){qo[0], qo[1], qo[2], qo[3]}; *(v4u*)(a.gki + (size_t)u * 4096 + t * 64 + d0) = (v4u){ko[0], ko[1], ko[2], ko[3]}; }
        if (tid < 64) a.decay[(size_t)u * 64 + tid] = __expf(Gs[63 * GS_LD + tid]);
        __syncthreads();
        f32x4 acc[4];
#pragma unroll
        for (int dt = 0; dt < 4; ++dt) acc[dt] = (f32x4){0.f, 0.f, 0.f, 0.f};
#pragma unroll
        for (int ks = 0; ks < 2; ++ks) { const bf16x8 af = *(const bf16x8*)(vT + (16 * w + l15) * GLA_LD + ks * 32 + 8 * quad);
#pragma unroll
            for (int dt = 0; dt < 4; ++dt) { const bf16x8 bfr = *(const bf16x8*)(kT + (16 * dt + l15) * GLA_LD + ks * 32 + 8 * quad); acc[dt] = mfma16(af, bfr, acc[dt]); } }
        bf16* uo = a.ut + (size_t)u * 8192;
#pragma unroll
        for (int dt = 0; dt < 4; ++dt)
#pragma unroll
            for (int r = 0; r < 4; ++r) uo[(16 * w + 4 * quad + r) * 64 + 16 * dt + l15] = (bf16)f2bf(acc[dt][r]);
        cur = nxt;
    }
}
__device__ __forceinline__ void gla_scan(const GlaArgs& a, int bid, int G, int tid) {
    for (int idx = bid * NTHR + tid; idx < 32 * 4096; idx += G * NTHR) {
        const int bh = idx >> 12, e = idx & 4095, d = e & 63; float s0 = 0.f, s1 = 0.f;
        const bf16* up = a.ut + (size_t)bh * 64 * 8192 + e; const float* dp = a.decay + (size_t)bh * 64 * 64 + d; bf16* sp = a.sin_ + (size_t)bh * 64 * 8192 + e;
#pragma nounroll
        for (int n0 = 0; n0 < 64; n0 += 8) {
            float u0[8], u1[8], dc[8];
#pragma unroll
            for (int k = 0; k < 8; ++k) { u0[k] = bf2f(up[(size_t)(n0 + k) * 8192]); u1[k] = bf2f(up[(size_t)(n0 + k) * 8192 + 4096]); dc[k] = dp[(n0 + k) * 64]; }
#pragma unroll
            for (int k = 0; k < 8; ++k) { sp[(size_t)(n0 + k) * 8192] = (bf16)f2bf(s0); sp[(size_t)(n0 + k) * 8192 + 4096] = (bf16)f2bf(s1); s0 = dc[k] * s0 + u0[k]; s1 = dc[k] * s1 + u1[k]; }
        }
    }
}
struct GlaPreO { v4u qd, ki, v0, v1; bf16x8 sfr[2][4]; };
__device__ __forceinline__ void gla_prefetch_o(GlaPreO& p, const GlaArgs& a, int u, int tid) {
    const int b = u >> 8, h = (u >> 6) & 3, n = u & 63, m0 = b * SEQ + n * 64, t = tid >> 3, d0 = 8 * (tid & 7);
    p.qd = *(const v4u*)(a.gqd + (size_t)u * 4096 + t * 64 + d0); p.ki = *(const v4u*)(a.gki + (size_t)u * 4096 + t * 64 + d0);
    const bf16* row = a.pmain + (size_t)(m0 + t) * NMAIN + PM_GV + h * 128;
    p.v0 = *(const v4u*)(row + d0); p.v1 = *(const v4u*)(row + 64 + d0);
    { const int lane = tid & 63, ch = tid >> 8, quad = lane >> 4, l15 = lane & 15; const bf16* Sg = a.sin_ + (size_t)u * 8192;
#pragma unroll
      for (int ks = 0; ks < 2; ++ks)
#pragma unroll
        for (int vt = 0; vt < 4; ++vt) p.sfr[ks][vt] = *(const bf16x8*)(Sg + (16 * (4 * ch + vt) + l15) * 64 + ks * 32 + 8 * quad); }
}
__device__ __forceinline__ void gla_out_phase(const GlaArgs& a, char* ldsg, int bid, int G, int tid) {
    const int lane = tid & 63, w = tid >> 6, quad = lane >> 4, l15 = lane & 15;
    bf16* Qd = (bf16*)ldsg; bf16* Ki = Qd + 64 * GLA_LD; bf16* vT = Ki + 64 * GLA_LD; bf16* At = vT + 128 * GLA_LD;
    float* part = (float*)(At + 64 * GLA_LD);
    if (bid >= NUNIT_GLA) return;
    const int rt = w & 3, ch = w >> 2;
    GlaPreO cur, nxt; gla_prefetch_o(cur, a, bid, tid);
    for (int u = bid; u < NUNIT_GLA; u += G) {
        const int b = u >> 8, h = (u >> 6) & 3, n = u & 63, m0 = b * SEQ + n * 64;
        const int un = (u + G < NUNIT_GLA) ? u + G : u; gla_prefetch_o(nxt, a, un, tid);
        unsigned short rg[4][4];
        {
#pragma unroll
          for (int r = 0; r < 4; ++r)
#pragma unroll
            for (int vt = 0; vt < 4; ++vt) rg[r][vt] = a.pmain[(size_t)(m0 + 16 * rt + 4 * quad + r) * NMAIN + PM_GR + h * 128 + 16 * (4 * ch + vt) + l15]; }
        __syncthreads();
        { const int t = tid >> 3, d0 = 8 * (tid & 7);
          const unsigned v0w[4] = {cur.v0.x, cur.v0.y, cur.v0.z, cur.v0.w}, v1w[4] = {cur.v1.x, cur.v1.y, cur.v1.z, cur.v1.w};
#pragma unroll
          for (int e = 0; e < 4; ++e) { const int d = d0 + 2 * e;
              vT[d * GLA_LD + t] = (bf16)(v0w[e] & 0xffffu); vT[(d + 1) * GLA_LD + t] = (bf16)(v0w[e] >> 16);
              vT[(64 + d) * GLA_LD + t] = (bf16)(v1w[e] & 0xffffu); vT[(64 + d + 1) * GLA_LD + t] = (bf16)(v1w[e] >> 16); }
          *(v4u*)(Qd + t * GLA_LD + d0) = cur.qd; *(v4u*)(Ki + t * GLA_LD + d0) = cur.ki; }
        __syncthreads();
        {
            f32x4 s2[2] = {(f32x4){0.f, 0.f, 0.f, 0.f}, (f32x4){0.f, 0.f, 0.f, 0.f}};
#pragma unroll
            for (int ks = 0; ks < 2; ++ks) { const bf16x8 af = *(const bf16x8*)(Qd + (16 * rt + l15) * GLA_LD + ks * 32 + 8 * quad);
#pragma unroll
                for (int j2 = 0; j2 < 2; ++j2) { const bf16x8 bfr = *(const bf16x8*)(Ki + (16 * (2 * ch + j2) + l15) * GLA_LD + ks * 32 + 8 * quad); s2[j2] = mfma16(af, bfr, s2[j2]); } }
#pragma unroll
            for (int j2 = 0; j2 < 2; ++j2)
#pragma unroll
                for (int r = 0; r < 4; ++r) { const int i = 16 * rt + 4 * quad + r, j = 16 * (2 * ch + j2) + l15; At[i * GLA_LD + j] = (bf16)f2bf(j <= i ? s2[j2][r] : 0.f); }
        }
        __syncthreads();
        f32x4 o[4];
#pragma unroll
        for (int vt = 0; vt < 4; ++vt) o[vt] = (f32x4){0.f, 0.f, 0.f, 0.f};
#pragma unroll
        for (int ks = 0; ks < 2; ++ks) {
            const bf16x8 a1 = *(const bf16x8*)(At + (16 * rt + l15) * GLA_LD + ks * 32 + 8 * quad);
            const bf16x8 a2 = *(const bf16x8*)(Qd + (16 * rt + l15) * GLA_LD + ks * 32 + 8 * quad);
#pragma unroll
            for (int vt = 0; vt < 4; ++vt) { const bf16x8 b1 = *(const bf16x8*)(vT + (16 * (4 * ch + vt) + l15) * GLA_LD + ks * 32 + 8 * quad);
                o[vt] = mfma16(a1, b1, o[vt]); o[vt] = mfma16(a2, cur.sfr[ks][vt], o[vt]); } }
#pragma unroll
        for (int r = 0; r < 4; ++r) { float sq = 0.f;
#pragma unroll
            for (int vt = 0; vt < 4; ++vt) sq += o[vt][r] * o[vt][r];
            sq += __shfl_xor(sq, 1); sq += __shfl_xor(sq, 2); sq += __shfl_xor(sq, 4); sq += __shfl_xor(sq, 8);
            if (l15 == 0) part[ch * 64 + 16 * rt + 4 * quad + r] = sq; }
        __syncthreads();
#pragma unroll
        for (int r = 0; r < 4; ++r) { const int i = 16 * rt + 4 * quad + r; const float rstd = 1.0f / sqrtf((part[i] + part[64 + i]) * (1.f / 128.f) + EPS);
#pragma unroll
            for (int vt = 0; vt < 4; ++vt) { const int v = 16 * (4 * ch + vt) + l15; const float rgf = bf2f(rg[r][vt]);
                a.mix[(size_t)(m0 + i) * 1024 + h * 128 + v] = (bf16)f2bf(o[vt][r] * rstd * a.gnw[v] * (rgf / (1.f + __expf(-rgf)))); } }
        cur = nxt;
    }
}

template <class T> __device__ __forceinline__ T ntl(const T* p) { return __builtin_nontemporal_load(p); }
template <class T> __device__ __forceinline__ void nts(T* p, T v) { __builtin_nontemporal_store(v, p); }
struct RowBuf { f32x4 x[4]; v2u r[4]; };
__device__ __forceinline__ void row_load(RowBuf& b, const float* xrow, const bf16* raw, int lane) {
#pragma unroll
    for (int j = 0; j < 4; ++j) { b.x[j] = ntl((const f32x4*)xrow + lane + 64 * j); b.r[j] = ntl((const v2u*)raw + lane + 64 * j); }
}
__device__ __forceinline__ f32x4 bf4(v2u rw);
__device__ __forceinline__ float row_ss(const v2u (&r)[4]);
__device__ __forceinline__ f32x4 bf4(v2u rw) { return (f32x4){bf2f(rw.x & 0xffffu), bf2f(rw.x >> 16), bf2f(rw.y & 0xffffu), bf2f(rw.y >> 16)}; }
__device__ __forceinline__ void p6_finish(const RowBuf& b, const float* wpost, const float* wpre, bf16* x1b, bf16* hn, int lane) {
    const float r1 = 1.0f / sqrtf(row_ss(b.r) * (1.f / DM) + EPS);
    f32x4 v[4]; float s = 0.f;
#pragma unroll
    for (int j = 0; j < 4; ++j) { v[j] = b.x[j] + (bf4(b.r[j]) * r1) * ((const f32x4*)wpost)[lane + 64 * j];
        s += (v[j].x * v[j].x + v[j].y * v[j].y) + (v[j].z * v[j].z + v[j].w * v[j].w);
        v2u o; o.x = pk2(v[j].x, v[j].y); o.y = pk2(v[j].z, v[j].w); ((v2u*)x1b)[lane + 64 * j] = o; }
    const float r2 = 1.0f / sqrtf(wave_sum(s) * (1.f / DM) + EPS);
#pragma unroll
    for (int j = 0; j < 4; ++j) { const f32x4 wv = ((const f32x4*)wpre)[lane + 64 * j]; const f32x4 y = (v[j] * r2) * wv;
        v2u o; o.x = pk2(y.x, y.y); o.y = pk2(y.z, y.w); ((v2u*)hn)[lane + 64 * j] = o; }
}
__device__ __forceinline__ float row_ss(const v2u (&r)[4]) { float s = 0.f;
#pragma unroll
    for (int j = 0; j < 4; ++j) { const f32x4 o = bf4(r[j]); s += (o.x * o.x + o.y * o.y) + (o.z * o.z + o.w * o.w); }
    return wave_sum(s); }
__device__ __forceinline__ void p6_rows(const float* x, bf16* raw, const float* wpost, const float* wpre, bf16* hn, int gw, int NGW, int lane) {
    if (gw >= M) return;
    RowBuf cur, nxt; row_load(cur, x + (size_t)gw * DM, raw + (size_t)gw * DM, lane);
    for (int m = gw; m < M; m += NGW) { const int mn = (m + NGW < M) ? m + NGW : m;
        if (mn != m) row_load(nxt, x + (size_t)mn * DM, raw + (size_t)mn * DM, lane);
        p6_finish(cur, wpost, wpre, raw + (size_t)m * DM, hn + (size_t)m * DM, lane); cur = nxt; }
}
__device__ __forceinline__ void p9_rows(const bf16* x1b, const bf16* raw2, const float* wpost2, float* out, int gw, int NGW, int lane) {
    if (gw >= M) return;
    v2u cx[4], c2[4], nx[4], n2[4];
#pragma unroll
    for (int j = 0; j < 4; ++j) { cx[j] = ntl((const v2u*)(x1b + (size_t)gw * DM) + lane + 64 * j); c2[j] = ntl((const v2u*)(raw2 + (size_t)gw * DM) + lane + 64 * j); }
    for (int m = gw; m < M; m += NGW) { const int mn = (m + NGW < M) ? m + NGW : m;
#pragma unroll
        for (int j = 0; j < 4; ++j) { nx[j] = ntl((const v2u*)(x1b + (size_t)mn * DM) + lane + 64 * j); n2[j] = ntl((const v2u*)(raw2 + (size_t)mn * DM) + lane + 64 * j); }
        const float r2 = 1.0f / sqrtf(row_ss(c2) * (1.f / DM) + EPS);
#pragma unroll
        for (int j = 0; j < 4; ++j) nts((f32x4*)(out + (size_t)m * DM) + lane + 64 * j, bf4(cx[j]) + (bf4(c2[j]) * r2) * ((const f32x4*)wpost2)[lane + 64 * j]);
#pragma unroll
        for (int j = 0; j < 4; ++j) { cx[j] = nx[j]; c2[j] = n2[j]; } }
}
__device__ __forceinline__ unsigned okey_of(float s) { const unsigned u = __float_as_uint(s); return (u & 0x80000000u) ? ~u : (u | 0x80000000u); }
__device__ __forceinline__ void cnt_ge(unsigned& n, unsigned k, unsigned c) { asm volatile("v_cmp_ge_u32 vcc, %1, %2\n\tv_addc_co_u32 %0, vcc, 0, %0, vcc" : "+v"(n) : "v"(k), "v"(c) : "vcc"); }
__device__ __forceinline__ void cnt_gt(unsigned& n, unsigned k, unsigned c) { asm volatile("v_cmp_gt_u32 vcc, %1, %2\n\tv_addc_co_u32 %0, vcc, 0, %0, vcc" : "+v"(n) : "v"(k), "v"(c) : "vcc"); }
__device__ __forceinline__ void cnt_tie(unsigned& n, unsigned k, unsigned T, unsigned lo, unsigned c) { unsigned tmp;
    asm volatile("v_cmp_eq_u32 vcc, %2, %3\n\tv_cndmask_b32 %1, 0, %4, vcc\n\tv_cmp_ge_u32 vcc, %1, %5\n\tv_addc_co_u32 %0, vcc, 0, %0, vcc" : "+v"(n), "=&v"(tmp) : "v"(k), "v"(T), "v"(lo), "v"(c) : "vcc"); }
#ifndef PROBE_IDX
#define PROBE_IDX 0
#endif
typedef _Float16 f16x8 __attribute__((ext_vector_type(8)));
__device__ __forceinline__ f32x4 mfma16h(f16x8 a, f16x8 b, f32x4 c) { return __builtin_amdgcn_mfma_f32_16x16x32_f16(a, b, c, 0, 0, 0); }
struct IdxArgs { const bf16 *iqh, *iql, *ikh, *ikl; const float* iw; unsigned short* mask16; const float* qb; float kbound; };
constexpr int IDX_ROUNDS = 45;
constexpr int IDX_NB = 2048, IDX_CAP = 512;
constexpr int IDX_HIST = 0, IDX_CAND = 8 * IDX_NB * 4, IDX_SMALL = IDX_CAND + 8 * IDX_CAP * 8;
__device__ __forceinline__ float okey_to_f(unsigned k) { return __uint_as_float((k & 0x80000000u) ? (k & 0x7fffffffu) : ~k); }
__device__ __forceinline__ unsigned idx_bin(float s, float inv) { return min((unsigned)__builtin_fmaf(s, inv, 0.5f * IDX_NB), (unsigned)(IDX_NB - 1)); }
template <int NI, int PV>
__device__ __forceinline__ void indexer_unit_t(const IdxArgs& a, int b, int c, int g, char* ldsg, int tid, int probe) {
    int lane_ = tid & 63; asm volatile("" : "+v"(lane_));
    const int lane = lane_, w = __builtin_amdgcn_readfirstlane(tid >> 6), quad = lane >> 4, l15 = lane & 15;
    const int q0 = b * SEQ + c * 64 + g * 8, ntile = 4 * (c + 1), nloc = (ntile - w + 7) >> 3;
    unsigned* hist = (unsigned*)(ldsg + IDX_HIST); unsigned long long* cand = (unsigned long long*)(ldsg + IDX_CAND); unsigned* sm = (unsigned*)(ldsg + IDX_SMALL);
    unsigned* qmin = sm; unsigned* qmax = sm + 8; unsigned* bstar = sm + 16; unsigned* above = sm + 24; unsigned* candn = sm + 32; unsigned* Tq = sm + 40; unsigned* Lq = sm + 48; unsigned* ovf = sm + 56; unsigned* dump = sm + 60; unsigned* cnt = sm + 64;
    __syncthreads();
    { v4u z = {0u, 0u, 0u, 0u}; v4u* h4 = (v4u*)hist;
#pragma unroll
      for (int k = 0; k < 8; ++k) h4[tid + k * NTHR] = z;
      if (tid < 8) candn[tid] = 0u;
      if (tid == 8) ovf[0] = 0u; }
    f16x8 aqh[2][2], aql[2][2]; f32x4 wq[2];
#pragma unroll
    for (int rt = 0; rt < 2; ++rt) {
#pragma unroll
        for (int ks = 0; ks < 2; ++ks) { const size_t p = ((size_t)(q0 + rt * 4 + (l15 >> 2)) * 4 + (l15 & 3)) * 64 + ks * 32 + 8 * quad;
            aqh[rt][ks] = *(const f16x8*)(a.iqh + p); aql[rt][ks] = *(const f16x8*)(a.iql + p); }
        wq[rt] = *(const f32x4*)(a.iw + (size_t)(q0 + rt * 4 + quad) * 4); }
    float sc[NI][2];
    const float kmx = a.kbound * 0.1666667f; const float inv0 = (0.5f * IDX_NB) / (a.qb[q0 + quad] * kmx), inv1 = (0.5f * IDX_NB) / (a.qb[q0 + 4 + quad] * kmx);
    __syncthreads();
    const char* khb = (const char*)a.ikh + (size_t)b * SEQ * 128;
    const unsigned koff = (unsigned)lane * 16u;
    constexpr int RING = 8;
    f16x8 kb[RING][2];
#define IDX_LOAD(i) do { const int tc_ = (probe >= 4) ? 0 : min(w + 8 * (i), ntile - 1); const unsigned o_ = koff + (unsigned)tc_ * 2048u; kb[(i) % RING][0] = *(const f16x8*)(khb + o_); kb[(i) % RING][1] = *(const f16x8*)(khb + (o_ + 1024u)); } while (0)
#pragma unroll
    for (int i = 0; i < RING - 1; ++i) IDX_LOAD(i);
#pragma unroll
    for (int i = 0; i < NI; ++i) {
        if (i + RING - 1 < NI) IDX_LOAD(i + RING - 1);
        const f16x8 bh0 = kb[i % RING][0], bh1 = kb[i % RING][1];
#pragma unroll
        for (int rt = 0; rt < 2; ++rt) { f32x4 acc = {0.f, 0.f, 0.f, 0.f};
            acc = mfma16h(aqh[rt][0], bh0, acc); acc = mfma16h(aqh[rt][1], bh1, acc); acc = mfma16h(aql[rt][0], bh0, acc); acc = mfma16h(aql[rt][1], bh1, acc);
            if constexpr (PV == 5) sc[i][rt] = acc[0] + acc[1] + acc[2] + acc[3]; else
            sc[i][rt] = ((__builtin_amdgcn_fmed3f(acc[0], 0.f, wq[rt][0]) + __builtin_amdgcn_fmed3f(acc[1], 0.f, wq[rt][1])) + __builtin_amdgcn_fmed3f(acc[2], 0.f, wq[rt][2])) + __builtin_amdgcn_fmed3f(acc[3], 0.f, wq[rt][3]); }
        { const unsigned one = (i < nloc) ? 1u : 0u;
          atomicAdd(&hist[quad * IDX_NB + idx_bin(sc[i][0], inv0)], one); atomicAdd(&hist[(4 + quad) * IDX_NB + idx_bin(sc[i][1], inv1)], one); }
        __builtin_amdgcn_sched_barrier(0);
    }
#undef IDX_LOAD
    if (probe == 1 || probe >= 4) return;
    __syncthreads();
    { const v4u* hq = (const v4u*)(hist + w * IDX_NB) + lane * 8; unsigned cntv[32]; unsigned tot = 0u;
#pragma unroll
      for (int k = 0; k < 8; ++k) { const v4u v = hq[k]; cntv[4 * k] = v.x; cntv[4 * k + 1] = v.y; cntv[4 * k + 2] = v.z; cntv[4 * k + 3] = v.w; tot += (v.x + v.y) + (v.z + v.w); }
      unsigned suf = tot;
#pragma unroll
      for (int o = 1; o < 64; o <<= 1) { const unsigned t = __shfl_down(suf, o); if (lane + o < 64) suf += t; }
      unsigned run = suf - tot;
      int bj = -1; unsigned ab = 0u;
#pragma unroll
      for (int j = 31; j >= 0; --j) { const unsigned cj = cntv[j]; const bool hit = (run < (unsigned)TOPK) && (run + cj >= (unsigned)TOPK); bj = hit ? j : bj; ab = hit ? run : ab; run += cj; }
      if (bj >= 0) { bstar[w] = (unsigned)(lane * 32 + bj); above[w] = ab; } }
    __syncthreads();
    if (probe == 2) return;
    const unsigned lo_base = 4095u - (unsigned)(16 * w + l15);
    { const unsigned bs0 = bstar[quad], bs1 = bstar[4 + quad];
#pragma unroll
      for (int i = 0; i < NI; ++i) { const unsigned lo = lo_base - 128u * (unsigned)i; const bool act = (i < nloc);
          if (act && idx_bin(sc[i][0], inv0) == bs0) { const unsigned slot = atomicAdd(&candn[quad], 1u); if (slot < (unsigned)IDX_CAP) cand[quad * IDX_CAP + slot] = ((unsigned long long)okey_of(sc[i][0]) << 12) | lo; }
          if (act && idx_bin(sc[i][1], inv1) == bs1) { const unsigned slot = atomicAdd(&candn[4 + quad], 1u); if (slot < (unsigned)IDX_CAP) cand[(4 + quad) * IDX_CAP + slot] = ((unsigned long long)okey_of(sc[i][1]) << 12) | lo; } } }
    __syncthreads();
    if (probe == 7) return;
    { const unsigned L = candn[w], need = (unsigned)TOPK - above[w];
      if (L > (unsigned)IDX_CAP) { if (lane == 0) ovf[0] = 1u; }
      else if (L <= 64u) {
        const unsigned long long mine = ((unsigned)lane < L) ? cand[w * IDX_CAP + lane] : 0ull; const unsigned mlo = (unsigned)mine, mhi = (unsigned)(mine >> 32); unsigned rank = 0u;
        for (unsigned i = 0; i < L; ++i) { const unsigned long long o = ((unsigned long long)(unsigned)__builtin_amdgcn_readlane((int)mhi, (int)i) << 32) | (unsigned)__builtin_amdgcn_readlane((int)mlo, (int)i); rank += (o > mine) ? 1u : 0u; }
        const unsigned long long bal = __ballot((unsigned)lane < L && rank + 1u == need); const int src = (int)__ffsll((long long)bal) - 1;
        const unsigned klo = (unsigned)__builtin_amdgcn_readlane((int)mlo, src), khi = (unsigned)__builtin_amdgcn_readlane((int)mhi, src);
        if (lane == 0) { Tq[w] = (khi << 20) | (klo >> 12); Lq[w] = klo & 0xfffu; } }
      else { unsigned long long ck[8];
#pragma unroll
        for (int j = 0; j < 8; ++j) ck[j] = ((unsigned)(j * 64 + lane) < L) ? cand[w * IDX_CAP + j * 64 + lane] : 0ull;
        unsigned long long Kth = 0ull;
#pragma nounroll
        for (int bit = 43; bit >= 0; --bit) { const unsigned long long cv = Kth | (1ull << bit); unsigned n = 0u;
#pragma unroll
            for (int j = 0; j < 8; ++j) if ((unsigned)(j * 64) < L) n += (unsigned)__popcll(__ballot(ck[j] >= cv));
            if (n >= need) Kth = cv; }
        if (lane == 0) { Tq[w] = (unsigned)(Kth >> 12); Lq[w] = (unsigned)Kth & 0xfffu; } } }
    __syncthreads();
    if (probe == 3) return;
    unsigned T0, T1, L0, L1; float Tf0, Tf1;
    if (ovf[0] == 0u) { Tf0 = okey_to_f(Tq[quad]); Tf1 = okey_to_f(Tq[4 + quad]); L0 = Lq[quad]; L1 = Lq[4 + quad];
    } else {
#pragma unroll
        for (int i = 0; i < NI; ++i) { sc[i][0] = (i < nloc) ? __uint_as_float(okey_of(sc[i][0])) : 0.f; sc[i][1] = (i < nloc) ? __uint_as_float(okey_of(sc[i][1])) : 0.f; }
        for (int i = tid; i < IDX_ROUNDS * 8; i += NTHR) cnt[i] = 0u;
        __syncthreads();
        T0 = 0u; T1 = 0u;
#pragma nounroll
        for (int rd = 0; rd < 32; ++rd) {
            const unsigned c0v = T0 | (0x80000000u >> rd), c1v = T1 | (0x80000000u >> rd); unsigned n0 = 0u, n1 = 0u;
#pragma unroll
            for (int i = 0; i < NI; ++i) { cnt_ge(n0, __float_as_uint(sc[i][0]), c0v); cnt_ge(n1, __float_as_uint(sc[i][1]), c1v); }
#pragma unroll
            for (int o = 1; o < 16; o <<= 1) { n0 += __shfl_xor(n0, o); n1 += __shfl_xor(n1, o); }
            if (l15 == 0) { atomicAdd(&cnt[rd * 8 + quad], n0); atomicAdd(&cnt[rd * 8 + 4 + quad], n1); }
            __syncthreads();
            if (cnt[rd * 8 + quad] >= (unsigned)TOPK) T0 = c0v;
            if (cnt[rd * 8 + 4 + quad] >= (unsigned)TOPK) T1 = c1v;
        }
        { unsigned n0 = 0u, n1 = 0u;
#pragma unroll
          for (int i = 0; i < NI; ++i) { cnt_gt(n0, __float_as_uint(sc[i][0]), T0); cnt_gt(n1, __float_as_uint(sc[i][1]), T1); }
#pragma unroll
          for (int o = 1; o < 16; o <<= 1) { n0 += __shfl_xor(n0, o); n1 += __shfl_xor(n1, o); }
          if (l15 == 0) { atomicAdd(&cnt[32 * 8 + quad], n0); atomicAdd(&cnt[32 * 8 + 4 + quad], n1); }
          __syncthreads(); }
        const unsigned need0 = (unsigned)TOPK - cnt[32 * 8 + quad], need1 = (unsigned)TOPK - cnt[32 * 8 + 4 + quad];
        L0 = 0u; L1 = 0u;
#pragma nounroll
        for (int rd = 0; rd < 12; ++rd) {
            const unsigned c0v = L0 | (0x800u >> rd), c1v = L1 | (0x800u >> rd); unsigned n0 = 0u, n1 = 0u;
#pragma unroll
            for (int i = 0; i < NI; ++i) { const unsigned lo = lo_base - 128u * (unsigned)i; cnt_tie(n0, __float_as_uint(sc[i][0]), T0, lo, c0v); cnt_tie(n1, __float_as_uint(sc[i][1]), T1, lo, c1v); }
#pragma unroll
            for (int o = 1; o < 16; o <<= 1) { n0 += __shfl_xor(n0, o); n1 += __shfl_xor(n1, o); }
            if (l15 == 0) { atomicAdd(&cnt[(33 + rd) * 8 + quad], n0); atomicAdd(&cnt[(33 + rd) * 8 + 4 + quad], n1); }
            __syncthreads();
            if (cnt[(33 + rd) * 8 + quad] >= need0) L0 = c0v;
            if (cnt[(33 + rd) * 8 + 4 + quad] >= need1) L1 = c1v;
        }
        Tf0 = okey_to_f(T0); Tf1 = okey_to_f(T1);
#pragma unroll
        for (int i = 0; i < NI; ++i) { sc[i][0] = okey_to_f(__float_as_uint(sc[i][0])); sc[i][1] = okey_to_f(__float_as_uint(sc[i][1])); }
    }
#pragma unroll
    for (int i = 0; i < NI; ++i) {
        const int t = w + 8 * i; const unsigned lo = lo_base - 128u * (unsigned)i; const bool act = (i < nloc);
#pragma unroll
        for (int rt = 0; rt < 2; ++rt) { const float k = sc[i][rt], T = rt ? Tf1 : Tf0; const unsigned L = rt ? L1 : L0;
            const bool sel = (k > T) || (k == T && lo >= L);
            const unsigned long long bal = __ballot(sel);
            if (lane < 4 && act) a.mask16[(size_t)(q0 + rt * 4 + lane) * 256 + t] = (unsigned short)((bal >> (16 * lane)) & 0xffffull); }
        __builtin_amdgcn_sched_barrier(0);
    }
}
template <int PV>
__device__ __forceinline__ void indexer_unit(const IdxArgs& a, int b, int c, int g, char* ldsg, int tid, int probe) {
    if (c < 8) indexer_unit_t<4, PV>(a, b, c, g, ldsg, tid, probe); else if (c < 16) indexer_unit_t<8, PV>(a, b, c, g, ldsg, tid, probe); else if (c < 24) indexer_unit_t<12, PV>(a, b, c, g, ldsg, tid, probe); else if (c < 32) indexer_unit_t<16, PV>(a, b, c, g, ldsg, tid, probe);
    else if (c < 40) indexer_unit_t<20, PV>(a, b, c, g, ldsg, tid, probe); else if (c < 48) indexer_unit_t<24, PV>(a, b, c, g, ldsg, tid, probe); else if (c < 56) indexer_unit_t<28, PV>(a, b, c, g, ldsg, tid, probe); else indexer_unit_t<32, PV>(a, b, c, g, ldsg, tid, probe);
}

namespace att {
using s16x4  = __attribute__((ext_vector_type(4))) short;
using f32x16 = __attribute__((ext_vector_type(16))) float;
using u32x4  = __attribute__((ext_vector_type(4))) unsigned;
constexpr int D = 128, NW = 8, QBLK = 32, KVBLK = 64;
constexpr float SCALE = 0.088388347648318440f, THR = 8.f;
constexpr int SHM_V = KVBLK * D * 2, SHM_K = KVBLK * D * 2, SHM_Q0 = 2 * SHM_V + 2 * SHM_K + NW * 64 * 4, SHM_ATTN = SHM_Q0 + 256 * D * 2;
constexpr int LDK = 128, LDV = NMAIN;
#define KSWZ(row, colB) ((row) * 256 + ((colB) ^ (((row) & 7) << 4)))
#define SBAR() __builtin_amdgcn_sched_barrier(0)
__device__ __forceinline__ int crow(int r, int hi) { return (r & 3) + 8 * (r >> 2) + 4 * hi; }
__device__ __forceinline__ unsigned cvtpk(float lo, float hi) { unsigned r; asm volatile("v_cvt_pk_bf16_f32 %0, %1, %2" : "=v"(r) : "v"(lo), "v"(hi)); return r; }
__device__ __forceinline__ float mask_and(float e, unsigned m, int pos) { float r; asm("v_bfe_i32 %0, %1, %2, 1\n\tv_and_b32 %0, %0, %3" : "=&v"(r) : "v"(m), "n"(pos), "v"(e)); return r; }
__device__ __forceinline__ void partialSM(f32x16& p0, f32x16& p1, float& m_reg, float& mn, float& alpha, unsigned ml) {
  constexpr float C = SCALE * 1.4426950408889634f;
  float pmax = p0[0];
#pragma unroll
  for (int r = 1; r < 16; ++r) pmax = fmaxf(pmax, p0[r]);
#pragma unroll
  for (int r = 0; r < 16; ++r) pmax = fmaxf(pmax, p1[r]);
  { auto rr = __builtin_amdgcn_permlane32_swap(__float_as_uint(pmax), __float_as_uint(pmax), false, false);
    pmax = fmaxf(__uint_as_float(rr[0]), __uint_as_float(rr[1])); }
  if (__builtin_expect(__all(pmax - m_reg <= THR / SCALE), 1)) { mn = m_reg; alpha = 1.f; }
  else { mn = fmaxf(m_reg, pmax); alpha = __builtin_amdgcn_exp2f((m_reg - mn) * C); m_reg = mn; }
  const float mnC = -mn * C;
#pragma unroll
  for (int r = 0; r < 16; ++r) p0[r] = fmaf(p0[r], C, mnC);
#pragma unroll
  for (int r = 0; r < 16; ++r) p1[r] = fmaf(p1[r], C, mnC);
#pragma unroll
  for (int r = 0; r < 16; ++r) p0[r] = mask_and(__builtin_amdgcn_exp2f(p0[r]), ml, (r & 3) + 8 * (r >> 2));
}
__device__ __forceinline__ void finishSM(f32x16& p0, f32x16& p1, float alpha, float& l_reg, bf16x8& pa0, bf16x8& pa1, bf16x8& pa2, bf16x8& pa3, unsigned mh) {
#pragma unroll
  for (int r = 0; r < 16; ++r) p1[r] = mask_and(__builtin_amdgcn_exp2f(p1[r]), mh, (r & 3) + 8 * (r >> 2));
  float ps = 0;
#pragma unroll
  for (int r = 0; r < 16; ++r) ps += p0[r];
#pragma unroll
  for (int r = 0; r < 16; ++r) ps += p1[r];
  { auto rr = __builtin_amdgcn_permlane32_swap(__float_as_uint(ps), __float_as_uint(ps), false, false);
    ps = __uint_as_float(rr[0]) + __uint_as_float(rr[1]); }
  l_reg = l_reg * alpha + ps;
#define PK4(P, BASE, OUT) do { unsigned a0 = cvtpk(P[BASE + 0], P[BASE + 1]), a1 = cvtpk(P[BASE + 2], P[BASE + 3]);   \
    unsigned b0 = cvtpk(P[BASE + 4], P[BASE + 5]), b1 = cvtpk(P[BASE + 6], P[BASE + 7]);                              \
    auto r0 = __builtin_amdgcn_permlane32_swap(a0, b0, false, false); auto r1 = __builtin_amdgcn_permlane32_swap(a1, b1, false, false); \
    u32x4 w = {r0[0], r1[0], r0[1], r1[1]}; OUT = *reinterpret_cast<bf16x8*>(&w); } while (0)
  PK4(p0, 0, pa0); PK4(p0, 8, pa1); PK4(p1, 0, pa2); PK4(p1, 8, pa3);
#undef PK4
}
__device__ __forceinline__ void qkt(f32x16& p0, f32x16& p1, const bf16* Ks, const char* Qs, int r32, int hi) {
  p0 = f32x16{}; p1 = f32x16{};
#pragma unroll
  for (int d0 = 0; d0 < 8; ++d0) { int cb = (d0 * 16 + hi * 8) * 2;
    bf16x8 b0 = *reinterpret_cast<const bf16x8*>((const char*)Ks + KSWZ(r32, cb));
    bf16x8 b1 = *reinterpret_cast<const bf16x8*>((const char*)Ks + KSWZ(32 + r32, cb));
    bf16x8 q = *reinterpret_cast<const bf16x8*>(Qs + KSWZ(r32, cb));
    p0 = __builtin_amdgcn_mfma_f32_32x32x16_bf16(b0, q, p0, 0, 0, 0);
    p1 = __builtin_amdgcn_mfma_f32_32x32x16_bf16(b1, q, p1, 0, 0, 0); }
}
__device__ __forceinline__ int v_st(int k, int c) { const int kk = (k & ~0xC) | ((k & 4) << 1) | ((k & 8) >> 1); return ((kk >> 3) * 4 + (c >> 5)) * 512 + ((kk & 7) * 32 + (c & 31)) * 2; }
__device__ __forceinline__ int v_rd_base(int lane) { return ((lane & 3) << 3) | (((lane >> 2) & 3) << 6) | (((lane >> 4) & 1) << 5) | (((lane >> 5) & 1) << 8); }
constexpr int v_rd_off(int d0, int ks, int half) { return d0 * 512 + ks * 4096 + half * 2048; }
template <int OFF> __device__ __forceinline__ s16x4 tr_read(int vb) {
  s16x4 r; asm volatile("ds_read_b64_tr_b16 %0, %1 offset:%2" : "=&v"(r) : "v"(vb), "i"(OFF) : "memory"); return r;
}
template <int D0> __device__ __forceinline__ void pv_one(f32x16& od, int vb, bf16x8 pa0, bf16x8 pa1, bf16x8 pa2, bf16x8 pa3) {
  const s16x4 l0 = tr_read<v_rd_off(D0, 0, 0)>(vb), h0 = tr_read<v_rd_off(D0, 0, 1)>(vb), l1 = tr_read<v_rd_off(D0, 1, 0)>(vb), h1 = tr_read<v_rd_off(D0, 1, 1)>(vb);
  const s16x4 l2 = tr_read<v_rd_off(D0, 2, 0)>(vb), h2 = tr_read<v_rd_off(D0, 2, 1)>(vb), l3 = tr_read<v_rd_off(D0, 3, 0)>(vb), h3 = tr_read<v_rd_off(D0, 3, 1)>(vb);
  asm volatile("s_waitcnt lgkmcnt(0)" ::: "memory"); SBAR();
#define PK(L, H) (bf16x8){L[0], L[1], L[2], L[3], H[0], H[1], H[2], H[3]}
  od = __builtin_amdgcn_mfma_f32_32x32x16_bf16(pa0, PK(l0, h0), od, 0, 0, 0);
  od = __builtin_amdgcn_mfma_f32_32x32x16_bf16(pa1, PK(l1, h1), od, 0, 0, 0);
  od = __builtin_amdgcn_mfma_f32_32x32x16_bf16(pa2, PK(l2, h2), od, 0, 0, 0);
  od = __builtin_amdgcn_mfma_f32_32x32x16_bf16(pa3, PK(l3, h3), od, 0, 0, 0);
#undef PK
}
__device__ __forceinline__ void pv_d0(f32x16* o, int vb, bf16x8 pa0, bf16x8 pa1, bf16x8 pa2, bf16x8 pa3) {
  pv_one<0>(o[0], vb, pa0, pa1, pa2, pa3); pv_one<1>(o[1], vb, pa0, pa1, pa2, pa3); pv_one<2>(o[2], vb, pa0, pa1, pa2, pa3); pv_one<3>(o[3], vb, pa0, pa1, pa2, pa3);
}
__device__ __forceinline__ void attn_unit(const f32x2* __restrict__ TAB, const bf16* __restrict__ KR, const bf16* __restrict__ PMAIN, const unsigned long long* __restrict__ MASK,
                                          bf16* __restrict__ MIX, int b, int c, char* lds) {
  const int tid = threadIdx.x, wid = tid >> 6, lane = tid & 63, r32 = lane & 31, hi = lane >> 5;
  bf16* V_lds = (bf16*)lds; bf16* K_lds = (bf16*)(lds + 2 * SHM_V);
  float* ws = (float*)(lds + 2 * SHM_V + 2 * SHM_K) + wid * 64; float* li_l = ws; float* al_l = ws + 32;
  float m_reg = -1e30f, l_reg = 0; f32x16 o[4] = {};
  const char* qr = lds + SHM_Q0 + wid * (QBLK * 256);
  const int tok0 = b * SEQ + c * 64, qloc = 8 * wid + (r32 >> 2);
  const bf16* Kh = KR + (size_t)b * SEQ * LDK; const bf16* Vh = PMAIN + (size_t)b * SEQ * LDV + PM_DV;
  const char* mb = (const char*)MASK + (size_t)tok0 * 512; const unsigned moff = (unsigned)qloc * 512u; const bool allsel = (c <= 3);
  const int NTR = c + 1, NT = (NTR + 1) & ~1;
#define GETMASK(kt, ML, MH) do { unsigned long long mm_ = allsel ? ~0ull : *(const unsigned long long*)(mb + (moff + 8u * (unsigned)(kt))); if ((kt) >= NTR) mm_ = 0ull; ML = (unsigned)mm_ >> (4 * hi); MH = (unsigned)(mm_ >> 32) >> (4 * hi); } while (0)
  const int sr = tid >> 4, sc = (tid & 15) * 8, vst0 = v_st(sr, sc), vst1 = v_st(32 + sr, sc);
  const int vb0 = (int)(uintptr_t)V_lds + v_rd_base(lane);
  struct { bf16x8 vs0, vs1, ks0, ks1; } sr_[1];
const unsigned offV0 = (unsigned)(sr * LDV + sc) * 2u, offV1 = offV0 + 32u * LDV * 2u, offK0 = (unsigned)(sr * LDK + sc) * 2u, offK1 = offK0 + 32u * LDK * 2u;
#define SLOAD(i, k0) do { const char* vb_ = (const char*)Vh + (size_t)(k0) * (LDV * 2); const char* kb_ = (const char*)Kh + (size_t)(k0) * (LDK * 2); \
    sr_[i].vs0 = *(const bf16x8*)(vb_ + offV0); sr_[i].vs1 = *(const bf16x8*)(vb_ + offV1); sr_[i].ks0 = *(const bf16x8*)(kb_ + offK0); sr_[i].ks1 = *(const bf16x8*)(kb_ + offK1); } while (0)
#define SWRITE(bb, i) do { *(bf16x8*)((char*)V_lds + (bb) * SHM_V + vst0) = sr_[i].vs0;          \
    *(bf16x8*)((char*)V_lds + (bb) * SHM_V + vst1) = sr_[i].vs1; int kc = sc * 2;               \
    *(bf16x8*)((char*)K_lds + (bb) * SHM_K + KSWZ(sr, kc)) = sr_[i].ks0;                       \
    *(bf16x8*)((char*)K_lds + (bb) * SHM_K + KSWZ(32 + sr, kc)) = sr_[i].ks1; } while (0)
#define SWAIT() asm volatile("s_waitcnt vmcnt(0)" ::: "memory")
#define RESC(a) do { if (__any((a) < 1.f)) { if (hi == 0) al_l[r32] = (a); asm volatile("s_waitcnt lgkmcnt(0)" ::: "memory"); \
    _Pragma("unroll") for (int d = 0; d < 4; ++d) _Pragma("unroll") for (int r = 0; r < 16; ++r) o[d][r] *= al_l[crow(r, hi)]; } } while (0)
  f32x16 pA0, pA1, pB0, pB1; float mnA, mnB, alA, alB; bf16x8 pa0, pa1, pa2, pa3; unsigned mlA, mhA, mlB, mhB;
  constexpr int SE = 0, SO = 0;
  __syncthreads();
  {
    const char* qb = (const char*)PMAIN + (size_t)tok0 * (NMAIN * 2); const unsigned qoff = (unsigned)(qloc * NMAIN + PM_DQ + (r32 & 3) * 128 + hi * 8) * 2u;
    const f32x4* tb = (const f32x4*)(TAB + (size_t)(c * 64 + qloc) * 64 + hi * 8);
    v4u xq[8];
#pragma unroll
    for (int d0 = 0; d0 < 8; ++d0) xq[d0] = *reinterpret_cast<const v4u*>(qb + (qoff + 32u * d0));
#pragma unroll
    for (int d0 = 0; d0 < 4; ++d0) { const unsigned a1[4] = {xq[d0].x, xq[d0].y, xq[d0].z, xq[d0].w}, a2[4] = {xq[d0 + 4].x, xq[d0 + 4].y, xq[d0 + 4].z, xq[d0 + 4].w}; unsigned o1[4], o2[4];
#pragma unroll
        for (int e = 0; e < 4; ++e) { const f32x4 cs = tb[d0 * 8 + e];
            const float x10 = bfl(a1[e]), x11 = bfh(a1[e]), x20 = bfl(a2[e]), x21 = bfh(a2[e]);
            o1[e] = pk2(x10 * cs.x - x20 * cs.y, x11 * cs.z - x21 * cs.w); o2[e] = pk2(x20 * cs.x + x10 * cs.y, x21 * cs.z + x11 * cs.w); }
        *(v4u*)(const_cast<char*>(qr) + KSWZ(r32, (d0 * 16 + hi * 8) * 2)) = (v4u){o1[0], o1[1], o1[2], o1[3]};
        *(v4u*)(const_cast<char*>(qr) + KSWZ(r32, ((d0 + 4) * 16 + hi * 8) * 2)) = (v4u){o2[0], o2[1], o2[2], o2[3]}; }
    asm volatile("s_waitcnt lgkmcnt(0)" ::: "memory"); }
  SLOAD(SE, 0); asm volatile("s_waitcnt vmcnt(0)" ::: "memory"); SWRITE(0, SE); __syncthreads();
  GETMASK(0, mlA, mhA);
  qkt(pA0, pA1, K_lds, qr, r32, hi); partialSM(pA0, pA1, m_reg, mnA, alA, mlA);
  SLOAD(SO, KVBLK);
  SWAIT(); SWRITE(1, SO); __syncthreads();
  for (int j = 1; j + 1 < NT; j += 2) {
    GETMASK(j, mlB, mhB);
    SBAR(); qkt(pB0, pB1, (bf16*)((char*)K_lds + SHM_K), qr, r32, hi);
    finishSM(pA0, pA1, alA, l_reg, pa0, pa1, pa2, pa3, mhA); SBAR();
    SLOAD(SO, (j + 1) * KVBLK); SBAR();
    pv_d0(o, vb0, pa0, pa1, pa2, pa3); partialSM(pB0, pB1, m_reg, mnB, alB, mlB);
    __syncthreads(); SWAIT(); SWRITE(0, SE);
    RESC(alB); __syncthreads();
    GETMASK(j + 1, mlA, mhA);
    SBAR(); qkt(pA0, pA1, K_lds, qr, r32, hi);
    finishSM(pB0, pB1, alB, l_reg, pa0, pa1, pa2, pa3, mhB); SBAR();
    SLOAD(SE, (j + 2) * KVBLK); SBAR();
    pv_d0(o, vb0 + (int)SHM_V, pa0, pa1, pa2, pa3); partialSM(pA0, pA1, m_reg, mnA, alA, mlA);
    __syncthreads(); SWAIT(); SWRITE(1, SO);
    RESC(alA); __syncthreads();
  }
  GETMASK(NT - 1, mlB, mhB);
  SBAR(); qkt(pB0, pB1, (bf16*)((char*)K_lds + SHM_K), qr, r32, hi);
  finishSM(pA0, pA1, alA, l_reg, pa0, pa1, pa2, pa3, mhA); SBAR();
  pv_d0(o, vb0, pa0, pa1, pa2, pa3); partialSM(pB0, pB1, m_reg, mnB, alB, mlB);
  __syncthreads(); RESC(alB);
  finishSM(pB0, pB1, alB, l_reg, pa0, pa1, pa2, pa3, mhB); SBAR();
  pv_d0(o, vb0 + (int)SHM_V, pa0, pa1, pa2, pa3);
  if (hi == 0) li_l[r32] = l_reg; asm volatile("s_waitcnt lgkmcnt(0)" ::: "memory");
  float rli[16];
#pragma unroll
  for (int r = 0; r < 16; ++r) rli[r] = __builtin_amdgcn_rcpf(li_l[crow(r, hi)]);
  { char* ob = (char*)MIX + (size_t)tok0 * 2048; const unsigned ooff = (unsigned)((8 * wid + hi) * 1024 + 512 + r32) * 2u;
#pragma unroll
    for (int r = 0; r < 16; ++r)
#pragma unroll
      for (int d0 = 0; d0 < 4; ++d0) *(bf16*)(ob + (size_t)((2 * (r >> 2) * 1024 + (r & 3) * 128 + d0 * 32) * 2) + ooff) = (bf16)f2bf(o[d0][r] * rli[r]); }
#undef GETMASK
#undef SLOAD
#undef SWRITE
#undef SWAIT
#undef RESC
}
}
#ifndef MK_ONE_LAUNCH
#define MK_ONE_LAUNCH 1
#endif
constexpr int NPHASE = 10;
static_assert(att::SHM_ATTN <= MISC_OFF && pg8::STAGE_BYTES <= MISC_OFF, "LDS map");
struct Args { const float* in[14]; float* out; unsigned char* ws; int ph_lo, ph_hi, li, pad; };
__global__ void __launch_bounds__(NTHR, 2) fwd_kernel(Args args) {
    extern __shared__ __attribute__((aligned(16))) unsigned char lds[];
    const int tid = threadIdx.x, lane = tid & 63, wave = __builtin_amdgcn_readfirstlane(tid >> 6), bid = blockIdx.x, G = gridDim.x;
    typedef const __attribute__((address_space(4))) Args* KArgs;
    const KArgs ka = (KArgs)__builtin_amdgcn_kernarg_segment_ptr(); (void)args;
    unsigned char* ws = ka->ws; char* ldsg = (char*)lds; LAS unsigned char* ldsl = (LAS unsigned char*)lds;
    if (tid < 64) ((LAS unsigned*)(ldsl + MISC_OFF))[tid] = 0u;
    __syncthreads();
    volatile LAS unsigned* MISC = (volatile LAS unsigned*)(ldsl + MISC_OFF);
    unsigned* ctl = (unsigned*)(ws + WS_CTL);
    const int lo = ka->ph_lo, hi = ka->ph_hi;
    XcdBarrier bar; bar.bar = ctl + CW_BAR + ka->li * XCD_BAR_WORDS; bar.x = 0; bar.st = nullptr;
    if (hi - lo > 1) bar = xcd_barrier_post(ctl + CW_BAR + ka->li * XCD_BAR_WORDS, MISC + 8);
#ifndef PROBE_REPEAT
#define PROBE_REPEAT (-1)
#endif
#ifndef PROBE_SUB
#define PROBE_SUB 0
#endif
#ifndef PH_ENABLE
#define PH_ENABLE 0x3ff
#endif
#define IN(k) (((PH_ENABLE >> (k)) & 1) && lo <= (k) && (k) < hi)
#define SEAM(k) do { if (IN(k) && IN((k) + 1)) xcd_barrier(bar); } while (0)
#define hcat ((bf16*)(ws + WS_HCAT))
#define winm ((bf16*)(ws + WS_WINM))
#define wspl ((bf16*)(ws + WS_WSPL))
#define wo ((bf16*)(ws + WS_WO))
#define w1t ((bf16*)(ws + WS_W1))
#define w2t ((bf16*)(ws + WS_W2))
#define tab128 ((f32x2*)(ws + WS_TAB128))
#define tab64 ((f32x2*)(ws + WS_TAB64))
#define pmain ((bf16*)(ws + WS_PMAIN))
#define pspl ((float*)(ws + WS_PSPL))
#define mix ((bf16*)(ws + WS_MIX))
#define oraw ((bf16*)(ws + WS_ORAW))
#define hn ((bf16*)(ws + WS_HN))
#define hid ((bf16*)(ws + WS_HID))
#define ffraw ((bf16*)(ws + WS_FFRAW))
#define ss1 ((float*)(ctl + CW_SS1))
#define ss2 ((float*)(ctl + CW_SS2))
#define GLA_ARGS GlaArgs ga{pmain, pspl, ka->in[3], ka->in[4], ka->in[5], (bf16*)(ws + WS_UT), (float*)(ws + WS_DECAY), (bf16*)(ws + WS_SIN), mix, (bf16*)(ws + WS_GQD), (bf16*)(ws + WS_GKI)}
    const int gw = bid * NWAVES + wave, NGW = G * NWAVES;
    const int sub = (PROBE_SUB != 0 && ka->li == 1) ? PROBE_SUB : 0;

    if (IN(0)) {
        P0Args a{ka->in[0], ka->in[1], ka->in[2], ka->in[8], ka->in[11], ka->in[12], hcat, winm, wspl, wo, w1t, w2t, tab128, tab64};
        p0_prologue(a, ldsg, bid, G, tid);
        SEAM(0);
    }
    if (IN(1)) {
        { pg8::Gemm g{hcat, winm, M, NMAIN, 1024, 1024, 1024, 1 << 30}; pg8::StaticOrder S; S.init(M, NMAIN, G, bid);
          pg8::EpiBf16X<0, false> E{pmain, NMAIN, nullptr};
          pg8::gemm_phase<pg8::EpiBf16X<0, false>, pg8::StaticOrder, true, true, true>(ldsl, g, S, E); }
        __syncthreads();
        { pg8::Gemm g{hcat, wspl, M, NSPLIT, KSPLIT, 1024, KSPLIT, 1 << 30}; pg8::StaticOrder S; S.init(M, NSPLIT, G, bid);
          pg8::EpiF32 E{pspl, NSPLIT};
          pg8::gemm_phase<pg8::EpiF32, pg8::StaticOrder, true, true, true>(ldsl, g, S, E); }
        SEAM(1);
    }
    if (IN(2)) {
        GLA_ARGS;
        P2Args a{pmain, pspl, tab128, tab64, ka->in[6], ka->in[7], (bf16*)(ws + WS_QR), (bf16*)(ws + WS_KR), (bf16*)(ws + WS_IKH), (bf16*)(ws + WS_IKL), (bf16*)(ws + WS_IQH), (bf16*)(ws + WS_IQL), (float*)(ws + WS_IW), (float*)(ws + WS_QB)};
        if (sub != 2) p2_post_rows(a, gw, NGW, lane);
        if (sub != 1) gla_local_phase(ga, ldsg, bid, G, tid);
        SEAM(2);
    }
    if (IN(3)) {
        GLA_ARGS;
#ifndef PROBE_IDX
#define PROBE_IDX 0
#endif
        const int probe = (PROBE_IDX != 0 && ka->li == 1) ? PROBE_IDX : 0;
        if (probe == 0) gla_scan(ga, bid, G, tid);
        float kbound; { const float lw = fabsf(ka->in[6][lane]), lb = ka->in[7][lane]; float mw = lw;
#pragma unroll
          for (int o = 1; o < 64; o <<= 1) mw = fmaxf(mw, __shfl_xor(mw, o));
          kbound = 8.0f * mw + sqrtf(wave_sum(lb * lb)); }
        IdxArgs a{(const bf16*)(ws + WS_IQH), (const bf16*)(ws + WS_IQL), (const bf16*)(ws + WS_IKH), (const bf16*)(ws + WS_IKL), (const float*)(ws + WS_IW), (unsigned short*)(ws + WS_MASK), (const float*)(ws + WS_QB), kbound};
        if (G == 256) {
            const int b = bid >> 5, g = (bid & 31) >> 2, j = bid & 3;
            for (int k = 14; k >= 0; --k) { const int r = (k < 14) ? ((k >> 1) * 8 + ((k & 1) ? 7 - j : j)) : 56 + j;
                indexer_unit<0>(a, b, 4 + r, g, ldsg, tid, probe); }
        } else {
            for (int it = bid; it < BATCH * 30 * 8; it += G) {
                const int b = it / 240, rem = it % 240, p = rem >> 3, g = rem & 7;
                indexer_unit<0>(a, b, 4 + p, g, ldsg, tid, probe); indexer_unit<0>(a, b, 63 - p, g, ldsg, tid, probe); }
        }
        SEAM(3);
    }
    if (IN(4)) {
        GLA_ARGS;
        if (sub != 2) gla_out_phase(ga, ldsg, bid, G, tid);
        if (sub != 1) for (int it = bid; it < BATCH * 32; it += G) {
            const int b = it & 7, p = it >> 3;
            for (int half = 0; half < 2; ++half)
                att::attn_unit(tab128, (const bf16*)(ws + WS_KR), pmain, (const unsigned long long*)(ws + WS_MASK), mix, b, half ? p : 63 - p, ldsg);
        }
        SEAM(4);
    }
    if (IN(5)) {
        __syncthreads();
        pg8::Gemm g{mix, wo, M, DM, 1024, 1024, 1024, 1 << 30}; pg8::StaticOrder S; S.init(M, DM, G, bid);
        pg8::EpiBf16X<0, false> E{oraw, DM, nullptr};
        pg8::gemm_phase<pg8::EpiBf16X<0, false>, pg8::StaticOrder, true, true>(ldsl, g, S, E);
        SEAM(5);
    }
    if (IN(6)) {
        p6_rows(ka->in[0], oraw, ka->in[9], ka->in[10], hn, gw, NGW, lane);
        SEAM(6);
    }
    if (IN(7)) {
        pg8::Gemm g{hn, w1t, M, DFF, 1024, 1024, 1024, 1 << 30}; pg8::StaticOrder S; S.init(M, DFF, G, bid);
        pg8::EpiBf16X<2, false> E{hid, DFF, nullptr};
        pg8::gemm_phase<pg8::EpiBf16X<2, false>, pg8::StaticOrder, true, true>(ldsl, g, S, E);
        SEAM(7);
    }
    if (IN(8)) {
        pg8::Gemm g{hid, w2t, M, DM, DFF, DFF, DFF, 1 << 30}; pg8::StaticOrder S; S.init(M, DM, G, bid);
        pg8::EpiBf16X<0, false> E{ffraw, DM, nullptr};
        pg8::gemm_phase<pg8::EpiBf16X<0, false>, pg8::StaticOrder, true, true>(ldsl, g, S, E);
        SEAM(8);
    }
    if (IN(9)) {
        p9_rows(oraw, ffraw, ka->in[13], ka->out, gw, NGW, lane);
    }
#undef IN
#undef SEAM
#undef hcat
#undef winm
#undef wspl
#undef wo
#undef w1t
#undef w2t
#undef tab128
#undef tab64
#undef pmain
#undef pspl
#undef mix
#undef oraw
#undef hn
#undef hid
#undef ffraw
#undef ss1
#undef ss2
#undef GLA_ARGS
}

extern "C" void kernel_launch(void* const* d_in, const int* in_sizes, int n_in, void* d_out, int out_size, void* d_ws, size_t ws_size, hipStream_t stream) {
    static int grid = 0;
    if (grid == 0) {
        if (n_in != 14 || in_sizes[0] != M * DM || out_size != M * DM || ws_size < WS_END) { fprintf(stderr, "kernel_launch: shape/workspace mismatch (n_in %d, in0 %d, out %d, ws %zu < %zu); nothing launched\n", n_in, n_in > 0 ? in_sizes[0] : -1, out_size, ws_size, (size_t)WS_END); grid = -1; return; }
        int dev = 0, cus = 0, per_cu = 0;
        if (hipGetDevice(&dev) != hipSuccess || hipDeviceGetAttribute(&cus, hipDeviceAttributeMultiprocessorCount, dev) != hipSuccess) { fprintf(stderr, "kernel_launch: device query failed\n"); grid = -1; return; }
        if (hipFuncSetAttribute((const void*)fwd_kernel, hipFuncAttributeMaxDynamicSharedMemorySize, LDS_BYTES) != hipSuccess) { fprintf(stderr, "kernel_launch: hipFuncSetAttribute(%d B LDS) failed\n", LDS_BYTES); grid = -1; return; }
        if (hipOccupancyMaxActiveBlocksPerMultiprocessor(&per_cu, (const void*)fwd_kernel, NTHR, LDS_BYTES) != hipSuccess || per_cu < 1) fprintf(stderr, "kernel_launch: note: occupancy query reports %d workgroups per CU\n", per_cu);
        (void)hipGetLastError();
        grid = cus;
    }
    if (grid < 0) return;
    if (hipMemsetAsync((char*)d_ws + WS_CTL, 0, CTL_ZERO_BYTES, stream) != hipSuccess) { fprintf(stderr, "kernel_launch: memset failed\n"); return; }
    Args a{};
    for (int i = 0; i < 14; ++i) a.in[i] = (const float*)d_in[i];
    a.out = (float*)d_out; a.ws = (unsigned char*)d_ws;
#if MK_ONE_LAUNCH && PROBE_REPEAT >= 0
    { const int k = PROBE_REPEAT; const int lo3[3] = {0, k, k + 1}, hi3[3] = {k + 1, k + 1, NPHASE};
      for (int li = 0; li < 3; ++li) { if (lo3[li] >= hi3[li]) continue; a.ph_lo = lo3[li]; a.ph_hi = hi3[li]; a.li = li;
          hipLaunchKernelGGL(fwd_kernel, dim3(grid), dim3(NTHR), LDS_BYTES, stream, a); } }
#elif MK_ONE_LAUNCH
    a.ph_lo = 0; a.ph_hi = NPHASE; a.li = 0;
    hipLaunchKernelGGL(fwd_kernel, dim3(grid), dim3(NTHR), LDS_BYTES, stream, a);
#else
    for (int ph = 0; ph < NPHASE; ++ph) { a.ph_lo = ph; a.ph_hi = ph + 1; a.li = ph;
        hipLaunchKernelGGL(fwd_kernel, dim3(grid), dim3(NTHR), LDS_BYTES, stream, a); }
#endif
    const hipError_t le = hipPeekAtLastError();
    if (le != hipSuccess) fprintf(stderr, "kernel_launch: launch failed: %s\n", hipGetErrorName(le));
}
```
